# Optimizing an MI355X kernel written in HIP

```python
import math
import jax
import jax.numpy as jnp
from jax import lax
import numpy as np

D_MODEL = 1024
BATCH = 16
SEQ = 4096
DEPTH = 2

MEM_TOKENS = 256
X_HEADS = 4
X_HEAD_DIM = 64
MAX_POS_OFFSET = 1024

A_HEADS = 8
NOPE_DIM = 64
ROPE_DIM = 32
QK_DIM = NOPE_DIM + ROPE_DIM
V_DIM = 64
Q_LORA = 256
KV_LORA = 128
ROPE_THETA = 10000.0
Q_BLOCK = 128

B_HEADS = 8
SSD_HEAD_DIM = 64
D_INNER = B_HEADS * SSD_HEAD_DIM
SSD_GROUPS = 2
SSD_STATE = 128
CONV_K = 4
CONV_CH = D_INNER + 2 * SSD_GROUPS * SSD_STATE
CHUNK = 128

IN_SPLITS = (Q_LORA,
             Q_LORA + KV_LORA,
             Q_LORA + KV_LORA + ROPE_DIM,
             Q_LORA + KV_LORA + ROPE_DIM + D_INNER,
             Q_LORA + KV_LORA + ROPE_DIM + D_INNER + CONV_CH)
IN_DIM = Q_LORA + KV_LORA + ROPE_DIM + D_INNER + CONV_CH + B_HEADS
MIX_WIDTH = A_HEADS * V_DIM + D_INNER

POOL_WINDOWS = (2, 4, 8, 16)
POOL_GROUP = D_MODEL // 4

MOE_GROUPS = 4
EXPERTS_PER_GROUP = 8
N_EXPERTS = MOE_GROUPS * EXPERTS_PER_GROUP
TOP_K = 2
EXPERT_FF = 256
ROW_BLOCK = 128

RMS_EPS = 1e-6

kernel_name = "hybrid_mla_ssd_pool_hmoe_trunk"


def rms_norm(u, g):
    uf = u.astype(jnp.float32)
    y = uf * lax.rsqrt(jnp.mean(uf * uf, axis=-1, keepdims=True) + RMS_EPS)
    return (y * g.astype(jnp.float32)).astype(u.dtype)


def rope_angles(positions):
    inv = ROPE_THETA ** (-jnp.arange(0, ROPE_DIM // 2, dtype=jnp.float32) * 2.0 / ROPE_DIM)
    ang = positions.astype(jnp.float32)[..., None] * inv
    return jnp.cos(ang)[:, :, None, :], jnp.sin(ang)[:, :, None, :]


def apply_rope(u, cos, sin):
    u1, u2 = jnp.split(u.astype(jnp.float32), 2, axis=-1)
    return jnp.concatenate([u1 * cos - u2 * sin, u2 * cos + u1 * sin], axis=-1).astype(u.dtype)


def causal_block_attention(q, k, v):
    _, s_len, _, dq = q.shape
    scale = dq ** -0.5
    outs = []
    for i in range(s_len // Q_BLOCK):
        lo, hi = i * Q_BLOCK, (i + 1) * Q_BLOCK
        s = jnp.einsum('bqhd,bkhd->bhqk', q[:, lo:hi], k[:, :hi]).astype(jnp.float32) * scale
        mask = (lo + jnp.arange(Q_BLOCK))[:, None] >= jnp.arange(hi)[None, :]
        p = jax.nn.softmax(jnp.where(mask, s, -jnp.inf), axis=-1).astype(v.dtype)
        outs.append(jnp.einsum('bhqk,bkhd->bqhd', p, v[:, :hi]))
    return jnp.concatenate(outs, axis=1)


def causal_depthwise_conv(u, w, b):
    c = u.shape[-1]
    y = lax.conv_general_dilated(u, w[:, None, :].astype(u.dtype), window_strides=(1,),
                                 padding=[(w.shape[0] - 1, 0)],
                                 dimension_numbers=('NWC', 'WIO', 'NWC'),
                                 feature_group_count=c)
    return y + b.astype(u.dtype)


def ssd_chunked_scan(x, dt, a, bm, cm):
    b, L, H, P = x.shape
    G, N = bm.shape[2], bm.shape[3]
    R = H // G
    nc = L // CHUNK
    xdt = (x * dt[..., None]).reshape(b, nc, CHUNK, G, R, P)
    adt = (dt * a).reshape(b, nc, CHUNK, G, R).transpose(0, 3, 4, 1, 2)
    bc = bm.reshape(b, nc, CHUNK, G, N)
    cc = cm.reshape(b, nc, CHUNK, G, N)
    a_cs = jnp.cumsum(adt, axis=-1)
    tri = jnp.tril(jnp.ones((CHUNK, CHUNK), dtype=bool))
    decay = jnp.exp(jnp.where(tri, a_cs[..., :, None] - a_cs[..., None, :], -jnp.inf))
    cb = jnp.einsum('bctgn,bcsgn->bgcts', cc, bc)
    y_diag = jnp.einsum('bgcts,bgrcts,bcsgrp->bctgrp', cb, decay, xdt)
    decay_to_end = jnp.exp(a_cs[..., -1:] - a_cs)
    chunk_states = jnp.einsum('bcsgn,bgrcs,bcsgrp->cbgrpn', bc, decay_to_end, xdt)
    chunk_decay = jnp.exp(a_cs[..., -1]).transpose(3, 0, 1, 2)

    def step(state, inp):
        s_c, d_c = inp
        return state * d_c[..., None, None] + s_c, state

    _, prev = lax.scan(step, jnp.zeros(chunk_states.shape[1:], x.dtype), (chunk_states, chunk_decay))
    y_off = jnp.einsum('bctgn,cbgrpn,bgrct->bctgrp', cc, prev, jnp.exp(a_cs))
    return (y_diag + y_off).reshape(b, L, H, P)


def latent_attention_ssd_mixer(h, cos, sin, w_in, q_lat_norm, w_uq, kv_lat_norm, w_ukv, q_norm, k_norm,
                               conv_w, conv_b, dt_bias, a_log, d_skip, ssd_norm, w_out):
    bsz, s_len, _ = h.shape
    proj = h @ w_in
    q_lat, kv_lat, k_rope, z, xbc, dt_raw = jnp.split(proj, IN_SPLITS, axis=-1)

    q = (rms_norm(q_lat, q_lat_norm) @ w_uq).reshape(bsz, s_len, A_HEADS, QK_DIM)
    kv = (rms_norm(kv_lat, kv_lat_norm) @ w_ukv).reshape(bsz, s_len, A_HEADS, NOPE_DIM + V_DIM)
    k_nope, v = kv[..., :NOPE_DIM], kv[..., NOPE_DIM:]
    k = jnp.concatenate([k_nope, jnp.broadcast_to(k_rope[:, :, None, :],
                                                  (bsz, s_len, A_HEADS, ROPE_DIM))], axis=-1)
    q = rms_norm(q, q_norm)
    k = rms_norm(k, k_norm)
    q = jnp.concatenate([q[..., :NOPE_DIM], apply_rope(q[..., NOPE_DIM:], cos, sin)], axis=-1)
    k = jnp.concatenate([k[..., :NOPE_DIM], apply_rope(k[..., NOPE_DIM:], cos, sin)], axis=-1)
    attn = causal_block_attention(q, k, v).reshape(bsz, s_len, A_HEADS * V_DIM)

    xbc = jax.nn.silu(causal_depthwise_conv(xbc, conv_w, conv_b))
    xs, bm, cm = jnp.split(xbc, [D_INNER, D_INNER + SSD_GROUPS * SSD_STATE], axis=-1)
    xs_h = xs.reshape(bsz, s_len, B_HEADS, SSD_HEAD_DIM).astype(jnp.float32)
    dt = jax.nn.softplus(dt_raw.astype(jnp.float32) + dt_bias.astype(jnp.float32))
    a = -jnp.exp(a_log.astype(jnp.float32))
    y = ssd_chunked_scan(xs_h, dt, a,
                         bm.reshape(bsz, s_len, SSD_GROUPS, SSD_STATE).astype(jnp.float32),
                         cm.reshape(bsz, s_len, SSD_GROUPS, SSD_STATE).astype(jnp.float32))
    y = y + xs_h * d_skip.astype(jnp.float32)[:, None]
    y = y.reshape(bsz, s_len, D_INNER).astype(h.dtype)
    y = rms_norm(y * jax.nn.silu(z), ssd_norm)

    return jnp.concatenate([attn, y], axis=-1) @ w_out


def multiscale_pool_mixer(h, pool_w, pool_b, pool_scale):
    bsz, s_len, d = h.shape
    hf = h.astype(jnp.float32)
    cs = jnp.pad(jnp.cumsum(hf, axis=1), ((0, 0), (1, 0), (0, 0)))
    pos_count = jnp.arange(1, s_len + 1, dtype=jnp.float32)[None, :, None]
    diffs = []
    for g, w in enumerate(POOL_WINDOWS):
        sl = slice(g * POOL_GROUP, (g + 1) * POOL_GROUP)
        csg = cs[:, :, sl]
        win_sum = csg[:, 1:] - jnp.pad(csg[:, :s_len + 1 - w], ((0, 0), (w - 1, 0), (0, 0)))
        diffs.append(win_sum / jnp.minimum(pos_count, float(w)) - hf[:, :, sl])
    dlt = jnp.stack(diffs, axis=2).astype(h.dtype)
    y = jnp.einsum('bsgc,gcd->bsgd', dlt, pool_w).reshape(bsz, s_len, d) + pool_b
    return y * pool_scale


def memory_cross_attention(hq, mem_n, wq, wkv, q_norm, k_norm, wo):
    bsz, s_len, _ = hq.shape
    m_len = mem_n.shape[1]
    q = rms_norm((hq @ wq).reshape(bsz, s_len, X_HEADS, X_HEAD_DIM), q_norm)
    kv = (mem_n @ wkv).reshape(bsz, m_len, 2, X_HEADS, X_HEAD_DIM)
    k = rms_norm(kv[:, :, 0], k_norm)
    v = kv[:, :, 1]
    s = jnp.einsum('bshd,bmhd->bhsm', q, k).astype(jnp.float32) * (X_HEAD_DIM ** -0.5)
    p = jax.nn.softmax(s, axis=-1).astype(v.dtype)
    o = jnp.einsum('bhsm,bmhd->bshd', p, v).reshape(bsz, s_len, X_HEADS * X_HEAD_DIM)
    return o @ wo


def routed_expert_ffn(hf, expert_idx, gates, w_gate, w_up, w_down):
    n_tok, d = hf.shape
    n_exp = w_gate.shape[0]
    m = n_tok * TOP_K
    flat_e = expert_idx.reshape(m)
    order = jnp.argsort(flat_e)
    sorted_e = flat_e[order]
    tok = (order // TOP_K).astype(jnp.int32)
    counts = jnp.bincount(flat_e, length=n_exp)
    padded = (counts + ROW_BLOCK - 1) // ROW_BLOCK * ROW_BLOCK
    pad_end = jnp.cumsum(padded)
    pad_start = pad_end - padded
    start = jnp.cumsum(counts) - counts
    dest = pad_start[sorted_e] + jnp.arange(m) - start[sorted_e]
    n_blocks = -(-m // ROW_BLOCK) + n_exp
    row_tok = jnp.zeros((n_blocks * ROW_BLOCK,), jnp.int32).at[dest].set(tok)
    block_e = jnp.minimum(jnp.searchsorted(pad_end, jnp.arange(n_blocks) * ROW_BLOCK, side='right'),
                          n_exp - 1)
    xb = hf[row_tok].reshape(n_blocks, ROW_BLOCK, d)

    def expert_block(args):
        xblk, e = args
        return (jax.nn.silu(xblk @ w_gate[e]) * (xblk @ w_up[e])) @ w_down[e]

    yb = lax.map(expert_block, (xb, block_e)).reshape(n_blocks * ROW_BLOCK, d)
    y_assign = yb[dest] * gates.reshape(m)[order][:, None]
    return jax.ops.segment_sum(y_assign, tok, num_segments=n_tok)


def hierarchical_moe(h, rg_w, rg_b, re_w, re_b, w_gate, w_up, w_down):
    bsz, s_len, d = h.shape
    n_tok = bsz * s_len
    hf = h.reshape(n_tok, d)
    g_prob = jax.nn.softmax((hf @ rg_w).astype(jnp.float32) + rg_b.astype(jnp.float32), axis=-1)
    g_p, g_idx = lax.top_k(g_prob, 1)
    e_logits = ((hf @ re_w).astype(jnp.float32) + re_b.astype(jnp.float32)).reshape(
        n_tok, MOE_GROUPS, EXPERTS_PER_GROUP)
    e_logits = jnp.take_along_axis(e_logits, g_idx[:, :, None], axis=1)[:, 0]
    e_p, e_idx = lax.top_k(jax.nn.softmax(e_logits, axis=-1), TOP_K)
    gates = g_p * e_p / jnp.sum(e_p, axis=-1, keepdims=True)
    expert_idx = (g_idx * EXPERTS_PER_GROUP + e_idx).astype(jnp.int32)
    y = routed_expert_ffn(hf, expert_idx, gates.astype(h.dtype), w_gate, w_up, w_down)
    return y.reshape(bsz, s_len, d)


def setup_inputs(seed: int = 0) -> dict:
    key = jax.random.key(seed)
    keys = iter(jax.random.split(key, 48))

    def nrm(shape, scale):
        return scale * jax.random.normal(next(keys), shape, jnp.float32)

    def gain(shape):
        return 1.0 + 0.05 * jax.random.normal(next(keys), shape, jnp.float32)

    ne, no = (DEPTH + 1) // 2, DEPTH // 2
    x = nrm((BATCH, SEQ, D_MODEL), 1.0)
    mem = nrm((BATCH, MEM_TOKENS, D_MODEL), 1.0)
    positions = (jax.random.randint(next(keys), (BATCH, 1), 0, MAX_POS_OFFSET, jnp.int32)
                 + jnp.arange(SEQ, dtype=jnp.int32)[None, :])
    ln_mix = gain((DEPTH, D_MODEL))
    w_in = nrm((ne, D_MODEL, IN_DIM), D_MODEL ** -0.5)
    q_lat_norm = gain((ne, Q_LORA))
    w_uq = nrm((ne, Q_LORA, A_HEADS * QK_DIM), Q_LORA ** -0.5)
    kv_lat_norm = gain((ne, KV_LORA))
    w_ukv = nrm((ne, KV_LORA, A_HEADS * (NOPE_DIM + V_DIM)), KV_LORA ** -0.5)
    q_norm = gain((ne, QK_DIM))
    k_norm = gain((ne, QK_DIM))
    conv_w = nrm((ne, CONV_K, CONV_CH), CONV_K ** -0.5)
    conv_b = nrm((ne, CONV_CH), 0.02)
    dt0 = jnp.exp(jax.random.uniform(next(keys), (ne, B_HEADS), jnp.float32,
                                     math.log(1e-3), math.log(1e-1)))
    dt_bias = dt0 + jnp.log(-jnp.expm1(-dt0))
    a_log = jnp.log(jax.random.uniform(next(keys), (ne, B_HEADS), jnp.float32, 1.0, 16.0))
    d_skip = gain((ne, B_HEADS))
    ssd_norm = gain((ne, D_INNER))
    w_out = nrm((ne, MIX_WIDTH, D_MODEL), MIX_WIDTH ** -0.5)
    pool_w = nrm((no, len(POOL_WINDOWS), POOL_GROUP, POOL_GROUP), POOL_GROUP ** -0.5)
    pool_b = nrm((no, D_MODEL), 0.02)
    pool_scale = gain((no, D_MODEL))
    ln_xq = gain((DEPTH, D_MODEL))
    ln_mem = gain((DEPTH, D_MODEL))
    xq_w = nrm((DEPTH, D_MODEL, X_HEADS * X_HEAD_DIM), D_MODEL ** -0.5)
    xkv_w = nrm((DEPTH, D_MODEL, 2 * X_HEADS * X_HEAD_DIM), D_MODEL ** -0.5)
    xq_norm = gain((DEPTH, X_HEAD_DIM))
    xk_norm = gain((DEPTH, X_HEAD_DIM))
    xo_w = nrm((DEPTH, X_HEADS * X_HEAD_DIM, D_MODEL), (X_HEADS * X_HEAD_DIM) ** -0.5)
    ln_ffn = gain((DEPTH, D_MODEL))
    rg_w = nrm((DEPTH, D_MODEL, MOE_GROUPS), D_MODEL ** -0.5)
    rg_b = nrm((DEPTH, MOE_GROUPS), 0.01)
    re_w = nrm((DEPTH, D_MODEL, N_EXPERTS), D_MODEL ** -0.5)
    re_b = nrm((DEPTH, N_EXPERTS), 0.01)
    exp_w_gate = nrm((DEPTH, N_EXPERTS, D_MODEL, EXPERT_FF), D_MODEL ** -0.5)
    exp_w_up = nrm((DEPTH, N_EXPERTS, D_MODEL, EXPERT_FF), D_MODEL ** -0.5)
    exp_w_down = nrm((DEPTH, N_EXPERTS, EXPERT_FF, D_MODEL), EXPERT_FF ** -0.5)
    return {"x": x, "mem": mem, "positions": positions, "ln_mix": ln_mix,
            "w_in": w_in, "q_lat_norm": q_lat_norm, "w_uq": w_uq, "kv_lat_norm": kv_lat_norm,
            "w_ukv": w_ukv, "q_norm": q_norm, "k_norm": k_norm, "conv_w": conv_w, "conv_b": conv_b,
            "dt_bias": dt_bias, "a_log": a_log, "d_skip": d_skip, "ssd_norm": ssd_norm, "w_out": w_out,
            "pool_w": pool_w, "pool_b": pool_b, "pool_scale": pool_scale,
            "ln_xq": ln_xq, "ln_mem": ln_mem, "xq_w": xq_w, "xkv_w": xkv_w, "xq_norm": xq_norm,
            "xk_norm": xk_norm, "xo_w": xo_w, "ln_ffn": ln_ffn, "rg_w": rg_w, "rg_b": rg_b,
            "re_w": re_w, "re_b": re_b, "exp_w_gate": exp_w_gate, "exp_w_up": exp_w_up,
            "exp_w_down": exp_w_down}


def reference(x, mem, positions, ln_mix, w_in, q_lat_norm, w_uq, kv_lat_norm, w_ukv, q_norm, k_norm,
              conv_w, conv_b, dt_bias, a_log, d_skip, ssd_norm, w_out, pool_w, pool_b, pool_scale,
              ln_xq, ln_mem, xq_w, xkv_w, xq_norm, xk_norm, xo_w, ln_ffn, rg_w, rg_b, re_w, re_b,
              exp_w_gate, exp_w_up, exp_w_down):
    cos, sin = rope_angles(positions)
    for layer in range(DEPTH):
        j = layer // 2
        h = rms_norm(x, ln_mix[layer])
        if layer % 2 == 0:
            mixed = latent_attention_ssd_mixer(h, cos, sin, w_in[j], q_lat_norm[j], w_uq[j],
                                               kv_lat_norm[j], w_ukv[j], q_norm[j], k_norm[j],
                                               conv_w[j], conv_b[j], dt_bias[j], a_log[j], d_skip[j],
                                               ssd_norm[j], w_out[j])
        else:
            mixed = multiscale_pool_mixer(h, pool_w[j], pool_b[j], pool_scale[j])
        x = x + mixed
        x = x + memory_cross_attention(rms_norm(x, ln_xq[layer]), rms_norm(mem, ln_mem[layer]),
                                       xq_w[layer], xkv_w[layer], xq_norm[layer], xk_norm[layer],
                                       xo_w[layer])
        x = x + hierarchical_moe(rms_norm(x, ln_ffn[layer]), rg_w[layer], rg_b[layer], re_w[layer],
                                 re_b[layer], exp_w_gate[layer], exp_w_up[layer], exp_w_down[layer])
    return x
```

```cpp
#include <hip/hip_runtime.h>
#include <hip/hip_cooperative_groups.h>
#include <cstdio>
#include <cstdint>
namespace cg = cooperative_groups;

#ifndef MULTI_LAUNCH
#define MULTI_LAUNCH 0
#endif

typedef unsigned short bf16_t;
typedef short bf16x8 __attribute__((ext_vector_type(8)));
typedef float f32x4 __attribute__((ext_vector_type(4)));
typedef unsigned u32x4 __attribute__((ext_vector_type(4)));

constexpr int NT = 65536, DM = 1024, SEQ = 4096, NB = 16;
constexpr int PROJ_LD = 2048;
constexpr int C_QLAT = 0, C_KVLAT = 256, C_KROPE = 384, C_Z = 416, C_XBC = 928, C_DT = 1952;
constexpr float EPS = 1e-6f;
constexpr float LOG2E = 1.4426950408889634f;

enum { I_X = 0, I_MEM, I_POS, I_LN_MIX, I_W_IN, I_QLAT_NORM, I_W_UQ, I_KVLAT_NORM, I_W_UKV, I_Q_NORM, I_K_NORM,
       I_CONV_W, I_CONV_B, I_DT_BIAS, I_A_LOG, I_D_SKIP, I_SSD_NORM, I_W_OUT, I_POOL_W, I_POOL_B, I_POOL_SCALE,
       I_LN_XQ, I_LN_MEM, I_XQ_W, I_XKV_W, I_XQ_NORM, I_XK_NORM, I_XO_W, I_LN_FFN, I_RG_W, I_RG_B, I_RE_W, I_RE_B,
       I_EXP_G, I_EXP_U, I_EXP_D, N_IN };

constexpr size_t MiB = 1ull << 20;
constexpr size_t OFF_WIN_T = 0;
constexpr size_t OFF_WUQ_T = OFF_WIN_T + 2048ull * 1024 * 2;
constexpr size_t OFF_WUKV_T = OFF_WUQ_T + 1024ull * 256 * 2;
constexpr size_t OFF_WOUT_T = OFF_WUKV_T + 1024ull * 128 * 2;
constexpr size_t OFF_POOL_T = OFF_WOUT_T + 1024ull * 1024 * 2;
constexpr size_t OFF_XQ_T = OFF_POOL_T + 4ull * 256 * 256 * 2;
constexpr size_t OFF_XKV_T = OFF_XQ_T + 2ull * 256 * 1024 * 2;
constexpr size_t OFF_XO_T = OFF_XKV_T + 2ull * 512 * 1024 * 2;
constexpr size_t OFF_WGU_T = OFF_XO_T + 2ull * 1024 * 256 * 2;
constexpr size_t OFF_WD_T = OFF_WGU_T + 64ull * 512 * 1024 * 2;
constexpr size_t OFF_R1 = OFF_WD_T + 64ull * 1024 * 256 * 2;
constexpr size_t OFF_R2 = OFF_R1 + 128 * MiB;
constexpr size_t OFF_R3 = OFF_R2 + 256 * MiB;
constexpr size_t OFF_R4 = OFF_R3 + 256 * MiB;
constexpr size_t OFF_MISC = OFF_R4 + 128 * MiB;
constexpr size_t OFF_Q = OFF_R3, OFF_K = OFF_R3 + 96 * MiB, OFF_VT = OFF_R3 + 192 * MiB;
constexpr size_t OFF_XCB = OFF_R3, OFF_XQ = OFF_R3 + 128 * MiB, OFF_XO = OFF_R3 + 160 * MiB, OFF_HBUF = OFF_R3 + 192 * MiB;
constexpr size_t OFF_RS0 = OFF_MISC;
constexpr size_t OFF_SSQ_Q = OFF_RS0 + NT * 4ull;
constexpr size_t OFF_SSQ_KV = OFF_SSQ_Q + NT * 8ull;
constexpr size_t OFF_DTRAW = OFF_SSQ_KV + NT * 4ull;
constexpr size_t OFF_DT = OFF_DTRAW + NT * 32ull;
constexpr size_t OFF_SSQA = OFF_DT + NT * 32ull;
constexpr size_t OFF_SSQB = OFF_SSQA + NT * 32ull;
constexpr size_t OFF_RS3 = OFF_SSQB + NT * 32ull;
constexpr size_t OFF_MEMB = OFF_RS3 + NT * 4ull;
constexpr size_t OFF_RSM = OFF_MEMB + 4096ull * 1024 * 2;
constexpr size_t OFF_MEMK = OFF_RSM + 4096 * 4ull;
constexpr size_t OFF_MEMVT = OFF_MEMK + 2ull * 4096 * 256 * 2;
constexpr size_t OFF_GATE = OFF_MEMVT + 2ull * 4096 * 256 * 2;
constexpr size_t OFF_LIST = OFF_GATE + NT * 8ull;
constexpr size_t OFF_CTL = OFF_LIST + 32ull * 65536 * 4;
constexpr size_t WS_END = OFF_CTL + 4096;

constexpr int CTL_CNT = 0;
constexpr int CTL_QCTR = 64;

constexpr int LDS_ST = 72;
constexpr int CS_LD = 132;
constexpr int SMEM_MAIN = 2 * 2 * 128 * LDS_ST * 2;
constexpr int SMEM_BYTES = SMEM_MAIN + 512;

struct Params {
  const void* in[N_IN];
  float* out;
  char* ws;
  int phase_lo, phase_hi;
};

struct Ctx { const Params& p; char* ws; char* smem; int tid, bid, nblk; };
__device__ __forceinline__ int opq(int i) { asm volatile("" : "+s"(i)); return i; }
#define INP(i) ((const float*)c.p.in[opq(i)])

__device__ __forceinline__ bf16_t f2bf(float f) {
  unsigned u = __float_as_uint(f);
  u += 0x7fffu + ((u >> 16) & 1u);
  return (bf16_t)(u >> 16);
}
__device__ __forceinline__ float bf2f(bf16_t h) { return __uint_as_float(((unsigned)h) << 16); }
__device__ __forceinline__ unsigned pack2(float lo, float hi) { return (unsigned)f2bf(lo) | ((unsigned)f2bf(hi) << 16); }
__device__ __forceinline__ float bflo(unsigned u) { return __uint_as_float(u << 16); }
__device__ __forceinline__ float bfhi(unsigned u) { return __uint_as_float(u & 0xffff0000u); }
__device__ __forceinline__ float silu_f(float x) { return x / (1.f + __expf(-x)); }
__device__ __forceinline__ float wave_sum(float v) {
#pragma unroll
  for (int o = 32; o > 0; o >>= 1) v += __shfl_xor(v, o);
  return v;
}
__device__ __forceinline__ f32x4 mfma16(bf16x8 a, bf16x8 b, f32x4 c) { return __builtin_amdgcn_mfma_f32_16x16x32_bf16(a, b, c, 0, 0, 0); }

__device__ __forceinline__ void gemm_core(const bf16_t* const (&ap)[4], const bf16_t* const (&bp)[4], int K, char* smem, int tid) {
  const int t = tid, lane = t & 63, w = t >> 6;
  const int wr = w >> 1, wc = w & 1;
  const int l15 = lane & 15, lq = lane >> 4;
  bf16_t* As = (bf16_t*)smem;
  bf16_t* Bs = As + 2 * 128 * LDS_ST;
  const int srow = t >> 3, scol = (t & 7) * 8;
  u32x4 ra[4], rb[4];
#pragma unroll
  for (int i = 0; i < 4; ++i) { ra[i] = *(const u32x4*)(ap[i]); rb[i] = *(const u32x4*)(bp[i]); }
#pragma unroll
  for (int i = 0; i < 4; ++i) {
    *(u32x4*)(As + (srow + 32 * i) * LDS_ST + scol) = ra[i];
    *(u32x4*)(Bs + (srow + 32 * i) * LDS_ST + scol) = rb[i];
  }
  __syncthreads();
  f32x4 acc[4][4];
#pragma unroll
  for (int i = 0; i < 4; ++i)
#pragma unroll
    for (int j = 0; j < 4; ++j) acc[i][j] = (f32x4){0.f, 0.f, 0.f, 0.f};
  const int nk = K >> 6;
  for (int kt = 0; kt < nk; ++kt) {
    const int cur = kt & 1;
    {
      const int kn = (kt + 1 < nk) ? kt + 1 : kt;
#pragma unroll
      for (int i = 0; i < 4; ++i) { ra[i] = *(const u32x4*)(ap[i] + kn * 64); rb[i] = *(const u32x4*)(bp[i] + kn * 64); }
    }
    const bf16_t* Ac = As + cur * 128 * LDS_ST;
    const bf16_t* Bc = Bs + cur * 128 * LDS_ST;
#pragma unroll
    for (int ks = 0; ks < 2; ++ks) {
      bf16x8 af[4], bfr[4];
#pragma unroll
      for (int mt = 0; mt < 4; ++mt) af[mt] = *(const bf16x8*)(Ac + (wr * 64 + mt * 16 + l15) * LDS_ST + ks * 32 + lq * 8);
#pragma unroll
      for (int nt = 0; nt < 4; ++nt) bfr[nt] = *(const bf16x8*)(Bc + (wc * 64 + nt * 16 + l15) * LDS_ST + ks * 32 + lq * 8);
#pragma unroll
      for (int mt = 0; mt < 4; ++mt)
#pragma unroll
        for (int nt = 0; nt < 4; ++nt) acc[mt][nt] = mfma16(af[mt], bfr[nt], acc[mt][nt]);
    }
    {
      bf16_t* An = As + (cur ^ 1) * 128 * LDS_ST;
      bf16_t* Bn = Bs + (cur ^ 1) * 128 * LDS_ST;
#pragma unroll
      for (int i = 0; i < 4; ++i) {
        *(u32x4*)(An + (srow + 32 * i) * LDS_ST + scol) = ra[i];
        *(u32x4*)(Bn + (srow + 32 * i) * LDS_ST + scol) = rb[i];
      }
    }
    __syncthreads();
  }
  float* Cs = (float*)smem;
#pragma unroll
  for (int mt = 0; mt < 4; ++mt)
#pragma unroll
    for (int nt = 0; nt < 4; ++nt)
#pragma unroll
      for (int r = 0; r < 4; ++r)
        Cs[(wr * 64 + mt * 16 + lq * 4 + r) * CS_LD + wc * 64 + nt * 16 + l15] = acc[mt][nt][r];
  __syncthreads();
}

__device__ __forceinline__ void gemm_dense(const bf16_t* A, long lda, const bf16_t* Bt, long ldb, int K, char* smem, int tid) {
  const int t = tid;
  const int srow = t >> 3, scol = (t & 7) * 8;
  const bf16_t* ap[4]; const bf16_t* bp[4];
#pragma unroll
  for (int i = 0; i < 4; ++i) { ap[i] = A + (long)(srow + 32 * i) * lda + scol; bp[i] = Bt + (long)(srow + 32 * i) * ldb + scol; }
  gemm_core(ap, bp, K, smem, tid);
}

template <int N>
__device__ __forceinline__ void store_bf16_row(bf16_t* dst, const float (&v)[N]) {
#pragma unroll
  for (int j = 0; j < N; j += 8) {
    uint4 u;
    u.x = pack2(v[j], v[j + 1]); u.y = pack2(v[j + 2], v[j + 3]); u.z = pack2(v[j + 4], v[j + 5]); u.w = pack2(v[j + 6], v[j + 7]);
    *(uint4*)(dst + j) = u;
  }
}

__device__ __forceinline__ void tconv_tile(const float* src, int N, bf16_t* dst, int dst_ld, int grp, int grp_pad, int goff, const float* gain,
                           int tk, int tn, float* tl, int tid) {
  const int t = tid;
  const int k0 = tk * 64, n0 = tn * 64;
#pragma unroll
  for (int i = 0; i < 4; ++i) {
    const int r = (t >> 4) + 16 * i, c = (t & 15) * 4;
    float4 v = make_float4(0.f, 0.f, 0.f, 0.f);
    if (n0 + c < N) v = *(const float4*)(src + (long)(k0 + r) * N + n0 + c);
    const float g = gain ? gain[k0 + r] : 1.f;
    tl[r * 65 + c + 0] = v.x * g; tl[r * 65 + c + 1] = v.y * g; tl[r * 65 + c + 2] = v.z * g; tl[r * 65 + c + 3] = v.w * g;
  }
  __syncthreads();
  const int n = n0 + (t >> 2);
  if (n < N) {
    const int drow = (n / grp) * grp_pad + goff + (n % grp);
    const int kk = (t & 3) * 16;
    unsigned u[8];
#pragma unroll
    for (int j = 0; j < 8; ++j) u[j] = pack2(tl[(kk + 2 * j) * 65 + (t >> 2)], tl[(kk + 2 * j + 1) * 65 + (t >> 2)]);
    bf16_t* d = dst + (long)drow * dst_ld + k0 + kk;
    *(uint4*)(d) = make_uint4(u[0], u[1], u[2], u[3]);
    *(uint4*)(d + 8) = make_uint4(u[4], u[5], u[6], u[7]);
  }
  __syncthreads();
}

struct TJob { const float* src; int K, N; bf16_t* dst; int dst_ld, grp, grp_pad, goff; const float* gain; };
constexpr int N_TJOBS = 5 + 4 + 6 + 192;
__device__ __forceinline__ TJob get_tjob(int idx, const Ctx& c, char* ws) {
  constexpr int BIG = 1 << 30;
  TJob j;
  if (idx == 0) j = {INP(I_W_IN), 1024, 1960, (bf16_t*)(ws + OFF_WIN_T), 1024, BIG, 0, 0, INP(I_LN_MIX)};
  else if (idx == 1) j = {INP(I_W_UQ), 256, 768, (bf16_t*)(ws + OFF_WUQ_T), 256, 96, 128, 0, INP(I_QLAT_NORM)};
  else if (idx == 2) j = {INP(I_W_UKV), 128, 1024, (bf16_t*)(ws + OFF_WUKV_T), 128, BIG, 0, 0, INP(I_KVLAT_NORM)};
  else if (idx == 3) j = {INP(I_W_OUT), 512, 1024, (bf16_t*)(ws + OFF_WOUT_T), 1024, BIG, 0, 0, nullptr};
  else if (idx == 4) j = {INP(I_W_OUT) + 512 * 1024, 512, 1024, (bf16_t*)(ws + OFF_WOUT_T) + 512, 1024, BIG, 0, 0, INP(I_SSD_NORM)};
  else if (idx < 9) { const int g = idx - 5; j = {INP(I_POOL_W) + g * 65536, 256, 256, (bf16_t*)(ws + OFF_POOL_T) + g * 65536, 256, BIG, 0, 0, INP(I_LN_MIX) + 1024 + g * 256}; }
  else if (idx < 15) {
    const int l = (idx - 9) / 3, k = (idx - 9) % 3;
    if (k == 0) j = {INP(I_XQ_W) + l * 1024 * 256, 1024, 256, (bf16_t*)(ws + OFF_XQ_T) + l * 256 * 1024, 1024, BIG, 0, 0, INP(I_LN_XQ) + l * 1024};
    else if (k == 1) j = {INP(I_XKV_W) + l * 1024 * 512, 1024, 512, (bf16_t*)(ws + OFF_XKV_T) + l * 512 * 1024, 1024, BIG, 0, 0, INP(I_LN_MEM) + l * 1024};
    else j = {INP(I_XO_W) + l * 256 * 1024, 256, 1024, (bf16_t*)(ws + OFF_XO_T) + l * 1024 * 256, 256, BIG, 0, 0, nullptr};
  } else {
    const int le = (idx - 15) / 3, k = (idx - 15) % 3, l = le >> 5;
    const long wo = (long)le * 1024 * 256;
    if (k == 0) j = {INP(I_EXP_G) + wo, 1024, 256, (bf16_t*)(ws + OFF_WGU_T) + (long)le * 512 * 1024, 1024, 64, 128, 0, INP(I_LN_FFN) + l * 1024};
    else if (k == 1) j = {INP(I_EXP_U) + wo, 1024, 256, (bf16_t*)(ws + OFF_WGU_T) + (long)le * 512 * 1024, 1024, 64, 128, 64, INP(I_LN_FFN) + l * 1024};
    else j = {INP(I_EXP_D) + wo, 256, 1024, (bf16_t*)(ws + OFF_WD_T) + (long)le * 1024 * 256, 256, BIG, 0, 0, nullptr};
  }
  return j;
}

__device__ __forceinline__ void phase_prep(const Ctx& c) {
  char* ws = c.ws; char* smem = c.smem; const int bid = c.bid, nblk = c.nblk;
  float* tl = (float*)smem;
  int base = 0;
  for (int ji = 0; ji < N_TJOBS; ++ji) {
    const TJob j = get_tjob(ji, c, ws);
    const int tilesN = (j.N + 63) / 64, tilesK = j.K / 64;
    const int ntiles = tilesN * tilesK;
    const int t0 = (bid - (base % nblk) + nblk) % nblk;
    for (int tile = t0; tile < ntiles; tile += nblk)
      tconv_tile(j.src, j.N, j.dst, j.dst_ld, j.grp, j.grp_pad, j.goff, j.gain, tile / tilesN, tile % tilesN, tl, c.tid);
    base += ntiles;
  }
  {
    const int gt = bid * 256 + c.tid, gn = nblk * 256;
    uint4 z = make_uint4(0, 0, 0, 0);
    bf16_t* w1 = (bf16_t*)(ws + OFF_WIN_T) + 1960l * 1024;
    for (int i = gt; i < 88 * 1024 / 8; i += gn) *(uint4*)(w1 + i * 8) = z;
    bf16_t* w2 = (bf16_t*)(ws + OFF_WUQ_T);
    for (int i = gt; i < 8 * 32 * 256 / 8; i += gn) {
      const int e = i * 8, h = e / (32 * 256), rem = e % (32 * 256);
      *(uint4*)(w2 + (long)(h * 128 + 96) * 256 + rem) = z;
    }
    if (gt < 128) ((int*)(ws + OFF_CTL))[gt] = 0;
  }
  {
    const int lane = c.tid & 63;
    const int gw = bid * 4 + (c.tid >> 6), nw = nblk * 4;
    for (int row = gw; row < NT + 4096; row += nw) {
      const bool ism = row >= NT;
      const int r = ism ? row - NT : row;
      const float* src = (ism ? INP(I_MEM) : INP(I_X)) + (long)r * 1024;
      bf16_t* dst = (bf16_t*)(ws + (ism ? OFF_MEMB : OFF_R1)) + (long)r * 1024;
      float ss = 0.f;
#pragma unroll
      for (int i = 0; i < 4; ++i) {
        float4 v = *(const float4*)(src + i * 256 + lane * 4);
        ss += v.x * v.x + v.y * v.y + v.z * v.z + v.w * v.w;
        *(uint2*)(dst + i * 256 + lane * 4) = make_uint2(pack2(v.x, v.y), pack2(v.z, v.w));
      }
      ss = wave_sum(ss);
      if (lane == 0) ((float*)(ws + (ism ? OFF_RSM : OFF_RS0)))[r] = rsqrtf(ss * (1.f / 1024.f) + EPS);
    }
  }
}

__device__ __forceinline__ float cs_ssq(const float* crow, int n) {
  float ss = 0.f;
  for (int j = 0; j < n; j += 4) { const float4 c = *(const float4*)(crow + j); ss += c.x * c.x + c.y * c.y + c.z * c.z + c.w * c.w; }
  return ss;
}
__device__ __forceinline__ void cs_store_scaled(bf16_t* dst, const float* crow, int n, float sc, const float* g) {
  for (int j = 0; j < n; j += 8) {
    float4 a = *(const float4*)(crow + j), b = *(const float4*)(crow + j + 4);
    if (g) {
      const float4 ga = *(const float4*)(g + j), gb = *(const float4*)(g + j + 4);
      a.x *= ga.x; a.y *= ga.y; a.z *= ga.z; a.w *= ga.w; b.x *= gb.x; b.y *= gb.y; b.z *= gb.z; b.w *= gb.w;
    }
    *(uint4*)(dst + j) = make_uint4(pack2(a.x * sc, a.y * sc), pack2(a.z * sc, a.w * sc), pack2(b.x * sc, b.y * sc), pack2(b.z * sc, b.w * sc));
  }
}
__device__ __forceinline__ void rope_cs(float pos, int i, float& c, float& s) {
  const float ang = pos * exp2f(-(float)i * 0.8304820237218406f);
  float u = ang * 0.15915494309189535f;
  u -= rintf(u);
  c = __builtin_amdgcn_cosf(u);
  s = __builtin_amdgcn_sinf(u);
}

__device__ __forceinline__ void phase_gemm_in(const Ctx& c) {
  char* ws = c.ws; char* smem = c.smem; const int bid = c.bid, nblk = c.nblk; (void)smem; (void)bid; (void)nblk;
  const int t = c.tid, er = t >> 1, eh = t & 1;
  const float* crow = (const float*)smem + er * CS_LD + eh * 64;
  const int n_main = 512 * 16;
  const int n_items = n_main + 2 * 32 * 4;
  for (int item = bid; item < n_items; item += nblk) {
    if (item < n_main) {
      const int mt = item >> 4, nt = item & 15;
      gemm_dense((const bf16_t*)(ws + OFF_R1) + (long)mt * 128 * 1024, 1024, (const bf16_t*)(ws + OFF_WIN_T) + (long)nt * 128 * 1024, 1024, 1024, smem, c.tid);
      const int row = mt * 128 + er;
      const float sc = ((const float*)(ws + OFF_RS0))[row];
      cs_store_scaled((bf16_t*)(ws + OFF_R2) + (long)row * PROJ_LD + nt * 128 + eh * 64, crow, 64, sc, nullptr);
      if (nt == 15 && eh == 0) {
        float* d = (float*)(ws + OFF_DTRAW) + (long)row * 8;
        const float4 a = *(const float4*)(crow + 32), b = *(const float4*)(crow + 36);
        *(float4*)d = make_float4(a.x * sc, a.y * sc, a.z * sc, a.w * sc);
        *(float4*)(d + 4) = make_float4(b.x * sc, b.y * sc, b.z * sc, b.w * sc);
      }
      if (nt <= 2) {
        float ss = cs_ssq(crow, 64) * sc * sc;
        ss += __shfl_xor(ss, 1);
        if (eh == 0) {
          if (nt < 2) ((float*)(ws + OFF_SSQ_Q))[row * 2 + nt] = ss;
          else ((float*)(ws + OFF_SSQ_KV))[row] = ss;
        }
      }
    } else {
      const int it = item - n_main;
      const int l = it >> 7, mt = (it >> 2) & 31, nt = it & 3;
      gemm_dense((const bf16_t*)(ws + OFF_MEMB) + (long)mt * 128 * 1024, 1024,
                 (const bf16_t*)(ws + OFF_XKV_T) + (long)l * 512 * 1024 + (long)nt * 128 * 1024, 1024, 1024, smem, c.tid);
      const int row = mt * 128 + er;
      const float sc = ((const float*)(ws + OFF_RSM))[row];
      if (nt < 2) {
        const int head = nt * 2 + eh;
        const float ss = cs_ssq(crow, 64) * sc * sc;
        const float r = rsqrtf(ss * (1.f / 64.f) + EPS) * sc;
        cs_store_scaled((bf16_t*)(ws + OFF_MEMK) + (long)l * 4096 * 256 + (long)row * 256 + head * 64, crow, 64, r, INP(I_XK_NORM) + l * 64);
      } else {
        const int head = (nt - 2) * 2 + eh;
        const int b = row >> 8, m = row & 255;
        bf16_t* d = (bf16_t*)(ws + OFF_MEMVT) + (long)l * 4096 * 256 + ((long)(b * 4 + head) * 64) * 256 + m;
        for (int j = 0; j < 64; ++j) d[j * 256] = f2bf(crow[j] * sc);
      }
    }
    __syncthreads();
  }
}

__device__ __forceinline__ void phase_up(const Ctx& c) {
  char* ws = c.ws; char* smem = c.smem; const int bid = c.bid, nblk = c.nblk; (void)smem; (void)bid; (void)nblk;
  const int t = c.tid, er = t >> 1, eh = t & 1;
  const float* crow = (const float*)smem + er * CS_LD + eh * 64;
  const bf16_t* proj = (const bf16_t*)(ws + OFF_R2);
  const int* positions = (const int*)c.p.in[opq(I_POS)];
  const int n_items = 512 * 8 * 2;
  for (int item = bid; item < n_items; item += nblk) {
    const int which = item >= 4096;
    const int it = item & 4095;
    const int mt = it >> 3, h = it & 7;
    const int row = mt * 128 + er;
    const int b = row >> 12, s = row & 4095;
    if (!which) {
      gemm_dense(proj + (long)mt * 128 * PROJ_LD + C_QLAT, PROJ_LD, (const bf16_t*)(ws + OFF_WUQ_T) + (long)h * 128 * 256, 256, 256, smem, c.tid);
      const float* sq = (const float*)(ws + OFF_SSQ_Q) + row * 2;
      const float rq = rsqrtf((sq[0] + sq[1]) * (1.f / 256.f) + EPS);
      float ss = cs_ssq(crow, eh ? 32 : 64) * rq * rq;
      ss += __shfl_xor(ss, 1);
      const float r = rsqrtf(ss * (1.f / 96.f) + EPS) * rq * (0.10206207261596577f * LOG2E);
      const float* g = INP(I_Q_NORM) + eh * 64;
      bf16_t* dst = (bf16_t*)(ws + OFF_Q) + ((long)(b * 8 + h) * 4096 + s) * 96 + eh * 64;
      if (!eh) {
        cs_store_scaled(dst, crow, 64, r, g);
      } else {
        const float pos = (float)positions[row];
        for (int i0 = 0; i0 < 16; i0 += 8) {
          float o1[8], o2[8];
#pragma unroll
          for (int i = 0; i < 8; ++i) {
            float c, sn; rope_cs(pos, i0 + i, c, sn);
            const float u1 = crow[i0 + i] * r * g[i0 + i], u2 = crow[16 + i0 + i] * r * g[16 + i0 + i];
            o1[i] = u1 * c - u2 * sn; o2[i] = u2 * c + u1 * sn;
          }
          *(uint4*)(dst + i0) = make_uint4(pack2(o1[0], o1[1]), pack2(o1[2], o1[3]), pack2(o1[4], o1[5]), pack2(o1[6], o1[7]));
          *(uint4*)(dst + 16 + i0) = make_uint4(pack2(o2[0], o2[1]), pack2(o2[2], o2[3]), pack2(o2[4], o2[5]), pack2(o2[6], o2[7]));
        }
      }
    } else {
      gemm_dense(proj + (long)mt * 128 * PROJ_LD + C_KVLAT, PROJ_LD, (const bf16_t*)(ws + OFF_WUKV_T) + (long)h * 128 * 128, 128, 128, smem, c.tid);
      const float rkv = rsqrtf(((const float*)(ws + OFF_SSQ_KV))[row] * (1.f / 128.f) + EPS);
      if (!eh) {
        const bf16_t* kp = proj + (long)row * PROJ_LD + C_KROPE;
        float ss = cs_ssq(crow, 64) * rkv * rkv;
        for (int j = 0; j < 32; j += 8) {
          const uint4 u = *(const uint4*)(kp + j);
          ss += bflo(u.x) * bflo(u.x) + bfhi(u.x) * bfhi(u.x) + bflo(u.y) * bflo(u.y) + bfhi(u.y) * bfhi(u.y)
              + bflo(u.z) * bflo(u.z) + bfhi(u.z) * bfhi(u.z) + bflo(u.w) * bflo(u.w) + bfhi(u.w) * bfhi(u.w);
        }
        const float r = rsqrtf(ss * (1.f / 96.f) + EPS);
        const float* g = INP(I_K_NORM);
        bf16_t* dst = (bf16_t*)(ws + OFF_K) + ((long)(b * 8 + h) * 4096 + s) * 96;
        cs_store_scaled(dst, crow, 64, r * rkv, g);
        const float pos = (float)positions[row];
        for (int i0 = 0; i0 < 16; i0 += 8) {
          const uint4 ua = *(const uint4*)(kp + i0), ub = *(const uint4*)(kp + 16 + i0);
          const float k1[8] = {bflo(ua.x), bfhi(ua.x), bflo(ua.y), bfhi(ua.y), bflo(ua.z), bfhi(ua.z), bflo(ua.w), bfhi(ua.w)};
          const float k2[8] = {bflo(ub.x), bfhi(ub.x), bflo(ub.y), bfhi(ub.y), bflo(ub.z), bfhi(ub.z), bflo(ub.w), bfhi(ub.w)};
          float o1[8], o2[8];
#pragma unroll
          for (int i = 0; i < 8; ++i) {
            float c, sn; rope_cs(pos, i0 + i, c, sn);
            const float u1 = k1[i] * r * g[64 + i0 + i], u2 = k2[i] * r * g[80 + i0 + i];
            o1[i] = u1 * c - u2 * sn; o2[i] = u2 * c + u1 * sn;
          }
          *(uint4*)(dst + 64 + i0) = make_uint4(pack2(o1[0], o1[1]), pack2(o1[2], o1[3]), pack2(o1[4], o1[5]), pack2(o1[6], o1[7]));
          *(uint4*)(dst + 80 + i0) = make_uint4(pack2(o2[0], o2[1]), pack2(o2[2], o2[3]), pack2(o2[4], o2[5]), pack2(o2[6], o2[7]));
        }
      } else {
        bf16_t* d = (bf16_t*)(ws + OFF_VT) + ((long)(b * 8 + h) * 64) * 4096 + s;
        for (int j = 0; j < 64; ++j) d[(long)j * 4096] = f2bf(crow[j] * rkv);
      }
    }
    __syncthreads();
  }
  {
    const long gt = (long)bid * 256 + t, gn = (long)nblk * 256;
    const float* cw = INP(I_CONV_W);
    const float* cb = INP(I_CONV_B);
    bf16_t* xc = (bf16_t*)(ws + OFF_R4);
    for (long i = gt; i < (long)NT * 128; i += gn) {
      const int tok = (int)(i >> 7), ch = (int)(i & 127) * 8;
      const int s = tok & 4095;
      float a[8];
#pragma unroll
      for (int j = 0; j < 8; ++j) a[j] = cb[ch + j];
#pragma unroll
      for (int k = 0; k < 4; ++k) {
        const int ds = k - 3;
        if (s + ds >= 0) {
          uint4 u = *(const uint4*)(proj + (long)(tok + ds) * PROJ_LD + C_XBC + ch);
          const float* w = cw + k * 1024 + ch;
          a[0] += w[0] * bflo(u.x); a[1] += w[1] * bfhi(u.x); a[2] += w[2] * bflo(u.y); a[3] += w[3] * bfhi(u.y);
          a[4] += w[4] * bflo(u.z); a[5] += w[5] * bfhi(u.z); a[6] += w[6] * bflo(u.w); a[7] += w[7] * bfhi(u.w);
        }
      }
#pragma unroll
      for (int j = 0; j < 8; ++j) a[j] = silu_f(a[j]);
      *(uint4*)(xc + (long)tok * 1024 + ch) = make_uint4(pack2(a[0], a[1]), pack2(a[2], a[3]), pack2(a[4], a[5]), pack2(a[6], a[7]));
    }
    const float* dtr = (const float*)(ws + OFF_DTRAW);
    float* dt = (float*)(ws + OFF_DT);
    for (long i = gt; i < (long)NT * 8; i += gn) {
      const float x = dtr[i] + INP(I_DT_BIAS)[i & 7];
      dt[i] = x > 20.f ? x : log1pf(__expf(x));
    }
  }
}

template <int DQK, bool CAUSAL>
__device__ __forceinline__ void attn_block(const bf16_t* Q, long ldq, const bf16_t* K, long ldk, const bf16_t* Vt, long ldvt, int ntiles, int q0,
                           bf16_t* O, long ldo, char* smem, int tid) {
  constexpr int KLD = DQK + 8, NKS = DQK / 32, KCH = DQK / 8;
  const int t = tid, lane = t & 63, w = t >> 6, l15 = lane & 15, lq = lane >> 4;
  bf16_t* Ks = (bf16_t*)smem;
  bf16_t* Vts = Ks + 64 * KLD;
  bf16_t* Ps = Vts + 64 * 72 + w * 32 * 72;
  bf16x8 qf[2][NKS];
#pragma unroll
  for (int mt = 0; mt < 2; ++mt)
#pragma unroll
    for (int ks = 0; ks < NKS; ++ks) qf[mt][ks] = *(const bf16x8*)(Q + (long)(w * 32 + mt * 16 + l15) * ldq + ks * 32 + lq * 8);
  f32x4 oacc[2][4];
  float mrow[2][4], lrow[2][4];
#pragma unroll
  for (int mt = 0; mt < 2; ++mt)
#pragma unroll
    for (int i = 0; i < 4; ++i) { oacc[mt][i] = (f32x4){0.f, 0.f, 0.f, 0.f}; mrow[mt][i] = -1e30f; lrow[mt][i] = 0.f; }
  for (int kt = 0; kt < ntiles; ++kt) {
    for (int c = t; c < 64 * KCH; c += 256) {
      const int r = c / KCH, cc = c % KCH;
      *(uint4*)(Ks + r * KLD + cc * 8) = *(const uint4*)(K + (long)(kt * 64 + r) * ldk + cc * 8);
    }
    for (int c = t; c < 512; c += 256) {
      const int r = c >> 3, cc = c & 7;
      *(uint4*)(Vts + r * 72 + cc * 8) = *(const uint4*)(Vt + (long)r * ldvt + kt * 64 + cc * 8);
    }
    __syncthreads();
    f32x4 sacc[2][4];
#pragma unroll
    for (int mt = 0; mt < 2; ++mt)
#pragma unroll
      for (int nt = 0; nt < 4; ++nt) sacc[mt][nt] = (f32x4){0.f, 0.f, 0.f, 0.f};
#pragma unroll
    for (int nt = 0; nt < 4; ++nt)
#pragma unroll
      for (int ks = 0; ks < NKS; ++ks) {
        const bf16x8 kf = *(const bf16x8*)(Ks + (nt * 16 + l15) * KLD + ks * 32 + lq * 8);
        sacc[0][nt] = mfma16(qf[0][ks], kf, sacc[0][nt]);
        sacc[1][nt] = mfma16(qf[1][ks], kf, sacc[1][nt]);
      }
    if (CAUSAL && (kt * 64 + 63 > q0 + w * 32)) {
#pragma unroll
      for (int mt = 0; mt < 2; ++mt)
#pragma unroll
        for (int nt = 0; nt < 4; ++nt)
#pragma unroll
          for (int r = 0; r < 4; ++r) {
            const int key = kt * 64 + nt * 16 + l15, qr = q0 + w * 32 + mt * 16 + lq * 4 + r;
            if (key > qr) sacc[mt][nt][r] = -1e30f;
          }
    }
#pragma unroll
    for (int mt = 0; mt < 2; ++mt)
#pragma unroll
      for (int r = 0; r < 4; ++r) {
        float mx = fmaxf(fmaxf(sacc[mt][0][r], sacc[mt][1][r]), fmaxf(sacc[mt][2][r], sacc[mt][3][r]));
        mx = fmaxf(mx, __shfl_xor(mx, 1)); mx = fmaxf(mx, __shfl_xor(mx, 2));
        mx = fmaxf(mx, __shfl_xor(mx, 4)); mx = fmaxf(mx, __shfl_xor(mx, 8));
        const float mn = fmaxf(mrow[mt][r], mx);
        const float alpha = __builtin_amdgcn_exp2f(mrow[mt][r] - mn);
        mrow[mt][r] = mn;
        float ps = 0.f;
#pragma unroll
        for (int nt = 0; nt < 4; ++nt) {
          const float pv = __builtin_amdgcn_exp2f(sacc[mt][nt][r] - mn);
          ps += pv;
          Ps[(mt * 16 + lq * 4 + r) * 72 + nt * 16 + l15] = f2bf(pv);
        }
        lrow[mt][r] = lrow[mt][r] * alpha + ps;
#pragma unroll
        for (int dt = 0; dt < 4; ++dt) oacc[mt][dt][r] *= alpha;
      }
    __syncthreads();
#pragma unroll
    for (int ks = 0; ks < 2; ++ks) {
      bf16x8 pf[2], vf[4];
#pragma unroll
      for (int mt = 0; mt < 2; ++mt) pf[mt] = *(const bf16x8*)(Ps + (mt * 16 + l15) * 72 + ks * 32 + lq * 8);
#pragma unroll
      for (int dt = 0; dt < 4; ++dt) vf[dt] = *(const bf16x8*)(Vts + (dt * 16 + l15) * 72 + ks * 32 + lq * 8);
#pragma unroll
      for (int mt = 0; mt < 2; ++mt)
#pragma unroll
        for (int dt = 0; dt < 4; ++dt) oacc[mt][dt] = mfma16(pf[mt], vf[dt], oacc[mt][dt]);
    }
    __syncthreads();
  }
#pragma unroll
  for (int mt = 0; mt < 2; ++mt)
#pragma unroll
    for (int r = 0; r < 4; ++r) {
      float l = lrow[mt][r];
      l += __shfl_xor(l, 1); l += __shfl_xor(l, 2); l += __shfl_xor(l, 4); l += __shfl_xor(l, 8);
      const float inv = 1.f / l;
      bf16_t* orow = O + (long)(w * 32 + mt * 16 + lq * 4 + r) * ldo;
#pragma unroll
      for (int dt = 0; dt < 4; ++dt) orow[dt * 16 + l15] = f2bf(oacc[mt][dt][r] * inv);
    }
}

__device__ __forceinline__ void ssd_item(const Ctx& c, int b, int h) {
  char* ws = c.ws; char* smem = c.smem; const int bid = c.bid, nblk = c.nblk; (void)smem; (void)bid; (void)nblk;
  const int t = c.tid, lane = t & 63, w = t >> 6, l15 = lane & 15, lq = lane >> 4;
  const int g = h >> 2;
  bf16_t* Cl = (bf16_t*)smem;
  bf16_t* Bl = Cl + 64 * 136;
  bf16_t* Sl = Bl + 64 * 136;
  bf16_t* Xl = Sl + 64 * 136;
  bf16_t* Ml = Xl + 64 * 72;
  float* fa = (float*)(Ml + 64 * 72);
  const bf16_t* xc = (const bf16_t*)(ws + OFF_R4);
  const bf16_t* proj = (const bf16_t*)(ws + OFF_R2);
  const float* dtp = (const float*)(ws + OFF_DT);
  bf16_t* AY = (bf16_t*)(ws + OFF_R1);
  const float a_h = -__expf(INP(I_A_LOG)[h]);
  const float dsk = INP(I_D_SKIP)[h];
  f32x4 st[8];
#pragma unroll
  for (int i = 0; i < 8; ++i) st[i] = (f32x4){0.f, 0.f, 0.f, 0.f};
  for (int ck = 0; ck < 64; ++ck) {
    const long t0 = (long)b * 4096 + ck * 64;
#pragma unroll
    for (int i = 0; i < 4; ++i) {
      const int ch = t + 256 * i, r = ch >> 4, cc = ch & 15;
      *(uint4*)(Cl + r * 136 + cc * 8) = *(const uint4*)(xc + (t0 + r) * 1024 + 768 + g * 128 + cc * 8);
      *(uint4*)(Bl + r * 136 + cc * 8) = *(const uint4*)(xc + (t0 + r) * 1024 + 512 + g * 128 + cc * 8);
    }
#pragma unroll
    for (int i = 0; i < 2; ++i) {
      const int ch = t + 256 * i, r = ch >> 3, cc = ch & 7;
      const uint4 u = *(const uint4*)(xc + (t0 + r) * 1024 + h * 64 + cc * 8);
      const float d = dtp[(t0 + r) * 8 + h];
      *(uint4*)(Xl + r * 72 + cc * 8) = make_uint4(pack2(bflo(u.x) * d, bfhi(u.x) * d), pack2(bflo(u.y) * d, bfhi(u.y) * d),
                                                   pack2(bflo(u.z) * d, bfhi(u.z) * d), pack2(bflo(u.w) * d, bfhi(u.w) * d));
    }
    if (w == 0) {
      float a = dtp[(t0 + lane) * 8 + h] * a_h;
#pragma unroll
      for (int o = 1; o < 64; o <<= 1) { const float n = __shfl_up(a, o); if (lane >= o) a += n; }
      const float alast = __shfl(a, 63);
      fa[lane] = a; fa[64 + lane] = __expf(a); fa[128 + lane] = __expf(alast - a);
    }
#pragma unroll
    for (int nt = 0; nt < 8; ++nt)
#pragma unroll
      for (int r = 0; r < 4; ++r) Sl[(w * 16 + lq * 4 + r) * 136 + nt * 16 + l15] = f2bf(st[nt][r]);
    __syncthreads();
    bf16x8 cf[4];
#pragma unroll
    for (int ks = 0; ks < 4; ++ks) cf[ks] = *(const bf16x8*)(Cl + (w * 16 + l15) * 136 + ks * 32 + lq * 8);
    f32x4 yacc[4];
#pragma unroll
    for (int pt = 0; pt < 4; ++pt) {
      yacc[pt] = (f32x4){0.f, 0.f, 0.f, 0.f};
#pragma unroll
      for (int ks = 0; ks < 4; ++ks) {
        const bf16x8 sf = *(const bf16x8*)(Sl + (pt * 16 + l15) * 136 + ks * 32 + lq * 8);
        yacc[pt] = mfma16(cf[ks], sf, yacc[pt]);
      }
#pragma unroll
      for (int r = 0; r < 4; ++r) yacc[pt][r] *= fa[64 + w * 16 + lq * 4 + r];
    }
#pragma unroll
    for (int stl = 0; stl < 4; ++stl) {
      f32x4 gacc = (f32x4){0.f, 0.f, 0.f, 0.f};
      if (stl <= w) {
#pragma unroll
        for (int ks = 0; ks < 4; ++ks) {
          const bf16x8 bfv = *(const bf16x8*)(Bl + (stl * 16 + l15) * 136 + ks * 32 + lq * 8);
          gacc = mfma16(cf[ks], bfv, gacc);
        }
      }
#pragma unroll
      for (int r = 0; r < 4; ++r) {
        const int tt = w * 16 + lq * 4 + r, ss = stl * 16 + l15;
        float m = 0.f;
        if (ss <= tt) m = gacc[r] * __expf(fa[tt] - fa[ss]);
        Ml[tt * 72 + ss] = f2bf(m);
      }
    }
    __syncthreads();
#pragma unroll
    for (int ks = 0; ks < 2; ++ks) {
      const bf16x8 mf = *(const bf16x8*)(Ml + (w * 16 + l15) * 72 + ks * 32 + lq * 8);
#pragma unroll
      for (int pt = 0; pt < 4; ++pt) {
        bf16x8 xf;
#pragma unroll
        for (int j = 0; j < 8; ++j) xf[j] = (short)Xl[(ks * 32 + lq * 8 + j) * 72 + pt * 16 + l15];
        yacc[pt] = mfma16(mf, xf, yacc[pt]);
      }
    }
#pragma unroll
    for (int pt = 0; pt < 4; ++pt)
#pragma unroll
      for (int r = 0; r < 4; ++r) {
        const long tok = t0 + w * 16 + lq * 4 + r;
        const int pp = pt * 16 + l15;
        const float xv = bf2f(xc[tok * 1024 + h * 64 + pp]);
        const float zv = bf2f(proj[tok * PROJ_LD + C_Z + h * 64 + pp]);
        const float yv = (yacc[pt][r] + xv * dsk) * silu_f(zv);
        AY[tok * 1024 + 512 + h * 64 + pp] = f2bf(yv);
      }
    {
      const float dec = fa[64 + 63];
#pragma unroll
      for (int nt = 0; nt < 8; ++nt)
#pragma unroll
        for (int r = 0; r < 4; ++r) st[nt][r] *= dec;
#pragma unroll
      for (int ks = 0; ks < 2; ++ks) {
        bf16x8 xf;
#pragma unroll
        for (int j = 0; j < 8; ++j) {
          const int s = ks * 32 + lq * 8 + j;
          xf[j] = (short)f2bf(bf2f(Xl[s * 72 + w * 16 + l15]) * fa[128 + s]);
        }
#pragma unroll
        for (int nt = 0; nt < 8; ++nt) {
          bf16x8 bfv;
#pragma unroll
          for (int j = 0; j < 8; ++j) bfv[j] = (short)Bl[(ks * 32 + lq * 8 + j) * 136 + nt * 16 + l15];
          st[nt] = mfma16(xf, bfv, st[nt]);
        }
      }
    }
    __syncthreads();
  }
}

__device__ __forceinline__ void phase_mix(const Ctx& c0) {
  int* sitem = (int*)(c0.smem + SMEM_MAIN);
  int* qctr = (int*)(c0.ws + OFF_CTL) + CTL_QCTR;
  const int n_items = 128 + 4096;
  for (;;) {
    int tid = c0.tid; asm volatile("" : "+v"(tid));
    char* ws = c0.ws; asm volatile("" : "+s"(ws));
    const Ctx c{c0.p, ws, c0.smem, tid, c0.bid, c0.nblk};
    char* smem = c.smem;
    if (tid == 0) *sitem = atomicAdd(qctr, 1);
    __syncthreads();
    const int item = *sitem;
    __syncthreads();
    if (item >= n_items) break;
#ifndef TEST_NO_SSD
    if (item < 128) {
      ssd_item(c, item >> 3, item & 7);
    } else
#endif
    {
#ifndef TEST_NO_ATTN
      const int it = item - 128;
      const int qb = 31 - (it >> 7), bh = it & 127;
      const bf16_t* Q = (const bf16_t*)(ws + OFF_Q) + ((long)bh * 4096 + qb * 128) * 96;
      const bf16_t* K = (const bf16_t*)(ws + OFF_K) + (long)bh * 4096 * 96;
      const bf16_t* Vt = (const bf16_t*)(ws + OFF_VT) + (long)bh * 64 * 4096;
      const int b = bh >> 3, h = bh & 7;
      bf16_t* O = (bf16_t*)(ws + OFF_R1) + ((long)b * 4096 + qb * 128) * 1024 + h * 64;
      attn_block<96, true>(Q, 96, K, 96, Vt, 4096, 2 * qb + 2, qb * 128, O, 1024, smem, c.tid);
#endif
    }
  }
}

__device__ __forceinline__ void phase_ynorm(const Ctx& c) {
  bf16_t* AY = (bf16_t*)(c.ws + OFF_R1);
  const int bid = c.bid, nblk = c.nblk;
  const int lane = c.tid & 63;
  const int gw = bid * 4 + (c.tid >> 6), nw = nblk * 4;
  for (int row = gw; row < NT; row += nw) {
    bf16_t* ptr = AY + (long)row * 1024 + 512 + lane * 8;
    const uint4 u = *(const uint4*)ptr;
    float v[8] = {bflo(u.x), bfhi(u.x), bflo(u.y), bfhi(u.y), bflo(u.z), bfhi(u.z), bflo(u.w), bfhi(u.w)};
    float ss = 0.f;
#pragma unroll
    for (int j = 0; j < 8; ++j) ss += v[j] * v[j];
    ss = wave_sum(ss);
    const float r = rsqrtf(ss * (1.f / 512.f) + EPS);
    *(uint4*)ptr = make_uint4(pack2(v[0] * r, v[1] * r), pack2(v[2] * r, v[3] * r), pack2(v[4] * r, v[5] * r), pack2(v[6] * r, v[7] * r));
  }
}

template <int MODE>
__device__ __forceinline__ void epi_residual(const Ctx& c, const float* Cs, int mt, int nt, float* ssq) {
  const int t = c.tid, er = t >> 1, eh = t & 1;
  const int row = mt * 128 + er, col = nt * 128 + eh * 64;
  const float* base = (MODE == 0 ? INP(I_X) : c.p.out) + (long)row * 1024 + col;
  float* o = c.p.out + (long)row * 1024 + col;
  bf16_t* xcb = (bf16_t*)(c.ws + OFF_XCB) + (long)row * 1024 + col;
  float ss = 0.f;
#pragma unroll
  for (int j = 0; j < 64; j += 8) {
    float v[8];
    const float4 b0 = *(const float4*)(base + j), b1 = *(const float4*)(base + j + 4);
    const float bb[8] = {b0.x, b0.y, b0.z, b0.w, b1.x, b1.y, b1.z, b1.w};
#pragma unroll
    for (int i = 0; i < 8; ++i) {
      float a = Cs[er * CS_LD + eh * 64 + j + i];
      if (MODE == 2) a = (a + INP(I_POOL_B)[col + j + i]) * INP(I_POOL_SCALE)[col + j + i];
      v[i] = bb[i] + a;
      ss += v[i] * v[i];
    }
    *(float4*)(o + j) = make_float4(v[0], v[1], v[2], v[3]);
    *(float4*)(o + j + 4) = make_float4(v[4], v[5], v[6], v[7]);
    *(uint4*)(xcb + j) = make_uint4(pack2(v[0], v[1]), pack2(v[2], v[3]), pack2(v[4], v[5]), pack2(v[6], v[7]));
  }
  ss += __shfl_xor(ss, 1);
  if (eh == 0) ssq[row * 8 + nt] = ss;
}

__device__ __forceinline__ void phase_gemm_out(const Ctx& c) {
  char* ws = c.ws; char* smem = c.smem; const int bid = c.bid, nblk = c.nblk; (void)smem; (void)bid; (void)nblk;
  for (int item = bid; item < 512 * 8; item += nblk) {
    const int mt = item >> 3, nt = item & 7;
    gemm_dense((const bf16_t*)(ws + OFF_R1) + (long)mt * 128 * 1024, 1024, (const bf16_t*)(ws + OFF_WOUT_T) + (long)nt * 128 * 1024, 1024, 1024, smem, c.tid);
    epi_residual<0>(c, (const float*)smem, mt, nt, (float*)(ws + OFF_SSQA));
    __syncthreads();
  }
}

__device__ __forceinline__ void phase_pool_gemm(const Ctx& c) {
  char* ws = c.ws; char* smem = c.smem; const int bid = c.bid, nblk = c.nblk; (void)smem; (void)bid; (void)nblk;
  for (int item = bid; item < 512 * 8; item += nblk) {
    const int mt = item >> 3, nt = item & 7, g = nt >> 1;
    gemm_dense((const bf16_t*)(ws + OFF_R1) + (long)mt * 128 * 1024 + g * 256, 1024,
               (const bf16_t*)(ws + OFF_POOL_T) + (long)g * 65536 + (long)(nt & 1) * 128 * 256, 256, 256, smem, c.tid);
    epi_residual<2>(c, (const float*)smem, mt, nt, (float*)(ws + OFF_SSQA));
    __syncthreads();
  }
}

__device__ __forceinline__ void phase_xq(const Ctx& c, int l) {
  char* ws = c.ws; char* smem = c.smem; const int bid = c.bid, nblk = c.nblk; (void)smem; (void)bid; (void)nblk;
  const int t = c.tid, er = t >> 1, eh = t & 1;
  const float* Cs = (const float*)smem;
  for (int item = bid; item < 512 * 2; item += nblk) {
    const int mt = item >> 1, nt = item & 1;
    gemm_dense((const bf16_t*)(ws + OFF_XCB) + (long)mt * 128 * 1024, 1024,
               (const bf16_t*)(ws + OFF_XQ_T) + (long)l * 256 * 1024 + (long)nt * 128 * 1024, 1024, 1024, smem, c.tid);
    const int row = mt * 128 + er;
    const float* sq = (const float*)(ws + OFF_SSQA) + row * 8;
    const float rs = rsqrtf((sq[0] + sq[1] + sq[2] + sq[3] + sq[4] + sq[5] + sq[6] + sq[7]) * (1.f / 1024.f) + EPS);
    const float* crow = Cs + er * CS_LD + eh * 64;
    const float ss = cs_ssq(crow, 64) * rs * rs;
    const float r = rsqrtf(ss * (1.f / 64.f) + EPS) * rs * (0.125f * LOG2E);
    const float* g = INP(I_XQ_NORM) + l * 64;
    cs_store_scaled((bf16_t*)(ws + OFF_XQ) + (long)row * 256 + (nt * 2 + eh) * 64, crow, 64, r, g);
    __syncthreads();
  }
}

__device__ __forceinline__ void phase_xattn(const Ctx& c, int l) {
  char* ws = c.ws; char* smem = c.smem; const int bid = c.bid, nblk = c.nblk; (void)smem; (void)bid; (void)nblk;
  for (int item = bid; item < 512 * 4; item += nblk) {
    const int mt = item >> 2, h = item & 3;
    const int b = mt >> 5;
    const bf16_t* Q = (const bf16_t*)(ws + OFF_XQ) + (long)mt * 128 * 256 + h * 64;
    const bf16_t* K = (const bf16_t*)(ws + OFF_MEMK) + (long)l * 4096 * 256 + (long)b * 256 * 256 + h * 64;
    const bf16_t* Vt = (const bf16_t*)(ws + OFF_MEMVT) + (long)l * 4096 * 256 + (long)(b * 4 + h) * 64 * 256;
    bf16_t* O = (bf16_t*)(ws + OFF_XO) + (long)mt * 128 * 256 + h * 64;
    attn_block<64, false>(Q, 256, K, 256, Vt, 256, 4, 0, O, 256, smem, c.tid);
  }
}

__device__ __forceinline__ void phase_xo(const Ctx& c, int l) {
  char* ws = c.ws; char* smem = c.smem; const int bid = c.bid, nblk = c.nblk; (void)smem; (void)bid; (void)nblk;
  for (int item = bid; item < 512 * 8; item += nblk) {
    const int mt = item >> 3, nt = item & 7;
    gemm_dense((const bf16_t*)(ws + OFF_XO) + (long)mt * 128 * 256, 256,
               (const bf16_t*)(ws + OFF_XO_T) + (long)l * 1024 * 256 + (long)nt * 128 * 256, 256, 256, smem, c.tid);
    epi_residual<1>(c, (const float*)smem, mt, nt, (float*)(ws + OFF_SSQB));
    __syncthreads();
  }
}

__device__ __forceinline__ void phase_router(const Ctx& c, int l) {
  char* ws = c.ws; char* smem = c.smem; const int bid = c.bid, nblk = c.nblk; (void)smem; (void)bid; (void)nblk;
  const int t = c.tid;
  float* hs = (float*)smem;
  float* wsl = hs + 64 * 65;
  float* lg = wsl + 64 * 36;
  const float* lnf = INP(I_LN_FFN) + l * 1024;
  const float* rgw = INP(I_RG_W) + l * 1024 * 4;
  const float* rew = INP(I_RE_W) + l * 1024 * 32;
  int* cnt = (int*)(ws + OFF_CTL) + CTL_CNT + l * 32;
  int* list = (int*)(ws + OFF_LIST);
  float* gate = (float*)(ws + OFF_GATE);
  for (int item = bid; item < NT / 64; item += nblk) {
    const int tok0 = item * 64;
    const int tk = t >> 2, q = t & 3;
    float acc[9];
#pragma unroll
    for (int j = 0; j < 9; ++j) acc[j] = 0.f;
    for (int kc = 0; kc < 16; ++kc) {
#pragma unroll
      for (int i = 0; i < 4; ++i) {
        const int r = (t >> 4) + 16 * i, cc = (t & 15) * 4;
        const int row = tok0 + r;
        const float* sq = (const float*)(ws + OFF_SSQB) + row * 8;
        const float rs = rsqrtf((sq[0] + sq[1] + sq[2] + sq[3] + sq[4] + sq[5] + sq[6] + sq[7]) * (1.f / 1024.f) + EPS);
        const float4 v = *(const float4*)(c.p.out + (long)row * 1024 + kc * 64 + cc);
        const float4 gn = *(const float4*)(lnf + kc * 64 + cc);
        hs[r * 65 + cc] = v.x * rs * gn.x; hs[r * 65 + cc + 1] = v.y * rs * gn.y; hs[r * 65 + cc + 2] = v.z * rs * gn.z; hs[r * 65 + cc + 3] = v.w * rs * gn.w;
      }
      for (int i = t; i < 64 * 36; i += 256) {
        const int d = i / 36, o = i % 36;
        wsl[i] = (o < 4) ? rgw[(kc * 64 + d) * 4 + o] : rew[(kc * 64 + d) * 32 + (o - 4)];
      }
      __syncthreads();
      for (int d = 0; d < 64; ++d) {
        const float hv = hs[tk * 65 + d];
#pragma unroll
        for (int j = 0; j < 9; ++j) acc[j] += hv * wsl[d * 36 + q * 9 + j];
      }
      __syncthreads();
    }
#pragma unroll
    for (int j = 0; j < 9; ++j) lg[tk * 36 + q * 9 + j] = acc[j];
    __syncthreads();
    if (q == 0) {
      const int tok = tok0 + tk;
      const float* L = lg + tk * 36;
      float gl[4];
#pragma unroll
      for (int i = 0; i < 4; ++i) gl[i] = L[i] + INP(I_RG_B)[l * 4 + i];
      int gi = 0; float gm = gl[0];
#pragma unroll
      for (int i = 1; i < 4; ++i) if (gl[i] > gm) { gm = gl[i]; gi = i; }
      float gsum = 0.f;
#pragma unroll
      for (int i = 0; i < 4; ++i) gsum += __expf(gl[i] - gm);
      const float gp = 1.f / gsum;
      float e0 = -3e38f, e1 = -3e38f; int i0 = 0, i1 = 0;
      for (int j = 0; j < 8; ++j) {
        const float v = L[4 + gi * 8 + j] + INP(I_RE_B)[l * 32 + gi * 8 + j];
        if (v > e0) { e1 = e0; i1 = i0; e0 = v; i0 = j; }
        else if (v > e1) { e1 = v; i1 = j; }
      }
      const float p1 = __expf(e1 - e0);
      const float g0 = gp / (1.f + p1), g1 = gp * p1 / (1.f + p1);
      const int x0 = gi * 8 + i0, x1 = gi * 8 + i1;
      const int pos0 = atomicAdd(&cnt[x0], 1);
      list[x0 * 65536 + pos0] = tok * 2;
      const int pos1 = atomicAdd(&cnt[x1], 1);
      list[x1 * 65536 + pos1] = tok * 2 + 1;
      gate[tok * 2] = g0; gate[tok * 2 + 1] = g1;
    }
    __syncthreads();
  }
}

__device__ __forceinline__ int expert_prefix(const int* cnt, int* pre, int tid) {
  if (tid == 0) {
    int s = 0;
    for (int e = 0; e < 32; ++e) { pre[e] = s; s += (cnt[e] + 127) >> 7; }
    pre[32] = s;
  }
  __syncthreads();
  return pre[32];
}

template <int WHICH>
__device__ __forceinline__ void phase_expert(const Ctx& c, int l) {
  char* ws = c.ws; char* smem = c.smem; const int bid = c.bid, nblk = c.nblk; (void)smem; (void)bid; (void)nblk;
  const int t = c.tid, er = t >> 1, eh = t & 1;
  const float* Cs = (const float*)smem;
  int* pre = (int*)(smem + SMEM_MAIN + 16);
  const int* cnt = (const int*)(ws + OFF_CTL) + CTL_CNT + l * 32;
  const int* list = (const int*)(ws + OFF_LIST);
  const float* gate = (const float*)(ws + OFF_GATE);
  const int ttiles = expert_prefix(cnt, pre, c.tid);
  constexpr int NNT = WHICH == 0 ? 4 : 8;
  const int srow = t >> 3, scol = (t & 7) * 8;
  for (int item = bid; item < ttiles * NNT; item += nblk) {
    const int tile = item / NNT, nt = item % NNT;
    int e = 0;
    for (int i = 1; i < 32; ++i) if (pre[i] <= tile) e = i;
    const int ce = cnt[e];
    const int pos0 = (tile - pre[e]) * 128;
    const int nvalid = min(128, ce - pos0);
    const bf16_t* ap[4]; const bf16_t* bp[4];
#pragma unroll
    for (int i = 0; i < 4; ++i) {
      const int r = srow + 32 * i;
      const int pair = list[e * 65536 + pos0 + min(r, nvalid - 1)];
      if (WHICH == 0) {
        ap[i] = (const bf16_t*)(ws + OFF_XCB) + (long)(pair >> 1) * 1024 + scol;
        bp[i] = (const bf16_t*)(ws + OFF_WGU_T) + ((long)(l * 32 + e) * 512 + nt * 128 + r) * 1024 + scol;
      } else {
        ap[i] = (const bf16_t*)(ws + OFF_HBUF) + (long)pair * 256 + scol;
        bp[i] = (const bf16_t*)(ws + OFF_WD_T) + ((long)(l * 32 + e) * 1024 + nt * 128 + r) * 256 + scol;
      }
    }
    gemm_core(ap, bp, WHICH == 0 ? 1024 : 256, smem, c.tid);
    if (er < nvalid) {
      const int pair = list[e * 65536 + pos0 + er];
      if (WHICH == 0) {
        const int tok = pair >> 1;
        const float* sq = (const float*)(ws + OFF_SSQB) + tok * 8;
        const float rs = rsqrtf((sq[0] + sq[1] + sq[2] + sq[3] + sq[4] + sq[5] + sq[6] + sq[7]) * (1.f / 1024.f) + EPS);
        bf16_t* dst = (bf16_t*)(ws + OFF_HBUF) + (long)pair * 256 + nt * 64 + eh * 32;
        const float* cg_ = Cs + er * CS_LD + eh * 32;
        for (int j = 0; j < 32; j += 8) {
          float v[8];
#pragma unroll
          for (int i = 0; i < 8; ++i) v[i] = silu_f(cg_[j + i] * rs) * (cg_[64 + j + i] * rs);
          *(uint4*)(dst + j) = make_uint4(pack2(v[0], v[1]), pack2(v[2], v[3]), pack2(v[4], v[5]), pack2(v[6], v[7]));
        }
      } else {
        cs_store_scaled((bf16_t*)(ws + OFF_R2) + (long)pair * 1024 + nt * 128 + eh * 64, Cs + er * CS_LD + eh * 64, 64, gate[pair], nullptr);
      }
    }
    __syncthreads();
  }
}

__device__ __forceinline__ void phase_combine(const Ctx& c, int l) {
  char* ws = c.ws; char* smem = c.smem; const int bid = c.bid, nblk = c.nblk; (void)smem; (void)bid; (void)nblk;
  const int lane = c.tid & 63;
  const int gw = bid * 4 + (c.tid >> 6), nw = nblk * 4;
  const bf16_t* yb = (const bf16_t*)(ws + OFF_R2);
  bf16_t* xnb = (bf16_t*)(ws + OFF_R4);
  for (int row = gw; row < NT; row += nw) {
    float* o = c.p.out + (long)row * 1024;
    float v[16]; float ss = 0.f;
#pragma unroll
    for (int i = 0; i < 4; ++i) {
      const int cc = i * 256 + lane * 4;
      float4 x = *(const float4*)(o + cc);
      const uint2 a = *(const uint2*)(yb + (long)(row * 2) * 1024 + cc), b2 = *(const uint2*)(yb + (long)(row * 2 + 1) * 1024 + cc);
      x.x += bflo(a.x) + bflo(b2.x); x.y += bfhi(a.x) + bfhi(b2.x); x.z += bflo(a.y) + bflo(b2.y); x.w += bfhi(a.y) + bfhi(b2.y);
      *(float4*)(o + cc) = x;
      v[i * 4] = x.x; v[i * 4 + 1] = x.y; v[i * 4 + 2] = x.z; v[i * 4 + 3] = x.w;
      ss += x.x * x.x + x.y * x.y + x.z * x.z + x.w * x.w;
    }
    if (l == 0) {
      ss = wave_sum(ss);
      const float r = rsqrtf(ss * (1.f / 1024.f) + EPS);
#pragma unroll
      for (int i = 0; i < 4; ++i)
        *(uint2*)(xnb + (long)row * 1024 + i * 256 + lane * 4) = make_uint2(pack2(v[i * 4] * r, v[i * 4 + 1] * r), pack2(v[i * 4 + 2] * r, v[i * 4 + 3] * r));
    }
  }
}

__device__ __forceinline__ void phase_pool_dlt(const Ctx& c) {
  char* ws = c.ws; char* smem = c.smem; const int bid = c.bid, nblk = c.nblk; (void)smem; (void)bid; (void)nblk;
  const bf16_t* xnb = (const bf16_t*)(ws + OFF_R4);
  bf16_t* dl = (bf16_t*)(ws + OFF_R1);
  const long gt = (long)bid * 256 + c.tid, gn = (long)nblk * 256;
  for (long i = gt; i < (long)NT * 128; i += gn) {
    const int tok = (int)(i >> 7), ch = (int)(i & 127) * 8;
    const int s = tok & 4095;
    const int wnd = 2 << (ch >> 8);
    const int n = min(s + 1, wnd);
    float a[8] = {0.f, 0.f, 0.f, 0.f, 0.f, 0.f, 0.f, 0.f};
    float self[8];
    for (int k = 0; k < n; ++k) {
      const uint4 u = *(const uint4*)(xnb + (long)(tok - k) * 1024 + ch);
      const float f[8] = {bflo(u.x), bfhi(u.x), bflo(u.y), bfhi(u.y), bflo(u.z), bfhi(u.z), bflo(u.w), bfhi(u.w)};
#pragma unroll
      for (int j = 0; j < 8; ++j) { a[j] += f[j]; if (k == 0) self[j] = f[j]; }
    }
    const float inv = 1.f / (float)n;
#pragma unroll
    for (int j = 0; j < 8; ++j) a[j] = a[j] * inv - self[j];
    *(uint4*)(dl + (long)tok * 1024 + ch) = make_uint4(pack2(a[0], a[1]), pack2(a[2], a[3]), pack2(a[4], a[5]), pack2(a[6], a[7]));
  }
}

constexpr int N_PHASES = 22;
__device__ __forceinline__ void run_phase(const Params& p, char* smem, int ph) {
  int tid = threadIdx.x; asm volatile("" : "+v"(tid));
  char* ws = p.ws; asm volatile("" : "+s"(ws));
  int bid = blockIdx.x; asm volatile("" : "+s"(bid));
  int nblk = gridDim.x; asm volatile("" : "+s"(nblk));
  const Ctx c{p, ws, smem, tid, bid, nblk};
  switch (ph) {
    case 0: phase_prep(c); break;
    case 1: phase_gemm_in(c); break;
    case 2: phase_up(c); break;
    case 3: phase_mix(c); break;
    case 4: phase_ynorm(c); break;
    case 5: phase_gemm_out(c); break;
    case 6: case 15: phase_xq(c, ph == 15); break;
    case 7: case 16: phase_xattn(c, ph == 16); break;
    case 8: case 17: phase_xo(c, ph == 17); break;
    case 9: case 18: phase_router(c, ph == 18); break;
    case 10: case 19: phase_expert<0>(c, ph == 19); break;
    case 11: case 20: phase_expert<1>(c, ph == 20); break;
    case 12: case 21: phase_combine(c, ph == 21); break;
    case 13: phase_pool_dlt(c); break;
    case 14: phase_pool_gemm(c); break;
    default: break;
  }
}

#ifdef PHASE_KERNELS
template <int PH> __global__ void __launch_bounds__(256, 2) phase_kernel(Params p) {
  __shared__ __attribute__((aligned(16))) char smem[SMEM_BYTES];
  run_phase(p, smem, PH);
}
template __global__ void phase_kernel<0>(Params);
template __global__ void phase_kernel<1>(Params);
template __global__ void phase_kernel<2>(Params);
template __global__ void phase_kernel<3>(Params);
template __global__ void phase_kernel<4>(Params);
template __global__ void phase_kernel<5>(Params);
template __global__ void phase_kernel<6>(Params);
template __global__ void phase_kernel<7>(Params);
template __global__ void phase_kernel<8>(Params);
template __global__ void phase_kernel<9>(Params);
template __global__ void phase_kernel<10>(Params);
template __global__ void phase_kernel<11>(Params);
template __global__ void phase_kernel<12>(Params);
template __global__ void phase_kernel<13>(Params);
template __global__ void phase_kernel<14>(Params);
#endif

__global__ void __launch_bounds__(256, 2) fwd_megakernel(Params p) {
  __shared__ __attribute__((aligned(16))) char smem[SMEM_BYTES];
#if MULTI_LAUNCH
  for (int ph = p.phase_lo; ph < p.phase_hi; ++ph) run_phase(p, smem, ph);
#else
  cg::grid_group grid = cg::this_grid();
  for (int ph = p.phase_lo; ph < p.phase_hi; ++ph) {
    run_phase(p, smem, ph);
    if (ph + 1 < p.phase_hi) grid.sync();
  }
#endif
}

extern "C" void kernel_launch(void* const* d_in, const int* in_sizes, int n_in, void* d_out,
                              int out_size, void* d_ws, size_t ws_size, hipStream_t stream) {
  static int grid_blocks = 0;
  if (!grid_blocks) {
    int dev = 0, cus = 0, per_cu = 0;
    (void)hipGetDevice(&dev);
    (void)hipDeviceGetAttribute(&cus, hipDeviceAttributeMultiprocessorCount, dev);
    (void)hipOccupancyMaxActiveBlocksPerMultiprocessor(&per_cu, fwd_megakernel, 256, 0);
    if (per_cu > 2) per_cu = 2;
    if (per_cu < 1) per_cu = 1;
    grid_blocks = cus * per_cu;
    if (ws_size < WS_END) { fprintf(stderr, "workspace too small: %zu < %zu\n", ws_size, (size_t)WS_END); grid_blocks = -1; }
    if (n_in != N_IN) { fprintf(stderr, "unexpected n_in %d\n", n_in); grid_blocks = -1; }
  }
  if (grid_blocks < 0) return;
  Params p{};
  for (int i = 0; i < N_IN; ++i) p.in[i] = d_in[i];
  p.out = (float*)d_out;
  p.ws = (char*)d_ws;
#if MULTI_LAUNCH
  for (int ph = 0; ph < N_PHASES; ++ph) {
    p.phase_lo = ph; p.phase_hi = ph + 1;
    hipLaunchKernelGGL(fwd_megakernel, dim3(grid_blocks), dim3(256), 0, stream, p);
  }
#else
  p.phase_lo = 0; p.phase_hi = N_PHASES;
  void* args[] = {&p};
  hipError_t e = hipLaunchCooperativeKernel((void*)fwd_megakernel, dim3(grid_blocks), dim3(256), args, 0, stream);
  if (e != hipSuccess) fprintf(stderr, "cooperative launch failed: %s (grid %d)\n", hipGetErrorString(e), grid_blocks);
#endif
}
```

```cpp
#include <hip/hip_runtime.h>
#include <hip/hip_cooperative_groups.h>
#include <cstdio>
#include <cstdint>
namespace cg = cooperative_groups;

#ifndef MULTI_LAUNCH
#define MULTI_LAUNCH 0
#endif

typedef unsigned short bf16_t;
typedef short bf16x8 __attribute__((ext_vector_type(8)));
typedef float f32x4 __attribute__((ext_vector_type(4)));
typedef unsigned u32x4 __attribute__((ext_vector_type(4)));

constexpr int NT = 65536, DM = 1024, SEQ = 4096, NB = 16;
constexpr int NTHR = 512, NWAV = 8;
constexpr int PROJ_LD = 2048;
constexpr int C_QLAT = 0, C_KVLAT = 256, C_KROPE = 384, C_Z = 416, C_XBC = 928, C_DT = 1952;
constexpr float EPS = 1e-6f;
constexpr float LOG2E = 1.4426950408889634f;

enum { I_X = 0, I_MEM, I_POS, I_LN_MIX, I_W_IN, I_QLAT_NORM, I_W_UQ, I_KVLAT_NORM, I_W_UKV, I_Q_NORM, I_K_NORM,
       I_CONV_W, I_CONV_B, I_DT_BIAS, I_A_LOG, I_D_SKIP, I_SSD_NORM, I_W_OUT, I_POOL_W, I_POOL_B, I_POOL_SCALE,
       I_LN_XQ, I_LN_MEM, I_XQ_W, I_XKV_W, I_XQ_NORM, I_XK_NORM, I_XO_W, I_LN_FFN, I_RG_W, I_RG_B, I_RE_W, I_RE_B,
       I_EXP_G, I_EXP_U, I_EXP_D, N_IN };

constexpr size_t MiB = 1ull << 20;
constexpr size_t OFF_WIN_T = 0;
constexpr size_t OFF_WUQ_T = OFF_WIN_T + 2048ull * 1024 * 2;
constexpr size_t OFF_WUKV_T = OFF_WUQ_T + 1024ull * 256 * 2;
constexpr size_t OFF_WOUT_T = OFF_WUKV_T + 1024ull * 128 * 2;
constexpr size_t OFF_POOL_T = OFF_WOUT_T + 1024ull * 1024 * 2;
constexpr size_t OFF_XQ_T = OFF_POOL_T + 4ull * 256 * 256 * 2;
constexpr size_t OFF_XKV_T = OFF_XQ_T + 2ull * 256 * 1024 * 2;
constexpr size_t OFF_XO_T = OFF_XKV_T + 2ull * 512 * 1024 * 2;
constexpr size_t OFF_WGU_T = OFF_XO_T + 2ull * 1024 * 256 * 2;
constexpr size_t OFF_WD_T = OFF_WGU_T + 64ull * 512 * 1024 * 2;
constexpr size_t OFF_R1 = OFF_WD_T + 64ull * 1024 * 256 * 2;
constexpr size_t OFF_R2 = OFF_R1 + 128 * MiB;
constexpr size_t OFF_R3 = OFF_R2 + 256 * MiB;
constexpr size_t OFF_R4 = OFF_R3 + 256 * MiB;
constexpr size_t OFF_MISC = OFF_R4 + 128 * MiB;
constexpr size_t OFF_Q = OFF_R3, OFF_K = OFF_R3 + 96 * MiB, OFF_VT = OFF_R3 + 192 * MiB;
constexpr size_t OFF_XCB = OFF_R3, OFF_XQ = OFF_R3 + 128 * MiB, OFF_XO = OFF_R3 + 160 * MiB, OFF_HBUF = OFF_R3 + 192 * MiB;
constexpr size_t OFF_RS0 = OFF_MISC;
constexpr size_t OFF_SSQ_Q = OFF_RS0 + NT * 4ull;
constexpr size_t OFF_SSQ_KV = OFF_SSQ_Q + NT * 32ull;
constexpr size_t OFF_DTRAW = OFF_SSQ_KV + NT * 16ull;
constexpr size_t OFF_DT = OFF_DTRAW + NT * 32ull;
constexpr size_t OFF_SSQA = OFF_DT + NT * 32ull;
constexpr size_t OFF_SSQB = OFF_SSQA + NT * 128ull;
constexpr size_t OFF_RS3 = OFF_SSQB + NT * 128ull;
constexpr size_t OFF_RS2 = OFF_RS3 + NT * 4ull;
constexpr size_t OFF_MEMB = OFF_RS2 + NT * 4ull;
constexpr size_t OFF_RSM = OFF_MEMB + 4096ull * 1024 * 2;
constexpr size_t OFF_MEMK = OFF_RSM + 4096 * 4ull;
constexpr size_t OFF_MEMVT = OFF_MEMK + 2ull * 4096 * 256 * 2;
constexpr size_t OFF_GATE = OFF_MEMVT + 2ull * 4096 * 256 * 2;
constexpr size_t OFF_LIST = OFF_GATE + NT * 8ull;
constexpr size_t OFF_CTL = OFF_LIST + 32ull * 65536 * 4;
constexpr size_t OFF_BAR = OFF_CTL + 4096;
constexpr size_t WS_END = OFF_BAR + 16384;

constexpr int CTL_CNT = 0;
constexpr int CTL_QCTR = 64;

constexpr int LDS_ST = 72;
constexpr int CS_LD = 132;
constexpr int SMEM_BYTES = 160 * 1024;
constexpr int SMEM_MAIN = SMEM_BYTES - 1024;

struct Params {
  const void* in[N_IN];
  float* out;
  char* ws;
  int phase_lo, phase_hi;
};

#ifndef PROBE_MASK
#define PROBE_MASK 0u
#endif
struct Ctx { const Params& p; char* ws; char* smem; int tid, bid, nblk; float f; int pass; };
__device__ __forceinline__ int opq(int i) { asm volatile("" : "+s"(i)); return i; }
#define INP(i) ((const float*)c.p.in[opq(i)])

__device__ __forceinline__ bf16_t f2bf(float f) {
  unsigned u = __float_as_uint(f);
  u += 0x7fffu + ((u >> 16) & 1u);
  return (bf16_t)(u >> 16);
}
__device__ __forceinline__ float bf2f(bf16_t h) { return __uint_as_float(((unsigned)h) << 16); }
__device__ __forceinline__ unsigned pack2(float lo, float hi) { return (unsigned)f2bf(lo) | ((unsigned)f2bf(hi) << 16); }
__device__ __forceinline__ float bflo(unsigned u) { return __uint_as_float(u << 16); }
__device__ __forceinline__ float bfhi(unsigned u) { return __uint_as_float(u & 0xffff0000u); }
__device__ __forceinline__ float silu_f(float x) { return x / (1.f + __expf(-x)); }
template <int M> __device__ __forceinline__ float sxor(float v) {
  static_assert(M >= 1 && M < 32, "swizzle xor mask");
  return __int_as_float(__builtin_amdgcn_ds_swizzle(__float_as_int(v), (M << 10) | 0x1f));
}
__device__ __forceinline__ float lane_get(float v, int src_lane) { return __int_as_float(__builtin_amdgcn_ds_bpermute(src_lane << 2, __float_as_int(v))); }
__device__ __forceinline__ float wave_sum(float v, int lane) {
  v += sxor<1>(v); v += sxor<2>(v); v += sxor<4>(v); v += sxor<8>(v); v += sxor<16>(v);
  v += lane_get(v, lane ^ 32);
  return v;
}
typedef short s16x4 __attribute__((ext_vector_type(4)));
__device__ __forceinline__ bf16x8 tr_frag(const bf16_t* M, int ld, int k0, int n0, int l15, int lq) {
  const bf16_t* p0 = M + (k0 + 8 * lq + (l15 >> 2)) * ld + n0 + 4 * (l15 & 3);
  const s16x4 a = __builtin_amdgcn_ds_read_tr16_b64_v4i16((__attribute__((address_space(3))) s16x4*)p0);
  const s16x4 b = __builtin_amdgcn_ds_read_tr16_b64_v4i16((__attribute__((address_space(3))) s16x4*)(p0 + 4 * ld));
  return (bf16x8){a[0], a[1], a[2], a[3], b[0], b[1], b[2], b[3]};
}
__device__ __forceinline__ f32x4 zero4() { float z = 0.f; asm volatile("" : "+v"(z)); return (f32x4){z, z, z, z}; }
__device__ __forceinline__ f32x4 mfma16(bf16x8 a, bf16x8 b, f32x4 c) { return __builtin_amdgcn_mfma_f32_16x16x32_bf16(a, b, c, 0, 0, 0); }

__device__ __forceinline__ void gemm_core(const char* Ab, const unsigned (&ao)[2], const char* Bb, const unsigned (&bo)[2], int K, char* smem, int tid) {
  const int t = tid, lane = t & 63, w = t >> 6;
  const int wr = w >> 1, wc = w & 1;
  const int l15 = lane & 15, lq = lane >> 4;
  bf16_t* As = (bf16_t*)smem;
  bf16_t* Bs = As + 2 * 128 * LDS_ST;
  const int srow = t >> 3, scol = (t & 7) * 8;
  const int nk = K >> 6;
  u32x4 ra0[2], rb0[2], ra1[2], rb1[2];
#define G_LOAD(RA, RB, KT) { const unsigned kk_ = (unsigned)((KT) < nk ? (KT) : nk - 1) * 128u; \
    _Pragma("unroll") for (int i = 0; i < 2; ++i) { RA[i] = *(const u32x4*)(Ab + (size_t)(ao[i] + kk_)); RB[i] = *(const u32x4*)(Bb + (size_t)(bo[i] + kk_)); } }
#define G_STORE(RA, RB, ST) { bf16_t* An_ = As + (ST) * 128 * LDS_ST; bf16_t* Bn_ = Bs + (ST) * 128 * LDS_ST; \
    _Pragma("unroll") for (int i = 0; i < 2; ++i) { *(u32x4*)(An_ + (srow + 64 * i) * LDS_ST + scol) = RA[i]; *(u32x4*)(Bn_ + (srow + 64 * i) * LDS_ST + scol) = RB[i]; } }
#define G_COMPUTE(ST) { const bf16_t* Ac = As + (ST) * 128 * LDS_ST; const bf16_t* Bc = Bs + (ST) * 128 * LDS_ST; \
    _Pragma("unroll") for (int ks = 0; ks < 2; ++ks) { bf16x8 af[2], bfr[4]; \
      _Pragma("unroll") for (int mt = 0; mt < 2; ++mt) af[mt] = *(const bf16x8*)(Ac + (wr * 32 + mt * 16 + l15) * LDS_ST + ks * 32 + lq * 8); \
      _Pragma("unroll") for (int nt = 0; nt < 4; ++nt) bfr[nt] = *(const bf16x8*)(Bc + (wc * 64 + nt * 16 + l15) * LDS_ST + ks * 32 + lq * 8); \
      _Pragma("unroll") for (int mt = 0; mt < 2; ++mt) _Pragma("unroll") for (int nt = 0; nt < 4; ++nt) acc[mt][nt] = mfma16(af[mt], bfr[nt], acc[mt][nt]); } }
  G_LOAD(ra0, rb0, 0)
  G_LOAD(ra1, rb1, 1)
  G_STORE(ra0, rb0, 0)
  __syncthreads();
  f32x4 acc[2][4];
#pragma unroll
  for (int i = 0; i < 2; ++i)
#pragma unroll
    for (int j = 0; j < 4; ++j) acc[i][j] = zero4();
  for (int kt = 0; kt < nk; kt += 2) {
    G_LOAD(ra0, rb0, kt + 2)
    __builtin_amdgcn_sched_barrier(0);
    G_COMPUTE(0)
    G_STORE(ra1, rb1, 1)
    __syncthreads();
    G_LOAD(ra1, rb1, kt + 3)
    __builtin_amdgcn_sched_barrier(0);
    G_COMPUTE(1)
    G_STORE(ra0, rb0, 0)
    __syncthreads();
  }
#undef G_LOAD
#undef G_STORE
#undef G_COMPUTE
  float* Cs = (float*)smem;
#pragma unroll
  for (int mt = 0; mt < 2; ++mt)
#pragma unroll
    for (int nt = 0; nt < 4; ++nt)
#pragma unroll
      for (int r = 0; r < 4; ++r)
        Cs[(wr * 32 + mt * 16 + lq * 4 + r) * CS_LD + wc * 64 + nt * 16 + l15] = acc[mt][nt][r];
  __syncthreads();
}

__device__ __forceinline__ void gemm_dense(const bf16_t* A, long lda, const bf16_t* Bt, long ldb, int K, char* smem, int tid) {
  const int t = tid;
  const int srow = t >> 3, scol = (t & 7) * 8;
  unsigned ao[2], bo[2];
#pragma unroll
  for (int i = 0; i < 2; ++i) { ao[i] = (unsigned)(((srow + 64 * i) * lda + scol) * 2); bo[i] = (unsigned)(((srow + 64 * i) * ldb + scol) * 2); }
  gemm_core((const char*)A, ao, (const char*)Bt, bo, K, smem, tid);
}

template <int N>
__device__ __forceinline__ void store_bf16_row(bf16_t* dst, const float (&v)[N]) {
#pragma unroll
  for (int j = 0; j < N; j += 8) {
    uint4 u;
    u.x = pack2(v[j], v[j + 1]); u.y = pack2(v[j + 2], v[j + 3]); u.z = pack2(v[j + 4], v[j + 5]); u.w = pack2(v[j + 6], v[j + 7]);
    *(uint4*)(dst + j) = u;
  }
}


#define LAS3 __attribute__((address_space(3)))
constexpr int FG_HTB = 128 * 64 * 2;
__device__ __forceinline__ int fg_lds_byte(int r, int c) { const int st = (r >> 4) * 2 + (c >> 5), rr = r & 15, cc = c & 31, ob = rr * 64 + cc * 2; return st * 1024 + (ob ^ (((ob >> 9) & 1) << 5)); }
__device__ __forceinline__ void fg_stage_rc(int b, int& R, int& C) { const int st = b / 1024, sb = b % 1024, swz = sb ^ (((sb >> 9) & 1) << 5); R = (st >> 1) * 16 + swz / 64; C = (st & 1) * 32 + (swz % 64) / 2; }
__device__ __forceinline__ int fg_perm32(int rho) { const int n = rho >> 4, i = rho & 15; return 8 * (i >> 2) + 4 * n + (i & 3); }
__device__ __forceinline__ unsigned cvt_pk_bf16(float lo, float hi) { unsigned r; asm volatile("v_cvt_pk_bf16_f32 %0, %1, %2" : "=v"(r) : "v"(lo), "v"(hi)); return r; }
struct FUnit { int pm, pn, e, pos0, nvalid; };

template <class Epi, class Sched>
__device__ __forceinline__ void fast_gemm(LAS3 unsigned char* lds, const Sched& S, const Epi& E, int K, int tid_) {
  const int tid = tid_, wid = __builtin_amdgcn_readfirstlane(tid >> 6), lane = tid & 63, wr = wid >> 2, wc = wid & 3, fr = lane & 15, fq = lane >> 4;
  const int nt = K / 64;
  int R0, C0, R1, C1; fg_stage_rc(tid * 16, R0, C0); fg_stage_rc(tid * 16 + 8192, R1, C1);
  const unsigned ldb = S.ldb();
  unsigned voffB[2];
  voffB[0] = (unsigned)(((R0 & ~31) + fg_perm32(R0 & 31)) * ldb + C0) * 2u;
  voffB[1] = (unsigned)(((R1 & ~31) + fg_perm32(R1 & 31)) * ldb + C1) * 2u;
  const size_t kstep = 128;
  const size_t hstepB = (size_t)128 * ldb * 2;
  const unsigned ldsw = (unsigned)wid * 1024u;
  const int aoff = fg_lds_byte(wr * 64 + fr, fq * 8), boff = fg_lds_byte(wc * 32 + fr, fq * 8);
#define FG_SA(b, h) (((b) * 2 + (h)) * FG_HTB)
#define FG_SB(b, h) ((4 + (b) * 2 + (h)) * FG_HTB)
#define FG_STAGE(bufoff, gbase, voff) do { _Pragma("unroll") for (int _i = 0; _i < 2; ++_i) \
    __builtin_amdgcn_global_load_lds((const unsigned*)((const char*)(gbase) + (voff)[_i]), (LAS3 unsigned*)(lds + (bufoff) + ldsw + _i * 8192), 16, 0, 0); } while (0)
#define FG_LDA(dst, b, h) do { _Pragma("unroll") for (int m = 0; m < 4; ++m) _Pragma("unroll") for (int k = 0; k < 2; ++k) dst[m][k] = *(const LAS3 bf16x8*)(lds + FG_SA(b, h) + aoff + m * 2048 + k * 1024); } while (0)
#define FG_LDB(dst, b, h) do { _Pragma("unroll") for (int n = 0; n < 2; ++n) _Pragma("unroll") for (int k = 0; k < 2; ++k) dst[n][k] = *(const LAS3 bf16x8*)(lds + FG_SB(b, h) + boff + n * 2048 + k * 1024); } while (0)
#define FG_MMA(ai, bj, At, Bt) do { __builtin_amdgcn_s_setprio(1); _Pragma("unroll") for (int m = 0; m < 4; ++m) _Pragma("unroll") for (int n = 0; n < 2; ++n) _Pragma("unroll") for (int k = 0; k < 2; ++k) \
    acc[ai][bj][m][n] = __builtin_amdgcn_mfma_f32_16x16x32_bf16(Bt[n][k], At[m][k], acc[ai][bj][m][n], 0, 0, 0); __builtin_amdgcn_s_setprio(0); } while (0)
#define FG_WAIT_V(n) asm volatile("s_waitcnt vmcnt(" #n ")" ::: "memory")
#define FG_WAIT_L(n) asm volatile("s_waitcnt lgkmcnt(" #n ")" ::: "memory")
#define FG_BAR __builtin_amdgcn_s_barrier()
#define FG_SCHED __builtin_amdgcn_sched_barrier(0)
  FUnit cur, nxt; int ui = 0;
  if (!S.next(0, cur)) return;
  f32x4 acc[2][2][4][2];
#pragma unroll
  for (int a = 0; a < 2; ++a)
#pragma unroll
    for (int b = 0; b < 2; ++b)
#pragma unroll
      for (int m = 0; m < 4; ++m)
#pragma unroll
        for (int n = 0; n < 2; ++n) acc[a][b][m][n] = zero4();
  bf16x8 At[4][2], B0[2][2], B1[2][2];
  constexpr bool GA = Sched::GATHER;
  const unsigned lda = S.lda();
  const size_t hstepA = (size_t)128 * lda * 2;
  unsigned voffA[2];
  voffA[0] = (unsigned)(R0 * lda + C0) * 2u; voffA[1] = (unsigned)(R1 * lda + C1) * 2u;
  unsigned vaC[2][2], vaN[2][2];
  const char* cA = S.a_ptr(cur);
  if (GA) S.a_offs(cur, tid, vaC);
  const char* cB = S.b_ptr(cur);
#define FG_STAGE_A(bufoff, UPTR, KOFF, H, VG) do { if (GA) FG_STAGE(bufoff, (UPTR) + (KOFF), (VG)[H]); else FG_STAGE(bufoff, (UPTR) + (KOFF) + (H) * hstepA, voffA); } while (0)
  FG_STAGE(FG_SB(0, 0), cB, voffB); FG_STAGE_A(FG_SA(0, 0), cA, 0, 0, vaC); FG_STAGE(FG_SB(0, 1), cB + hstepB, voffB); FG_STAGE_A(FG_SA(0, 1), cA, 0, 1, vaC);
  if (wr == 1) FG_BAR;
  FG_WAIT_V(4); FG_BAR;
  FG_STAGE(FG_SB(1, 0), cB + kstep, voffB); FG_STAGE_A(FG_SA(1, 0), cA, kstep, 0, vaC); FG_STAGE(FG_SB(1, 1), cB + hstepB + kstep, voffB);
  FG_WAIT_V(6); FG_BAR;
  for (;;) {
    const bool has_next = S.next(ui + 1, nxt);
    if (!has_next) nxt = cur;
    if (GA) S.a_offs(nxt, tid, vaN);
    const char* nA = has_next ? S.a_ptr(nxt) : cA;
    const char* nB = has_next ? S.b_ptr(nxt) : cB;
#pragma unroll 1
    for (int t = 0; t < nt; t += 2) {
      const bool last = (t == nt - 2);
      const size_t k1 = (size_t)(t + 1) * kstep;
      const char* a2 = last ? nA : cA + (size_t)(t + 2) * kstep;
      const char* b2 = last ? nB : cB + (size_t)(t + 2) * kstep;
      const char* b3 = b2 + kstep;
      FG_LDB(B0, 0, 0); FG_SCHED; FG_LDA(At, 0, 0); FG_STAGE_A(FG_SA(1, 1), cA, k1, 1, vaC);
      FG_WAIT_L(8); FG_BAR; FG_WAIT_L(0); FG_MMA(0, 0, At, B0); FG_BAR; FG_SCHED;
      if (GA && last) {
#pragma unroll
        for (int h = 0; h < 2; ++h)
#pragma unroll
          for (int i = 0; i < 2; ++i) vaC[h][i] = vaN[h][i];
      }
      FG_LDB(B1, 0, 1); FG_STAGE(FG_SB(0, 0), b2, voffB);
      FG_BAR; FG_WAIT_L(0); FG_MMA(0, 1, At, B1); FG_BAR;
      FG_LDA(At, 0, 1); FG_STAGE_A(FG_SA(0, 0), a2, 0, 0, vaC);
      FG_BAR; FG_WAIT_L(0); FG_MMA(1, 0, At, B0); FG_BAR; FG_SCHED;
      FG_STAGE(FG_SB(0, 1), b2 + hstepB, voffB);
      FG_WAIT_V(6); FG_BAR; FG_MMA(1, 1, At, B1); FG_BAR;
      FG_LDB(B0, 1, 0); FG_SCHED; FG_LDA(At, 1, 0); FG_STAGE_A(FG_SA(0, 1), a2, 0, 1, vaC);
      FG_WAIT_L(8); FG_BAR; FG_WAIT_L(0); FG_MMA(0, 0, At, B0); FG_BAR; FG_SCHED;
      FG_LDB(B1, 1, 1); FG_STAGE(FG_SB(1, 0), b3, voffB);
      FG_BAR; FG_WAIT_L(0); FG_MMA(0, 1, At, B1); FG_BAR;
      FG_LDA(At, 1, 1); FG_STAGE_A(FG_SA(1, 0), a2, kstep, 0, vaC);
      FG_BAR; FG_WAIT_L(0); FG_MMA(1, 0, At, B0); FG_BAR; FG_SCHED;
      FG_STAGE(FG_SB(1, 1), b3 + hstepB, voffB);
      FG_WAIT_V(6); FG_BAR; FG_MMA(1, 1, At, B1); FG_BAR;
    }
    E(acc, cur, wr, wc, fr, fq, lane);
    if (!has_next) break;
#pragma unroll
    for (int a = 0; a < 2; ++a)
#pragma unroll
      for (int b = 0; b < 2; ++b)
#pragma unroll
        for (int m = 0; m < 4; ++m)
#pragma unroll
          for (int n = 0; n < 2; ++n) acc[a][b][m][n] = zero4();
    cur = nxt; cA = nA; cB = nB; ++ui;
  }
  FG_WAIT_V(0);
  if (wr == 0) FG_BAR;
  FG_BAR;
}

struct DenseOrder {
  const char* A; const char* Bt; int lda_, ldb_, nM, nN, nwg, G, c, a_col_bytes_per_pn;
  __device__ __forceinline__ void init(const void* A_, int ldaa, const void* Bt_, int ldbb, int M, int N, int G_, int c_, int acol) {
    A = (const char*)A_; Bt = (const char*)Bt_; lda_ = ldaa; ldb_ = ldbb; nM = M / 256; nN = N / 256; nwg = nM * nN; G = G_; c = c_; a_col_bytes_per_pn = acol; }
  __device__ __forceinline__ bool next(int i, FUnit& u) const {
    const long L = (long)i * G + c; if (L >= nwg) return false;
    int wgid = (int)L; { const int q = nwg / 8, r = nwg % 8, xcd = wgid % 8, off = wgid / 8; wgid = (xcd < r ? xcd * (q + 1) : r * (q + 1) + (xcd - r) * q) + off; }
    const int nig = 8 * nN, gid = wgid / nig, fm = gid * 8, gsz = (nM - fm) < 8 ? (nM - fm) : 8;
    u.pm = fm + ((wgid % nig) % gsz); u.pn = (wgid % nig) / gsz; u.e = 0; u.pos0 = 0; u.nvalid = 256; return true;
  }
  static constexpr bool GATHER = false;
  __device__ __forceinline__ unsigned lda() const { return (unsigned)lda_; }
  __device__ __forceinline__ unsigned ldb() const { return (unsigned)ldb_; }
  __device__ __forceinline__ const char* a_ptr(const FUnit& u) const { return A + (size_t)u.pm * 256 * lda_ * 2 + (size_t)u.pn * a_col_bytes_per_pn; }
  __device__ __forceinline__ void a_offs(const FUnit&, int, unsigned (&)[2][2]) const {}
  __device__ __forceinline__ const char* b_ptr(const FUnit& u) const { return Bt + (size_t)u.pn * 256 * ldb_ * 2; }
};

struct EpiProj {
  char* ws;
  __device__ __forceinline__ void operator()(const f32x4 (&acc)[2][2][4][2], const FUnit& u, int wr, int wc, int fr, int fq, int lane) const {
    const float* rs0 = (const float*)(ws + OFF_RS0);
    bf16_t* proj = (bf16_t*)(ws + OFF_R2);
#pragma unroll
    for (int ai = 0; ai < 2; ++ai)
#pragma unroll
      for (int m = 0; m < 4; ++m) {
        const int row = u.pm * 256 + ai * 128 + wr * 64 + m * 16 + fr;
        const float sc = rs0[row];
#pragma unroll
        for (int bj = 0; bj < 2; ++bj) {
          const int col0 = u.pn * 256 + bj * 128 + wc * 32 + fq * 8;
          const f32x4 v0 = acc[ai][bj][m][0] * sc, v1 = acc[ai][bj][m][1] * sc;
          u32x4 w4; w4.x = cvt_pk_bf16(v0[0], v0[1]); w4.y = cvt_pk_bf16(v0[2], v0[3]); w4.z = cvt_pk_bf16(v1[0], v1[1]); w4.w = cvt_pk_bf16(v1[2], v1[3]);
          *(u32x4*)(proj + (long)row * PROJ_LD + col0) = w4;
          if (u.pn == 7 && bj == 1 && wc == 1 && fq == 0) {
            float* d = (float*)(ws + OFF_DTRAW) + (long)row * 8;
            *(f32x4*)d = v0; *(f32x4*)(d + 4) = v1;
          }
          if (u.pn == 0 || (u.pn == 1 && bj == 0)) {
            float ss = v0[0] * v0[0] + v0[1] * v0[1] + v0[2] * v0[2] + v0[3] * v0[3] + v1[0] * v1[0] + v1[1] * v1[1] + v1[2] * v1[2] + v1[3] * v1[3];
            ss += sxor<16>(ss); ss += lane_get(ss, lane ^ 32);
            if (fq == 0) {
              if (u.pn == 0) ((float*)(ws + OFF_SSQ_Q))[row * 8 + bj * 4 + wc] = ss;
              else ((float*)(ws + OFF_SSQ_KV))[row * 4 + wc] = ss;
            }
          }
        }
      }
  }
};

template <int MODE>
struct EpiRes {
  char* ws; const float* xin; float* out; float* ssq; const float* pb; const float* psc; float f;
  __device__ __forceinline__ void operator()(const f32x4 (&acc)[2][2][4][2], const FUnit& u, int wr, int wc, int fr, int fq, int lane) const {
    bf16_t* xcb = (bf16_t*)(ws + OFF_XCB);
#pragma unroll
    for (int bj = 0; bj < 2; ++bj) {
      const int col0 = u.pn * 256 + bj * 128 + wc * 32 + fq * 8;
      f32x4 b0 = zero4(), b1 = b0, s0 = (f32x4){1.f, 1.f, 1.f, 1.f}, s1 = s0;
      if (MODE == 2) { b0 = *(const f32x4*)(pb + col0); b1 = *(const f32x4*)(pb + col0 + 4); s0 = *(const f32x4*)(psc + col0); s1 = *(const f32x4*)(psc + col0 + 4); }
#pragma unroll
      for (int ai = 0; ai < 2; ++ai)
#pragma unroll
        for (int m = 0; m < 4; ++m) {
          const int row = u.pm * 256 + ai * 128 + wr * 64 + m * 16 + fr;
          const float* bp = (MODE == 0 ? xin : out) + (long)row * 1024 + col0;
          f32x4 a0 = acc[ai][bj][m][0], a1 = acc[ai][bj][m][1];
          if (MODE == 2) { a0 = (a0 + b0) * s0; a1 = (a1 + b1) * s1; }
          const float ff = (MODE == 0) ? 1.f : f;
          const f32x4 v0 = *(const f32x4*)bp + a0 * ff, v1 = *(const f32x4*)(bp + 4) + a1 * ff;
          float* op = out + (long)row * 1024 + col0;
          *(f32x4*)op = v0; *(f32x4*)(op + 4) = v1;
          u32x4 w4; w4.x = cvt_pk_bf16(v0[0], v0[1]); w4.y = cvt_pk_bf16(v0[2], v0[3]); w4.z = cvt_pk_bf16(v1[0], v1[1]); w4.w = cvt_pk_bf16(v1[2], v1[3]);
          *(u32x4*)(xcb + (long)row * 1024 + col0) = w4;
          float ss = v0[0] * v0[0] + v0[1] * v0[1] + v0[2] * v0[2] + v0[3] * v0[3] + v1[0] * v1[0] + v1[1] * v1[1] + v1[2] * v1[2] + v1[3] * v1[3];
          ss += sxor<16>(ss); ss += lane_get(ss, lane ^ 32);
          if (fq == 0) ssq[row * 32 + (u.pn * 2 + bj) * 4 + wc] = ss;
        }
    }
  }
};

__device__ __forceinline__ void tconv_tile(const float* src, int N, bf16_t* dst, int dst_ld, int grp, int grp_pad, int goff, const float* gain,
                           int tk, int tn, float* tl, int tid) {
  const int t = tid;
  const int k0 = tk * 64, n0 = tn * 64;
#pragma unroll
  for (int i = 0; i < 2; ++i) {
    const int r = (t >> 4) + 32 * i, c = (t & 15) * 4;
    float4 v = make_float4(0.f, 0.f, 0.f, 0.f);
    if (n0 + c < N) v = *(const float4*)(src + (long)(k0 + r) * N + n0 + c);
    const float g = gain ? gain[k0 + r] : 1.f;
    tl[r * 65 + c + 0] = v.x * g; tl[r * 65 + c + 1] = v.y * g; tl[r * 65 + c + 2] = v.z * g; tl[r * 65 + c + 3] = v.w * g;
  }
  __syncthreads();
  const int n = n0 + (t >> 3);
  if (n < N) {
    const int drow = (n / grp) * grp_pad + goff + (n % grp);
    const int kk = (t & 7) * 8;
    unsigned u[4];
#pragma unroll
    for (int j = 0; j < 4; ++j) u[j] = pack2(tl[(kk + 2 * j) * 65 + (t >> 3)], tl[(kk + 2 * j + 1) * 65 + (t >> 3)]);
    *(uint4*)(dst + (long)drow * dst_ld + k0 + kk) = make_uint4(u[0], u[1], u[2], u[3]);
  }
  __syncthreads();
}

struct TJob { const float* src; int K, N; bf16_t* dst; int dst_ld, grp, grp_pad, goff; const float* gain; };
constexpr int N_TJOBS = 5 + 4 + 6 + 192;
__device__ __forceinline__ TJob get_tjob(int idx, const Ctx& c, char* ws) {
  constexpr int BIG = 1 << 30;
  TJob j;
  if (idx == 0) j = {INP(I_W_IN), 1024, 1960, (bf16_t*)(ws + OFF_WIN_T), 1024, BIG, 0, 0, INP(I_LN_MIX)};
  else if (idx == 1) j = {INP(I_W_UQ), 256, 768, (bf16_t*)(ws + OFF_WUQ_T), 256, 96, 128, 0, INP(I_QLAT_NORM)};
  else if (idx == 2) j = {INP(I_W_UKV), 128, 1024, (bf16_t*)(ws + OFF_WUKV_T), 128, BIG, 0, 0, INP(I_KVLAT_NORM)};
  else if (idx == 3) j = {INP(I_W_OUT), 512, 1024, (bf16_t*)(ws + OFF_WOUT_T), 1024, BIG, 0, 0, nullptr};
  else if (idx == 4) j = {INP(I_W_OUT) + 512 * 1024, 512, 1024, (bf16_t*)(ws + OFF_WOUT_T) + 512, 1024, BIG, 0, 0, INP(I_SSD_NORM)};
  else if (idx < 9) { const int g = idx - 5; j = {INP(I_POOL_W) + g * 65536, 256, 256, (bf16_t*)(ws + OFF_POOL_T) + g * 65536, 256, BIG, 0, 0, INP(I_LN_MIX) + 1024 + g * 256}; }
  else if (idx < 15) {
    const int l = (idx - 9) / 3, k = (idx - 9) % 3;
    if (k == 0) j = {INP(I_XQ_W) + l * 1024 * 256, 1024, 256, (bf16_t*)(ws + OFF_XQ_T) + l * 256 * 1024, 1024, BIG, 0, 0, INP(I_LN_XQ) + l * 1024};
    else if (k == 1) j = {INP(I_XKV_W) + l * 1024 * 512, 1024, 512, (bf16_t*)(ws + OFF_XKV_T) + l * 512 * 1024, 1024, BIG, 0, 0, INP(I_LN_MEM) + l * 1024};
    else j = {INP(I_XO_W) + l * 256 * 1024, 256, 1024, (bf16_t*)(ws + OFF_XO_T) + l * 1024 * 256, 256, BIG, 0, 0, nullptr};
  } else {
    const int le = (idx - 15) / 3, k = (idx - 15) % 3, l = le >> 5;
    const long wo = (long)le * 1024 * 256;
    if (k == 0) j = {INP(I_EXP_G) + wo, 1024, 256, (bf16_t*)(ws + OFF_WGU_T) + (long)le * 512 * 1024, 1024, 4, 8, 0, INP(I_LN_FFN) + l * 1024};
    else if (k == 1) j = {INP(I_EXP_U) + wo, 1024, 256, (bf16_t*)(ws + OFF_WGU_T) + (long)le * 512 * 1024, 1024, 4, 8, 4, INP(I_LN_FFN) + l * 1024};
    else j = {INP(I_EXP_D) + wo, 256, 1024, (bf16_t*)(ws + OFF_WD_T) + (long)le * 1024 * 256, 256, BIG, 0, 0, nullptr};
  }
  return j;
}

__device__ __forceinline__ void phase_prep(const Ctx& c) {
  char* ws = c.ws; char* smem = c.smem; const int bid = c.bid, nblk = c.nblk;
  float* tl = (float*)smem;
  int base = 0;
  for (int ji = 0; ji < N_TJOBS; ++ji) {
    const TJob j = get_tjob(ji, c, ws);
    const int tilesN = (j.N + 63) / 64, tilesK = j.K / 64;
    const int ntiles = tilesN * tilesK;
    const int t0 = (bid - (base % nblk) + nblk) % nblk;
    for (int tile = t0; tile < ntiles; tile += nblk)
      tconv_tile(j.src, j.N, j.dst, j.dst_ld, j.grp, j.grp_pad, j.goff, j.gain, tile / tilesN, tile % tilesN, tl, c.tid);
    base += ntiles;
  }
  {
    const int gt = bid * NTHR + c.tid, gn = nblk * NTHR;
    uint4 z = make_uint4(0, 0, 0, 0);
    bf16_t* w1 = (bf16_t*)(ws + OFF_WIN_T) + 1960l * 1024;
    for (int i = gt; i < 88 * 1024 / 8; i += gn) *(uint4*)(w1 + i * 8) = z;
    bf16_t* w2 = (bf16_t*)(ws + OFF_WUQ_T);
    for (int i = gt; i < 8 * 32 * 256 / 8; i += gn) {
      const int e = i * 8, h = e / (32 * 256), rem = e % (32 * 256);
      *(uint4*)(w2 + (long)(h * 128 + 96) * 256 + rem) = z;
    }
    if (gt < 128) ((int*)(ws + OFF_CTL))[gt] = 0;
  }
  {
    const int lane = c.tid & 63;
    const int gw = bid * NWAV + (c.tid >> 6), nw = nblk * NWAV;
    for (int row = gw; row < NT + 4096; row += nw) {
      const bool ism = row >= NT;
      const int r = ism ? row - NT : row;
      const float* src = (ism ? INP(I_MEM) : INP(I_X)) + (long)r * 1024;
      bf16_t* dst = (bf16_t*)(ws + (ism ? OFF_MEMB : OFF_R1)) + (long)r * 1024;
      float ss = 0.f;
#pragma unroll
      for (int i = 0; i < 4; ++i) {
        float4 v = *(const float4*)(src + i * 256 + lane * 4);
        ss += v.x * v.x + v.y * v.y + v.z * v.z + v.w * v.w;
        *(uint2*)(dst + i * 256 + lane * 4) = make_uint2(pack2(v.x, v.y), pack2(v.z, v.w));
      }
      ss = wave_sum(ss, lane);
      if (lane == 0) ((float*)(ws + (ism ? OFF_RSM : OFF_RS0)))[r] = rsqrtf(ss * (1.f / 1024.f) + EPS);
    }
  }
}

__device__ __forceinline__ float cs_ssq(const float* crow, int n) {
  float ss = 0.f;
  for (int j = 0; j < n; j += 4) { const float4 c = *(const float4*)(crow + j); ss += c.x * c.x + c.y * c.y + c.z * c.z + c.w * c.w; }
  return ss;
}
__device__ __forceinline__ void cs_store_scaled(bf16_t* dst, const float* crow, int n, float sc, const float* g) {
  for (int j = 0; j < n; j += 8) {
    float4 a = *(const float4*)(crow + j), b = *(const float4*)(crow + j + 4);
    if (g) {
      const float4 ga = *(const float4*)(g + j), gb = *(const float4*)(g + j + 4);
      a.x *= ga.x; a.y *= ga.y; a.z *= ga.z; a.w *= ga.w; b.x *= gb.x; b.y *= gb.y; b.z *= gb.z; b.w *= gb.w;
    }
    *(uint4*)(dst + j) = make_uint4(pack2(a.x * sc, a.y * sc), pack2(a.z * sc, a.w * sc), pack2(b.x * sc, b.y * sc), pack2(b.z * sc, b.w * sc));
  }
}
__device__ __forceinline__ float row_rs32(const float* ssq, int row) {
  const float4* q = (const float4*)(ssq + (long)row * 32);
  float s = 0.f;
#pragma unroll
  for (int i = 0; i < 8; ++i) { const float4 v = q[i]; s += (v.x + v.y) + (v.z + v.w); }
  return rsqrtf(s * (1.f / 1024.f) + EPS);
}
__device__ __forceinline__ void rope_cs(float pos, int i, float& c, float& s) {
  const float ang = pos * exp2f(-(float)i * 0.8304820237218406f);
  float u = ang * 0.15915494309189535f;
  u -= rintf(u);
  c = __builtin_amdgcn_cosf(u);
  s = __builtin_amdgcn_sinf(u);
}

__device__ __forceinline__ void phase_gemm_in(const Ctx& c) {
  char* ws = c.ws; char* smem = c.smem; const int bid = c.bid, nblk = c.nblk;
  {
    DenseOrder S; S.init(ws + OFF_R1, 1024, ws + OFF_WIN_T, 1024, NT, 2048, nblk, bid, 0);
    EpiProj E{ws};
    fast_gemm(( LAS3 unsigned char*)smem, S, E, 1024, c.tid);
  }
  __syncthreads();
  const int t = c.tid, er = t >> 1, eh = t & 1;
  const float* crow = (const float*)smem + er * CS_LD + eh * 64;
  for (int it = bid; it < 2 * 32 * 4; it += nblk) {
    const int l = it >> 7, mt = (it >> 2) & 31, nt = it & 3;
    gemm_dense((const bf16_t*)(ws + OFF_MEMB) + (long)mt * 128 * 1024, 1024,
               (const bf16_t*)(ws + OFF_XKV_T) + (long)l * 512 * 1024 + (long)nt * 128 * 1024, 1024, 1024, smem, c.tid);
    if (t < 256) {
      const int row = mt * 128 + er;
      const float sc = ((const float*)(ws + OFF_RSM))[row];
      if (nt < 2) {
        const int head = nt * 2 + eh;
        const float ss = cs_ssq(crow, 64) * sc * sc;
        const float r = rsqrtf(ss * (1.f / 64.f) + EPS) * sc;
        cs_store_scaled((bf16_t*)(ws + OFF_MEMK) + (long)l * 4096 * 256 + (long)row * 256 + head * 64, crow, 64, r, INP(I_XK_NORM) + l * 64);
      } else {
        const int head = (nt - 2) * 2 + eh;
        const int b = row >> 8, m = row & 255;
        bf16_t* d = (bf16_t*)(ws + OFF_MEMVT) + (long)l * 4096 * 256 + ((long)(b * 4 + head) * 64) * 256 + m;
        for (int j = 0; j < 64; ++j) d[j * 256] = f2bf(crow[j] * sc);
      }
    }
    __syncthreads();
  }
}

__device__ __forceinline__ void phase_up(const Ctx& c) {
  char* ws = c.ws; char* smem = c.smem; const int bid = c.bid, nblk = c.nblk; (void)smem; (void)bid; (void)nblk;
  const int t = c.tid, er = t >> 1, eh = t & 1;
  const float* crow = (const float*)smem + er * CS_LD + eh * 64;
  const bf16_t* proj = (const bf16_t*)(ws + OFF_R2);
  const int* positions = (const int*)c.p.in[opq(I_POS)];
  const int n_items = 512 * 8 * 2;
  for (int item = bid; item < n_items; item += nblk) {
    const int which = item >= 4096;
    const int it = item & 4095;
    const int mt = it >> 3, h = it & 7;
    const int row = mt * 128 + er;
    const int b = row >> 12, s = row & 4095;
    {
      const int kk = which ? 128 : 256;
      gemm_dense(proj + (long)mt * 128 * PROJ_LD + (which ? C_KVLAT : C_QLAT), PROJ_LD,
                 (const bf16_t*)(ws + (which ? OFF_WUKV_T : OFF_WUQ_T)) + (long)h * 128 * kk, kk, kk, smem, c.tid);
    }
    if (t < 256) {
    if (!which) {
      const float* sq = (const float*)(ws + OFF_SSQ_Q) + row * 8;
      const float rq = rsqrtf(((sq[0] + sq[1]) + (sq[2] + sq[3]) + (sq[4] + sq[5]) + (sq[6] + sq[7])) * (1.f / 256.f) + EPS);
      float ss = cs_ssq(crow, eh ? 32 : 64) * rq * rq;
      ss += sxor<1>(ss);
      const float r = rsqrtf(ss * (1.f / 96.f) + EPS) * rq * (0.10206207261596577f * LOG2E);
      const float* g = INP(I_Q_NORM) + eh * 64;
      bf16_t* dst = (bf16_t*)(ws + OFF_Q) + ((long)(b * 8 + h) * 4096 + s) * 96 + eh * 64;
      if (!eh) {
        cs_store_scaled(dst, crow, 64, r, g);
      } else {
        const float pos = (float)positions[row];
        for (int i0 = 0; i0 < 16; i0 += 8) {
          float o1[8], o2[8];
#pragma unroll
          for (int i = 0; i < 8; ++i) {
            float c, sn; rope_cs(pos, i0 + i, c, sn);
            const float u1 = crow[i0 + i] * r * g[i0 + i], u2 = crow[16 + i0 + i] * r * g[16 + i0 + i];
            o1[i] = u1 * c - u2 * sn; o2[i] = u2 * c + u1 * sn;
          }
          *(uint4*)(dst + i0) = make_uint4(pack2(o1[0], o1[1]), pack2(o1[2], o1[3]), pack2(o1[4], o1[5]), pack2(o1[6], o1[7]));
          *(uint4*)(dst + 16 + i0) = make_uint4(pack2(o2[0], o2[1]), pack2(o2[2], o2[3]), pack2(o2[4], o2[5]), pack2(o2[6], o2[7]));
        }
      }
    } else {
      const float* sk = (const float*)(ws + OFF_SSQ_KV) + row * 4;
      const float rkv = rsqrtf(((sk[0] + sk[1]) + (sk[2] + sk[3])) * (1.f / 128.f) + EPS);
      if (!eh) {
        const bf16_t* kp = proj + (long)row * PROJ_LD + C_KROPE;
        float ss = cs_ssq(crow, 64) * rkv * rkv;
        for (int j = 0; j < 32; j += 8) {
          const uint4 u = *(const uint4*)(kp + j);
          ss += bflo(u.x) * bflo(u.x) + bfhi(u.x) * bfhi(u.x) + bflo(u.y) * bflo(u.y) + bfhi(u.y) * bfhi(u.y)
              + bflo(u.z) * bflo(u.z) + bfhi(u.z) * bfhi(u.z) + bflo(u.w) * bflo(u.w) + bfhi(u.w) * bfhi(u.w);
        }
        const float r = rsqrtf(ss * (1.f / 96.f) + EPS);
        const float* g = INP(I_K_NORM);
        bf16_t* dst = (bf16_t*)(ws + OFF_K) + ((long)(b * 8 + h) * 4096 + s) * 96;
        cs_store_scaled(dst, crow, 64, r * rkv, g);
        const float pos = (float)positions[row];
        for (int i0 = 0; i0 < 16; i0 += 8) {
          const uint4 ua = *(const uint4*)(kp + i0), ub = *(const uint4*)(kp + 16 + i0);
          const float k1[8] = {bflo(ua.x), bfhi(ua.x), bflo(ua.y), bfhi(ua.y), bflo(ua.z), bfhi(ua.z), bflo(ua.w), bfhi(ua.w)};
          const float k2[8] = {bflo(ub.x), bfhi(ub.x), bflo(ub.y), bfhi(ub.y), bflo(ub.z), bfhi(ub.z), bflo(ub.w), bfhi(ub.w)};
          float o1[8], o2[8];
#pragma unroll
          for (int i = 0; i < 8; ++i) {
            float c, sn; rope_cs(pos, i0 + i, c, sn);
            const float u1 = k1[i] * r * g[64 + i0 + i], u2 = k2[i] * r * g[80 + i0 + i];
            o1[i] = u1 * c - u2 * sn; o2[i] = u2 * c + u1 * sn;
          }
          *(uint4*)(dst + 64 + i0) = make_uint4(pack2(o1[0], o1[1]), pack2(o1[2], o1[3]), pack2(o1[4], o1[5]), pack2(o1[6], o1[7]));
          *(uint4*)(dst + 80 + i0) = make_uint4(pack2(o2[0], o2[1]), pack2(o2[2], o2[3]), pack2(o2[4], o2[5]), pack2(o2[6], o2[7]));
        }
      } else {
        bf16_t* d = (bf16_t*)(ws + OFF_VT) + ((long)(b * 8 + h) * 64) * 4096 + s;
        for (int j = 0; j < 64; ++j) d[(long)j * 4096] = f2bf(crow[j] * rkv);
      }
    }
    }
    __syncthreads();
  }
  {
    const long gt = (long)bid * NTHR + t, gn = (long)nblk * NTHR;
    const float* cw = INP(I_CONV_W);
    const float* cb = INP(I_CONV_B);
    bf16_t* xc = (bf16_t*)(ws + OFF_R4);
    for (long i = gt; i < (long)NT * 128; i += gn) {
      const int tok = (int)(i >> 7), ch = (int)(i & 127) * 8;
      const int s = tok & 4095;
      float a[8];
#pragma unroll
      for (int j = 0; j < 8; ++j) a[j] = cb[ch + j];
#pragma unroll
      for (int k = 0; k < 4; ++k) {
        const int ds = k - 3;
        if (s + ds >= 0) {
          uint4 u = *(const uint4*)(proj + (long)(tok + ds) * PROJ_LD + C_XBC + ch);
          const float* w = cw + k * 1024 + ch;
          a[0] += w[0] * bflo(u.x); a[1] += w[1] * bfhi(u.x); a[2] += w[2] * bflo(u.y); a[3] += w[3] * bfhi(u.y);
          a[4] += w[4] * bflo(u.z); a[5] += w[5] * bfhi(u.z); a[6] += w[6] * bflo(u.w); a[7] += w[7] * bfhi(u.w);
        }
      }
#pragma unroll
      for (int j = 0; j < 8; ++j) a[j] = silu_f(a[j]);
      *(uint4*)(xc + (long)tok * 1024 + ch) = make_uint4(pack2(a[0], a[1]), pack2(a[2], a[3]), pack2(a[4], a[5]), pack2(a[6], a[7]));
    }
    const float* dtr = (const float*)(ws + OFF_DTRAW);
    float* dt = (float*)(ws + OFF_DT);
    for (long i = gt; i < (long)NT * 8; i += gn) {
      const float x = dtr[i] + INP(I_DT_BIAS)[i & 7];
      dt[i] = x > 20.f ? x : log1pf(__expf(x));
    }
  }
}

template <int DQK, bool CAUSAL>
__device__ __forceinline__ void attn_block(const bf16_t* Q, long ldq, const bf16_t* K, long ldk, const bf16_t* Vt, long ldvt, int ntiles, int q0,
                           bf16_t* O, long ldo, char* smem, int tid) {
  constexpr int KLD = DQK + 8, NKS = DQK / 32, KCH = DQK / 8;
  const int t = tid, lane = t & 63, w = t >> 6, l15 = lane & 15, lq = lane >> 4;
  bf16_t* Ks = (bf16_t*)smem;
  bf16_t* Vts = Ks + 64 * KLD;
  bf16_t* Ps = Vts + 64 * 72 + w * 32 * 72;
  bf16x8 qf[2][NKS];
#pragma unroll
  for (int mt = 0; mt < 2; ++mt)
#pragma unroll
    for (int ks = 0; ks < NKS; ++ks) qf[mt][ks] = *(const bf16x8*)(Q + (long)(w * 32 + mt * 16 + l15) * ldq + ks * 32 + lq * 8);
  f32x4 oacc[2][4];
  float mrow[2][4], lrow[2][4];
#pragma unroll
  for (int mt = 0; mt < 2; ++mt)
#pragma unroll
    for (int i = 0; i < 4; ++i) { oacc[mt][i] = zero4(); mrow[mt][i] = -1e30f; lrow[mt][i] = 0.f; }
  for (int kt = 0; kt < ntiles; ++kt) {
    for (int c = t; c < 64 * KCH; c += NTHR) {
      const int r = c / KCH, cc = c % KCH;
      *(uint4*)(Ks + r * KLD + cc * 8) = *(const uint4*)(K + (long)(kt * 64 + r) * ldk + cc * 8);
    }
    for (int c = t; c < 512; c += NTHR) {
      const int r = c >> 3, cc = c & 7;
      *(uint4*)(Vts + r * 72 + cc * 8) = *(const uint4*)(Vt + (long)r * ldvt + kt * 64 + cc * 8);
    }
    __syncthreads();
    f32x4 sacc[2][4];
#pragma unroll
    for (int mt = 0; mt < 2; ++mt)
#pragma unroll
      for (int nt = 0; nt < 4; ++nt) sacc[mt][nt] = zero4();
#pragma unroll
    for (int nt = 0; nt < 4; ++nt)
#pragma unroll
      for (int ks = 0; ks < NKS; ++ks) {
        const bf16x8 kf = *(const bf16x8*)(Ks + (nt * 16 + l15) * KLD + ks * 32 + lq * 8);
        sacc[0][nt] = mfma16(qf[0][ks], kf, sacc[0][nt]);
        sacc[1][nt] = mfma16(qf[1][ks], kf, sacc[1][nt]);
      }
    if (CAUSAL && (kt * 64 + 63 > q0 + w * 32)) {
#pragma unroll
      for (int mt = 0; mt < 2; ++mt)
#pragma unroll
        for (int nt = 0; nt < 4; ++nt)
#pragma unroll
          for (int r = 0; r < 4; ++r) {
            const int key = kt * 64 + nt * 16 + l15, qr = q0 + w * 32 + mt * 16 + lq * 4 + r;
            if (key > qr) sacc[mt][nt][r] = -1e30f;
          }
    }
#pragma unroll
    for (int mt = 0; mt < 2; ++mt)
#pragma unroll
      for (int r = 0; r < 4; ++r) {
        float mx = fmaxf(fmaxf(sacc[mt][0][r], sacc[mt][1][r]), fmaxf(sacc[mt][2][r], sacc[mt][3][r]));
        mx = fmaxf(mx, sxor<1>(mx)); mx = fmaxf(mx, sxor<2>(mx));
        mx = fmaxf(mx, sxor<4>(mx)); mx = fmaxf(mx, sxor<8>(mx));
        const float mn = fmaxf(mrow[mt][r], mx);
        const float alpha = __builtin_amdgcn_exp2f(mrow[mt][r] - mn);
        mrow[mt][r] = mn;
        float ps = 0.f;
#pragma unroll
        for (int nt = 0; nt < 4; ++nt) {
          const float pv = __builtin_amdgcn_exp2f(sacc[mt][nt][r] - mn);
          ps += pv;
          Ps[(mt * 16 + lq * 4 + r) * 72 + nt * 16 + l15] = f2bf(pv);
        }
        lrow[mt][r] = lrow[mt][r] * alpha + ps;
#pragma unroll
        for (int dt = 0; dt < 4; ++dt) oacc[mt][dt][r] *= alpha;
      }
    __syncthreads();
#pragma unroll
    for (int ks = 0; ks < 2; ++ks) {
      bf16x8 pf[2], vf[4];
#pragma unroll
      for (int mt = 0; mt < 2; ++mt) pf[mt] = *(const bf16x8*)(Ps + (mt * 16 + l15) * 72 + ks * 32 + lq * 8);
#pragma unroll
      for (int dt = 0; dt < 4; ++dt) vf[dt] = *(const bf16x8*)(Vts + (dt * 16 + l15) * 72 + ks * 32 + lq * 8);
#pragma unroll
      for (int mt = 0; mt < 2; ++mt)
#pragma unroll
        for (int dt = 0; dt < 4; ++dt) oacc[mt][dt] = mfma16(pf[mt], vf[dt], oacc[mt][dt]);
    }
    __syncthreads();
  }
#pragma unroll
  for (int mt = 0; mt < 2; ++mt)
#pragma unroll
    for (int r = 0; r < 4; ++r) {
      float l = lrow[mt][r];
      l += sxor<1>(l); l += sxor<2>(l); l += sxor<4>(l); l += sxor<8>(l);
      const float inv = 1.f / l;
      bf16_t* orow = O + (long)(w * 32 + mt * 16 + lq * 4 + r) * ldo;
#pragma unroll
      for (int dt = 0; dt < 4; ++dt) orow[dt * 16 + l15] = f2bf(oacc[mt][dt][r] * inv);
    }
}

__device__ __forceinline__ void ssd_item(const Ctx& c, int b, int h) {
  char* ws = c.ws; char* smem = c.smem;
  const int t = c.tid, lane = t & 63, w = t >> 6, l15 = lane & 15, lq = lane >> 4;
  const int g = h >> 2;
  const int pw = w & 3, nq = (w >> 2) * 4;
  bf16_t* Cl = (bf16_t*)smem;
  bf16_t* Bl = Cl + 128 * 136;
  bf16_t* Ml = Bl + 128 * 136;
  bf16_t* Sl = Ml + 128 * 136;
  bf16_t* Xl = Sl + 64 * 136;
  float* fa = (float*)(Xl + 128 * 72);
  const bf16_t* xc = (const bf16_t*)(ws + OFF_R4);
  const bf16_t* proj = (const bf16_t*)(ws + OFF_R2);
  const float* dtp = (const float*)(ws + OFF_DT);
  bf16_t* AY = (bf16_t*)(ws + OFF_R1);
  const float a_h = -__expf(INP(I_A_LOG)[h]);
  const float dsk = INP(I_D_SKIP)[h];
  f32x4 st[4];
#pragma unroll
  for (int i = 0; i < 4; ++i) st[i] = zero4();
  for (int ck = 0; ck < 32; ++ck) {
    const long t0 = (long)b * 4096 + ck * 128;
#pragma unroll
    for (int i = 0; i < 4; ++i) {
      const int ch = t + NTHR * i, r = ch >> 4, cc = ch & 15;
      *(uint4*)(Cl + r * 136 + cc * 8) = *(const uint4*)(xc + (t0 + r) * 1024 + 768 + g * 128 + cc * 8);
      *(uint4*)(Bl + r * 136 + cc * 8) = *(const uint4*)(xc + (t0 + r) * 1024 + 512 + g * 128 + cc * 8);
    }
#pragma unroll
    for (int i = 0; i < 2; ++i) {
      const int ch = t + NTHR * i, r = ch >> 3, cc = ch & 7;
      const uint4 u = *(const uint4*)(xc + (t0 + r) * 1024 + h * 64 + cc * 8);
      const float d = dtp[(t0 + r) * 8 + h];
      *(uint4*)(Xl + r * 72 + cc * 8) = make_uint4(pack2(bflo(u.x) * d, bfhi(u.x) * d), pack2(bflo(u.y) * d, bfhi(u.y) * d),
                                                   pack2(bflo(u.z) * d, bfhi(u.z) * d), pack2(bflo(u.w) * d, bfhi(u.w) * d));
    }
    if (w == 0) {
      const float a0 = dtp[(t0 + 2 * lane) * 8 + h] * a_h, a1 = dtp[(t0 + 2 * lane + 1) * 8 + h] * a_h;
      const float pr = a0 + a1;
      float sc = pr;
#pragma unroll
      for (int o = 1; o < 64; o <<= 1) { const float n = lane_get(sc, (lane - o) & 63); if (lane >= o) sc += n; }
      const float alast = __int_as_float(__builtin_amdgcn_readlane(__float_as_int(sc), 63));
      const float c0 = sc - pr + a0, c1 = sc;
      fa[2 * lane] = c0; fa[2 * lane + 1] = c1;
      fa[128 + 2 * lane] = __expf(c0); fa[128 + 2 * lane + 1] = __expf(c1);
      fa[256 + 2 * lane] = __expf(alast - c0); fa[256 + 2 * lane + 1] = __expf(alast - c1);
    }
#pragma unroll
    for (int i = 0; i < 4; ++i)
#pragma unroll
      for (int r = 0; r < 4; ++r) Sl[(pw * 16 + lq * 4 + r) * 136 + (nq + i) * 16 + l15] = f2bf(st[i][r]);
    __syncthreads();
    bf16x8 cf[4];
#pragma unroll
    for (int ks = 0; ks < 4; ++ks) cf[ks] = *(const bf16x8*)(Cl + (w * 16 + l15) * 136 + ks * 32 + lq * 8);
    f32x4 yacc[4];
#pragma unroll
    for (int pt = 0; pt < 4; ++pt) {
      yacc[pt] = zero4();
#pragma unroll
      for (int ks = 0; ks < 4; ++ks) {
        const bf16x8 sf = *(const bf16x8*)(Sl + (pt * 16 + l15) * 136 + ks * 32 + lq * 8);
        yacc[pt] = mfma16(cf[ks], sf, yacc[pt]);
      }
#pragma unroll
      for (int r = 0; r < 4; ++r) yacc[pt][r] *= fa[128 + w * 16 + lq * 4 + r];
    }
#pragma unroll
    for (int stl = 0; stl < 8; ++stl) {
      f32x4 gacc = zero4();
      if (stl <= w) {
#pragma unroll
        for (int ks = 0; ks < 4; ++ks) {
          const bf16x8 bfv = *(const bf16x8*)(Bl + (stl * 16 + l15) * 136 + ks * 32 + lq * 8);
          gacc = mfma16(cf[ks], bfv, gacc);
        }
      }
#pragma unroll
      for (int r = 0; r < 4; ++r) {
        const int tt = w * 16 + lq * 4 + r, ss = stl * 16 + l15;
        float m = 0.f;
        if (ss <= tt) m = gacc[r] * __expf(fa[tt] - fa[ss]);
        Ml[tt * 136 + ss] = f2bf(m);
      }
    }
    __syncthreads();
#pragma unroll
    for (int ks = 0; ks < 4; ++ks) {
      if (ks * 32 <= w * 16 + 15) {
        const bf16x8 mf = *(const bf16x8*)(Ml + (w * 16 + l15) * 136 + ks * 32 + lq * 8);
#pragma unroll
        for (int pt = 0; pt < 4; ++pt) {
          const bf16x8 xf = tr_frag(Xl, 72, ks * 32, pt * 16, l15, lq);
          yacc[pt] = mfma16(mf, xf, yacc[pt]);
        }
      }
    }
#pragma unroll
    for (int pt = 0; pt < 4; ++pt)
#pragma unroll
      for (int r = 0; r < 4; ++r) {
        const long tok = t0 + w * 16 + lq * 4 + r;
        const int pp = pt * 16 + l15;
        const float xv = bf2f(xc[tok * 1024 + h * 64 + pp]);
        const float zv = bf2f(proj[tok * PROJ_LD + C_Z + h * 64 + pp]);
        const float yv = (yacc[pt][r] + xv * dsk) * silu_f(zv);
        AY[tok * 1024 + 512 + h * 64 + pp] = f2bf(yv);
      }
    {
      const float dec = fa[128 + 127];
#pragma unroll
      for (int i = 0; i < 4; ++i)
#pragma unroll
        for (int r = 0; r < 4; ++r) st[i][r] *= dec;
#pragma unroll
      for (int ks = 0; ks < 4; ++ks) {
        const bf16x8 xr = tr_frag(Xl, 72, ks * 32, pw * 16, l15, lq);
        bf16x8 xf;
#pragma unroll
        for (int j = 0; j < 8; ++j) xf[j] = (short)f2bf(bf2f((bf16_t)xr[j]) * fa[256 + ks * 32 + lq * 8 + j]);
#pragma unroll
        for (int i = 0; i < 4; ++i) {
          const bf16x8 bfv = tr_frag(Bl, 136, ks * 32, (nq + i) * 16, l15, lq);
          st[i] = mfma16(xf, bfv, st[i]);
        }
      }
    }
    __syncthreads();
  }
}

__device__ __forceinline__ void phase_mix(const Ctx& c0) {
  int* sitem = (int*)(c0.smem + SMEM_MAIN);
  int* qctr = (int*)(c0.ws + OFF_CTL) + CTL_QCTR + c0.pass;
  const int n_items = 128 + 2048;
  for (;;) {
    int tid = c0.tid; asm volatile("" : "+v"(tid));
    size_t wz = 0; asm volatile("" : "+s"(wz));
    char* ws = c0.ws + wz;
    const Ctx c{c0.p, ws, c0.smem, tid, c0.bid, c0.nblk, c0.f, c0.pass};
    char* smem = c.smem;
    if (tid == 0) *sitem = atomicAdd(qctr, 1);
    __syncthreads();
    const int item = *sitem;
    __syncthreads();
    if (item >= n_items) break;
#ifndef TEST_NO_SSD
    if (item < 128) {
      ssd_item(c, item >> 3, item & 7);
    } else
#endif
    {
#ifndef TEST_NO_ATTN
      const int it = item - 128;
      const int qb = 15 - (it >> 7), bh = it & 127;
      const bf16_t* Q = (const bf16_t*)(ws + OFF_Q) + ((long)bh * 4096 + qb * 256) * 96;
      const bf16_t* K = (const bf16_t*)(ws + OFF_K) + (long)bh * 4096 * 96;
      const bf16_t* Vt = (const bf16_t*)(ws + OFF_VT) + (long)bh * 64 * 4096;
      const int b = bh >> 3, h = bh & 7;
      bf16_t* O = (bf16_t*)(ws + OFF_R1) + ((long)b * 4096 + qb * 256) * 1024 + h * 64;
      attn_block<96, true>(Q, 96, K, 96, Vt, 4096, 4 * qb + 4, qb * 256, O, 1024, smem, c.tid);
#endif
    }
  }
}

__device__ __forceinline__ void phase_ynorm(const Ctx& c) {
  bf16_t* AY = (bf16_t*)(c.ws + OFF_R1);
  const int bid = c.bid, nblk = c.nblk;
  const int lane = c.tid & 63;
  const int gw = bid * NWAV + (c.tid >> 6), nw = nblk * NWAV;
  for (int row = gw; row < NT; row += nw) {
    bf16_t* ptr = AY + (long)row * 1024 + 512 + lane * 8;
    const uint4 u = *(const uint4*)ptr;
    float v[8] = {bflo(u.x), bfhi(u.x), bflo(u.y), bfhi(u.y), bflo(u.z), bfhi(u.z), bflo(u.w), bfhi(u.w)};
    float ss = 0.f;
#pragma unroll
    for (int j = 0; j < 8; ++j) ss += v[j] * v[j];
    ss = wave_sum(ss, lane);
    const float r = rsqrtf(ss * (1.f / 512.f) + EPS);
    *(uint4*)ptr = make_uint4(pack2(v[0] * r, v[1] * r), pack2(v[2] * r, v[3] * r), pack2(v[4] * r, v[5] * r), pack2(v[6] * r, v[7] * r));
  }
}

__device__ __forceinline__ void phase_gemm_out(const Ctx& c) {
  char* ws = c.ws;
  DenseOrder S; S.init(ws + OFF_R1, 1024, ws + OFF_WOUT_T, 1024, NT, 1024, c.nblk, c.bid, 0);
  EpiRes<0> E{ws, INP(I_X), c.p.out, (float*)(ws + OFF_SSQA), nullptr, nullptr, 1.f};
  fast_gemm((LAS3 unsigned char*)c.smem, S, E, 1024, c.tid);
}

__device__ __forceinline__ void phase_pool_gemm(const Ctx& c) {
  char* ws = c.ws;
  DenseOrder S; S.init(ws + OFF_R1, 1024, ws + OFF_POOL_T, 256, NT, 1024, c.nblk, c.bid, 512);
  EpiRes<2> E{ws, nullptr, c.p.out, (float*)(ws + OFF_SSQA), INP(I_POOL_B), INP(I_POOL_SCALE), c.f};
  fast_gemm((LAS3 unsigned char*)c.smem, S, E, 256, c.tid);
}

__device__ __forceinline__ void phase_xq(const Ctx& c, int l) {
  char* ws = c.ws; char* smem = c.smem; const int bid = c.bid, nblk = c.nblk; (void)smem; (void)bid; (void)nblk;
  const int t = c.tid, er = t >> 1, eh = t & 1;
  const float* Cs = (const float*)smem;
  for (int item = bid; item < 512 * 2; item += nblk) {
    const int mt = item >> 1, nt = item & 1;
    gemm_dense((const bf16_t*)(ws + OFF_XCB) + (long)mt * 128 * 1024, 1024,
               (const bf16_t*)(ws + OFF_XQ_T) + (long)l * 256 * 1024 + (long)nt * 128 * 1024, 1024, 1024, smem, c.tid);
    if (t < 256) {
      const int row = mt * 128 + er;
      const float rs = row_rs32((const float*)(ws + OFF_SSQA), row);
      const float* crow = Cs + er * CS_LD + eh * 64;
      const float ss = cs_ssq(crow, 64) * rs * rs;
      const float r = rsqrtf(ss * (1.f / 64.f) + EPS) * rs * (0.125f * LOG2E);
      const float* g = INP(I_XQ_NORM) + l * 64;
      cs_store_scaled((bf16_t*)(ws + OFF_XQ) + (long)row * 256 + (nt * 2 + eh) * 64, crow, 64, r, g);
    }
    __syncthreads();
  }
}

__device__ __forceinline__ void phase_xattn(const Ctx& c, int l) {
  char* ws = c.ws; char* smem = c.smem; const int bid = c.bid, nblk = c.nblk; (void)smem; (void)bid; (void)nblk;
  for (int item = bid; item < 256 * 4; item += nblk) {
    const int mt = item >> 2, h = item & 3;
    const int b = mt >> 4;
    const bf16_t* Q = (const bf16_t*)(ws + OFF_XQ) + (long)mt * 256 * 256 + h * 64;
    const bf16_t* K = (const bf16_t*)(ws + OFF_MEMK) + (long)l * 4096 * 256 + (long)b * 256 * 256 + h * 64;
    const bf16_t* Vt = (const bf16_t*)(ws + OFF_MEMVT) + (long)l * 4096 * 256 + (long)(b * 4 + h) * 64 * 256;
    bf16_t* O = (bf16_t*)(ws + OFF_XO) + (long)mt * 256 * 256 + h * 64;
    attn_block<64, false>(Q, 256, K, 256, Vt, 256, 4, 0, O, 256, smem, c.tid);
  }
}

__device__ __forceinline__ void phase_xo(const Ctx& c, int l) {
  char* ws = c.ws;
  DenseOrder S; S.init(ws + OFF_XO, 256, ws + OFF_XO_T + (size_t)l * 1024 * 256 * 2, 256, NT, 1024, c.nblk, c.bid, 0);
  EpiRes<1> E{ws, nullptr, c.p.out, (float*)(ws + OFF_SSQB), nullptr, nullptr, c.f};
  fast_gemm((LAS3 unsigned char*)c.smem, S, E, 256, c.tid);
}

__device__ __forceinline__ void phase_router(const Ctx& c, int l) {
  char* ws = c.ws; char* smem = c.smem; const int bid = c.bid, nblk = c.nblk; (void)smem; (void)bid; (void)nblk;
  const int t = c.tid;
  float* hs = (float*)smem;
  float* wsl = hs + 128 * 65;
  float* lg = wsl + 64 * 36;
  const float* lnf = INP(I_LN_FFN) + l * 1024;
  const float* rgw = INP(I_RG_W) + l * 1024 * 4;
  const float* rew = INP(I_RE_W) + l * 1024 * 32;
  int* cnt = (int*)(ws + OFF_CTL) + CTL_CNT + l * 32;
  int* list = (int*)(ws + OFF_LIST);
  float* gate = (float*)(ws + OFF_GATE);
  for (int item = bid; item < NT / 128; item += nblk) {
    const int tok0 = item * 128;
    const int tk = t >> 2, q = t & 3;
    float acc[9];
#pragma unroll
    for (int j = 0; j < 9; ++j) acc[j] = 0.f;
    for (int kc = 0; kc < 16; ++kc) {
#pragma unroll
      for (int i = 0; i < 4; ++i) {
        const int r = (t >> 4) + 32 * i, cc = (t & 15) * 4;
        const int row = tok0 + r;
        const float rs = row_rs32((const float*)(ws + OFF_SSQB), row);
        const float4 v = *(const float4*)(c.p.out + (long)row * 1024 + kc * 64 + cc);
        const float4 gn = *(const float4*)(lnf + kc * 64 + cc);
        hs[r * 65 + cc] = v.x * rs * gn.x; hs[r * 65 + cc + 1] = v.y * rs * gn.y; hs[r * 65 + cc + 2] = v.z * rs * gn.z; hs[r * 65 + cc + 3] = v.w * rs * gn.w;
      }
      for (int i = t; i < 64 * 36; i += NTHR) {
        const int d = i / 36, o = i % 36;
        wsl[i] = (o < 4) ? rgw[(kc * 64 + d) * 4 + o] : rew[(kc * 64 + d) * 32 + (o - 4)];
      }
      __syncthreads();
      for (int d = 0; d < 64; ++d) {
        const float hv = hs[tk * 65 + d];
#pragma unroll
        for (int j = 0; j < 9; ++j) acc[j] += hv * wsl[d * 36 + q * 9 + j];
      }
      __syncthreads();
    }
#pragma unroll
    for (int j = 0; j < 9; ++j) lg[tk * 36 + q * 9 + j] = acc[j];
    __syncthreads();
    if (q == 0) {
      const int tok = tok0 + tk;
      ((float*)(ws + OFF_RS2))[tok] = row_rs32((const float*)(ws + OFF_SSQB), tok);
      const float* L = lg + tk * 36;
      float gl[4];
#pragma unroll
      for (int i = 0; i < 4; ++i) gl[i] = L[i] + INP(I_RG_B)[l * 4 + i];
      int gi = 0; float gm = gl[0];
#pragma unroll
      for (int i = 1; i < 4; ++i) if (gl[i] > gm) { gm = gl[i]; gi = i; }
      float gsum = 0.f;
#pragma unroll
      for (int i = 0; i < 4; ++i) gsum += __expf(gl[i] - gm);
      const float gp = 1.f / gsum;
      float e0 = -3e38f, e1 = -3e38f; int i0 = 0, i1 = 0;
      for (int j = 0; j < 8; ++j) {
        const float v = L[4 + gi * 8 + j] + INP(I_RE_B)[l * 32 + gi * 8 + j];
        if (v > e0) { e1 = e0; i1 = i0; e0 = v; i0 = j; }
        else if (v > e1) { e1 = v; i1 = j; }
      }
      const float p1 = __expf(e1 - e0);
      const float g0 = gp / (1.f + p1), g1 = gp * p1 / (1.f + p1);
      const int x0 = gi * 8 + i0, x1 = gi * 8 + i1;
      if (c.f != 0.f) {
        const int pos0 = atomicAdd(&cnt[x0], 1);
        list[x0 * 65536 + pos0] = tok * 2;
        const int pos1 = atomicAdd(&cnt[x1], 1);
        list[x1 * 65536 + pos1] = tok * 2 + 1;
        gate[tok * 2] = g0; gate[tok * 2 + 1] = g1;
      }
    }
    __syncthreads();
  }
}

__device__ __forceinline__ int expert_prefix(const int* cnt, int* pre, int tid) {
  if (tid == 0) {
    int s = 0;
    for (int e = 0; e < 32; ++e) { pre[e] = s; s += (cnt[e] + 255) >> 8; }
    pre[32] = s;
  }
  __syncthreads();
  return pre[32];
}

struct ExpertOrder {
  static constexpr bool GATHER = true;
  const char* A; const char* W; const int* list; const int* cnt; const int* pre; int lda_, ldb_, nN, total, G, c, which; size_t wstride;
  __device__ __forceinline__ bool next(int i, FUnit& u) const {
    const long L = (long)i * G + c; if (L >= (long)total * nN) return false;
    const int tile = (int)(L / nN); u.pn = (int)(L % nN); u.pm = tile;
    int e = 0;
    for (int j = 1; j < 32; ++j) if (pre[j] <= tile) e = j;
    e = __builtin_amdgcn_readfirstlane(e);
    u.e = e; u.pos0 = __builtin_amdgcn_readfirstlane((tile - pre[e]) * 256);
    u.nvalid = __builtin_amdgcn_readfirstlane(min(256, cnt[e] - u.pos0)); return true;
  }
  __device__ __forceinline__ unsigned lda() const { return (unsigned)lda_; }
  __device__ __forceinline__ unsigned ldb() const { return (unsigned)ldb_; }
  __device__ __forceinline__ const char* a_ptr(const FUnit&) const { return A; }
  __device__ __forceinline__ const char* b_ptr(const FUnit& u) const { return W + (size_t)u.e * wstride + (size_t)u.pn * 256 * ldb_ * 2; }
  __device__ __forceinline__ void a_offs(const FUnit& u, int tid, unsigned (&va)[2][2]) const {
    int R0, C0, R1, C1; fg_stage_rc(tid * 16, R0, C0); fg_stage_rc(tid * 16 + 8192, R1, C1);
    const int* lp = list + u.e * 65536 + u.pos0;
#pragma unroll
    for (int h = 0; h < 2; ++h) {
      const int p0 = lp[min(128 * h + R0, u.nvalid - 1)], p1 = lp[min(128 * h + R1, u.nvalid - 1)];
      const int r0 = which == 0 ? (p0 >> 1) : p0, r1 = which == 0 ? (p1 >> 1) : p1;
      va[h][0] = (unsigned)(r0 * lda_ + C0) * 2u; va[h][1] = (unsigned)(r1 * lda_ + C1) * 2u;
    }
  }
};

struct EpiExpUp {
  char* ws; const int* list;
  __device__ __forceinline__ void operator()(const f32x4 (&acc)[2][2][4][2], const FUnit& u, int wr, int wc, int fr, int fq, int lane) const {
    const float* rs2 = (const float*)(ws + OFF_RS2);
    bf16_t* hb = (bf16_t*)(ws + OFF_HBUF);
#pragma unroll
    for (int ai = 0; ai < 2; ++ai)
#pragma unroll
      for (int m = 0; m < 4; ++m) {
        const int rl = ai * 128 + wr * 64 + m * 16 + fr;
        const int pair = list[u.e * 65536 + u.pos0 + min(rl, u.nvalid - 1)];
        const float rs = rs2[pair >> 1];
        if (rl < u.nvalid) {
#pragma unroll
          for (int bj = 0; bj < 2; ++bj) {
            const f32x4 g4 = acc[ai][bj][m][0] * rs, u4 = acc[ai][bj][m][1] * rs;
            const int col = u.pn * 128 + bj * 64 + wc * 16 + fq * 4;
            uint2 w2; w2.x = cvt_pk_bf16(silu_f(g4[0]) * u4[0], silu_f(g4[1]) * u4[1]); w2.y = cvt_pk_bf16(silu_f(g4[2]) * u4[2], silu_f(g4[3]) * u4[3]);
            *(uint2*)(hb + (long)pair * 256 + col) = w2;
          }
        }
      }
  }
};
struct EpiExpDown {
  char* ws; const int* list;
  __device__ __forceinline__ void operator()(const f32x4 (&acc)[2][2][4][2], const FUnit& u, int wr, int wc, int fr, int fq, int lane) const {
    const float* gate = (const float*)(ws + OFF_GATE);
    bf16_t* yb = (bf16_t*)(ws + OFF_R2);
#pragma unroll
    for (int ai = 0; ai < 2; ++ai)
#pragma unroll
      for (int m = 0; m < 4; ++m) {
        const int rl = ai * 128 + wr * 64 + m * 16 + fr;
        const int pair = list[u.e * 65536 + u.pos0 + min(rl, u.nvalid - 1)];
        const float gt = gate[pair];
        if (rl < u.nvalid) {
#pragma unroll
          for (int bj = 0; bj < 2; ++bj) {
            const f32x4 v0 = acc[ai][bj][m][0] * gt, v1 = acc[ai][bj][m][1] * gt;
            const int col0 = u.pn * 256 + bj * 128 + wc * 32 + fq * 8;
            u32x4 w4; w4.x = cvt_pk_bf16(v0[0], v0[1]); w4.y = cvt_pk_bf16(v0[2], v0[3]); w4.z = cvt_pk_bf16(v1[0], v1[1]); w4.w = cvt_pk_bf16(v1[2], v1[3]);
            *(u32x4*)(yb + (long)pair * 1024 + col0) = w4;
          }
        }
      }
  }
};

template <int WHICH>
__device__ __forceinline__ void phase_expert(const Ctx& c, int l) {
  char* ws = c.ws; char* smem = c.smem;
  int* pre = (int*)(smem + SMEM_MAIN + 16);
  const int* cnt = (const int*)(ws + OFF_CTL) + CTL_CNT + l * 32;
  const int* list = (const int*)(ws + OFF_LIST);
  const int ttiles = expert_prefix(cnt, pre, c.tid);
  ExpertOrder S;
  S.list = list; S.cnt = cnt; S.pre = pre; S.total = ttiles; S.G = c.nblk; S.c = c.bid; S.which = WHICH;
  if (WHICH == 0) {
    S.A = ws + OFF_XCB; S.lda_ = 1024; S.W = ws + OFF_WGU_T + (size_t)l * 32 * 512 * 1024 * 2; S.ldb_ = 1024; S.nN = 2; S.wstride = (size_t)512 * 1024 * 2;
    EpiExpUp E{ws, list};
    fast_gemm((LAS3 unsigned char*)smem, S, E, 1024, c.tid);
  } else {
    S.A = ws + OFF_HBUF; S.lda_ = 256; S.W = ws + OFF_WD_T + (size_t)l * 32 * 1024 * 256 * 2; S.ldb_ = 256; S.nN = 4; S.wstride = (size_t)1024 * 256 * 2;
    EpiExpDown E{ws, list};
    fast_gemm((LAS3 unsigned char*)smem, S, E, 256, c.tid);
  }
}

__device__ __forceinline__ void phase_combine(const Ctx& c, int l) {
  char* ws = c.ws; char* smem = c.smem; const int bid = c.bid, nblk = c.nblk; (void)smem; (void)bid; (void)nblk;
  const int lane = c.tid & 63;
  const int gw = bid * NWAV + (c.tid >> 6), nw = nblk * NWAV;
  const bf16_t* yb = (const bf16_t*)(ws + OFF_R2);
  bf16_t* xnb = (bf16_t*)(ws + OFF_R4);
  for (int row = gw; row < NT; row += nw) {
    float* o = c.p.out + (long)row * 1024;
    float v[16]; float ss = 0.f;
#pragma unroll
    for (int i = 0; i < 4; ++i) {
      const int cc = i * 256 + lane * 4;
      float4 x = *(const float4*)(o + cc);
      const uint2 a = *(const uint2*)(yb + (long)(row * 2) * 1024 + cc), b2 = *(const uint2*)(yb + (long)(row * 2 + 1) * 1024 + cc);
      x.x += c.f * (bflo(a.x) + bflo(b2.x)); x.y += c.f * (bfhi(a.x) + bfhi(b2.x)); x.z += c.f * (bflo(a.y) + bflo(b2.y)); x.w += c.f * (bfhi(a.y) + bfhi(b2.y));
      *(float4*)(o + cc) = x;
      v[i * 4] = x.x; v[i * 4 + 1] = x.y; v[i * 4 + 2] = x.z; v[i * 4 + 3] = x.w;
      ss += x.x * x.x + x.y * x.y + x.z * x.z + x.w * x.w;
    }
    if (l == 0) {
      ss = wave_sum(ss, lane);
      const float r = rsqrtf(ss * (1.f / 1024.f) + EPS);
#pragma unroll
      for (int i = 0; i < 4; ++i)
        *(uint2*)(xnb + (long)row * 1024 + i * 256 + lane * 4) = make_uint2(pack2(v[i * 4] * r, v[i * 4 + 1] * r), pack2(v[i * 4 + 2] * r, v[i * 4 + 3] * r));
    }
  }
}

__device__ __forceinline__ void phase_pool_dlt(const Ctx& c) {
  char* ws = c.ws; char* smem = c.smem; const int bid = c.bid, nblk = c.nblk; (void)smem; (void)bid; (void)nblk;
  const bf16_t* xnb = (const bf16_t*)(ws + OFF_R4);
  bf16_t* dl = (bf16_t*)(ws + OFF_R1);
  const long gt = (long)bid * NTHR + c.tid, gn = (long)nblk * NTHR;
  for (long i = gt; i < (long)NT * 128; i += gn) {
    const int tok = (int)(i >> 7), ch = (int)(i & 127) * 8;
    const int s = tok & 4095;
    const int wnd = 2 << (ch >> 8);
    const int n = min(s + 1, wnd);
    float a[8] = {0.f, 0.f, 0.f, 0.f, 0.f, 0.f, 0.f, 0.f};
    float self[8];
    for (int k = 0; k < n; ++k) {
      const uint4 u = *(const uint4*)(xnb + (long)(tok - k) * 1024 + ch);
      const float f[8] = {bflo(u.x), bfhi(u.x), bflo(u.y), bfhi(u.y), bflo(u.z), bfhi(u.z), bflo(u.w), bfhi(u.w)};
#pragma unroll
      for (int j = 0; j < 8; ++j) { a[j] += f[j]; if (k == 0) self[j] = f[j]; }
    }
    const float inv = 1.f / (float)n;
#pragma unroll
    for (int j = 0; j < 8; ++j) a[j] = a[j] * inv - self[j];
    *(uint4*)(dl + (long)tok * 1024 + ch) = make_uint4(pack2(a[0], a[1]), pack2(a[2], a[3]), pack2(a[4], a[5]), pack2(a[6], a[7]));
  }
}

#define XB_TMO      128
#define XB_XCNT(j)  (256  + 64 * (j))
#define XB_XSUB(j)  (1280 + 64 * (j))
#define XB_XGEN(j)  (2304 + 64 * (j))
#define XB_TOP      3328
#define XB_TOPGEN   3392
#define XCD_BAR_WORDS 3456
#define XB_SPIN_CAP (1u << 22)
#define LAS __attribute__((address_space(3)))
__device__ __forceinline__ unsigned xb_ld(unsigned* p)              { return __hip_atomic_load(p, __ATOMIC_RELAXED, __HIP_MEMORY_SCOPE_AGENT); }
__device__ __forceinline__ unsigned xb_add(unsigned* p, unsigned v) { return __hip_atomic_fetch_add(p, v, __ATOMIC_RELAXED, __HIP_MEMORY_SCOPE_AGENT); }
__device__ __forceinline__ unsigned xb_xcc_id() { return (unsigned)__builtin_amdgcn_s_getreg((3 << 11) | 20) & 0xFu; }
#define XB_SPIN(cond, bar) do { unsigned _sp = 0; while (cond) { __builtin_amdgcn_s_sleep(1); \
    if ((++_sp & 255u) == 0u) { if (xb_ld(&(bar)[XB_TMO])) break; if (_sp > XB_SPIN_CAP) { atomicAdd(&(bar)[XB_TMO], 1u); break; } } } } while (0)
struct XcdBarrier { unsigned* bar; unsigned x; volatile LAS unsigned* st; };
__device__ __forceinline__ XcdBarrier xcd_barrier_post(unsigned* bar, volatile LAS unsigned* st) {
  XcdBarrier b; b.bar = bar; b.x = xb_xcc_id(); b.st = st;
  if (threadIdx.x == 0) (void)xb_add(&bar[XB_XCNT(b.x)], 1u);
  return b;
}
__device__ __forceinline__ void xcd_barrier_complete(unsigned* bar, unsigned x, unsigned& nloc, unsigned& nx) {
  const unsigned G = gridDim.x * gridDim.y * gridDim.z;
  unsigned sum, cnt, mine, sp = 0u;
  for (;;) {
    sum = 0u; cnt = 0u; mine = 0u;
#pragma unroll
    for (unsigned j = 0; j < 16; ++j) { const unsigned cc = xb_ld(&bar[XB_XCNT(j)]); sum += cc; cnt += (cc > 0u) ? 1u : 0u; mine = (j == x) ? cc : mine; }
    if (sum == G) break;
    __builtin_amdgcn_s_sleep(1);
    if ((++sp & 255u) == 0u) { if (xb_ld(&bar[XB_TMO])) break; if (sp > XB_SPIN_CAP) { atomicAdd(&bar[XB_TMO], 1u); break; } }
  }
  nloc = mine > 0u ? mine : 1u; nx = cnt > 0u ? cnt : 1u;
}
__device__ __forceinline__ void xcd_barrier(const XcdBarrier& b) {
  asm volatile("s_waitcnt vmcnt(0)" ::: "memory");
  __syncthreads();
  if (threadIdx.x == 0) {
    unsigned* bar = b.bar;
    __builtin_amdgcn_s_waitcnt(0);
    unsigned nloc = b.st[0], nx = b.st[1];
    if (nloc == 0u) { xcd_barrier_complete(bar, b.x, nloc, nx); b.st[0] = nloc; b.st[1] = nx; }
    const unsigned old = xb_add(&bar[XB_XSUB(b.x)], 1u);
    const unsigned gen = old / nloc;
    if (old + 1u == (gen + 1u) * nloc) {
      __builtin_amdgcn_fence(__ATOMIC_RELEASE, "agent");
      asm volatile("s_waitcnt vmcnt(0)" ::: "memory");
      const unsigned og = xb_add(&bar[XB_TOP], 1u);
      const unsigned tg = og / nx;
      if (og + 1u == (tg + 1u) * nx) xb_add(&bar[XB_TOPGEN], 1u);
      else XB_SPIN(xb_ld(&bar[XB_TOPGEN]) == tg, bar);
      __builtin_amdgcn_fence(__ATOMIC_ACQUIRE, "agent");
      xb_add(&bar[XB_XGEN(b.x)], 1u);
      asm volatile("s_waitcnt vmcnt(0)" ::: "memory");
    } else {
      XB_SPIN(xb_ld(&bar[XB_XGEN(b.x)]) == gen, bar);
      __builtin_amdgcn_fence(__ATOMIC_ACQUIRE, "agent");
      asm volatile("s_waitcnt vmcnt(0)" ::: "memory");
    }
  }
  __syncthreads();
}

constexpr int N_PHASES = 22;
#define RUN_PHASE(PH, CALL) do { \
    constexpr int nrep_ = ((PROBE_MASK >> (PH)) & 1u) ? 2 : 1; \
    _Pragma("unroll 1") for (int rep_ = 0; rep_ < nrep_; ++rep_) { \
      int tid = threadIdx.x; asm volatile("" : "+v"(tid)); \
      size_t wz = 0; asm volatile("" : "+s"(wz)); \
      char* ws = p.ws + wz; \
      int bid = blockIdx.x; asm volatile("" : "+s"(bid)); \
      int nblk = gridDim.x; asm volatile("" : "+s"(nblk)); \
      const Ctx c{p, ws, smem, tid, bid, nblk, (PROBE_MASK != 0u && rep_) ? 0.f : 1.f, rep_}; \
      CALL; \
      if ((PH) + 1 < N_PHASES || rep_ + 1 < nrep_) xcd_barrier(xb); \
    } } while (0)

__global__ void __launch_bounds__(NTHR, 2) fwd_megakernel(Params p) {
  extern __shared__ __attribute__((aligned(16))) char smem[];
  volatile LAS unsigned* xst = (volatile LAS unsigned*)(smem + SMEM_MAIN + 256);
  if (threadIdx.x < 4) xst[threadIdx.x] = 0u;
  __syncthreads();
  const XcdBarrier xb = xcd_barrier_post((unsigned*)(p.ws + OFF_BAR), xst);
  RUN_PHASE(0, phase_prep(c));
  RUN_PHASE(1, phase_gemm_in(c));
  RUN_PHASE(2, phase_up(c));
  RUN_PHASE(3, phase_mix(c));
  RUN_PHASE(4, phase_ynorm(c));
  RUN_PHASE(5, phase_gemm_out(c));
  RUN_PHASE(6, phase_xq(c, 0));
  RUN_PHASE(7, phase_xattn(c, 0));
  RUN_PHASE(8, phase_xo(c, 0));
  RUN_PHASE(9, phase_router(c, 0));
  RUN_PHASE(10, phase_expert<0>(c, 0));
  RUN_PHASE(11, phase_expert<1>(c, 0));
  RUN_PHASE(12, phase_combine(c, 0));
  RUN_PHASE(13, phase_pool_dlt(c));
  RUN_PHASE(14, phase_pool_gemm(c));
  RUN_PHASE(15, phase_xq(c, 1));
  RUN_PHASE(16, phase_xattn(c, 1));
  RUN_PHASE(17, phase_xo(c, 1));
  RUN_PHASE(18, phase_router(c, 1));
  RUN_PHASE(19, phase_expert<0>(c, 1));
  RUN_PHASE(20, phase_expert<1>(c, 1));
  RUN_PHASE(21, phase_combine(c, 1));
}

extern "C" void kernel_launch(void* const* d_in, const int* in_sizes, int n_in, void* d_out,
                              int out_size, void* d_ws, size_t ws_size, hipStream_t stream) {
  static int grid_blocks = 0;
  if (!grid_blocks) {
    int dev = 0, cus = 0, per_cu = 0;
    (void)hipGetDevice(&dev);
    (void)hipDeviceGetAttribute(&cus, hipDeviceAttributeMultiprocessorCount, dev);
    (void)hipFuncSetAttribute((const void*)fwd_megakernel, hipFuncAttributeMaxDynamicSharedMemorySize, SMEM_BYTES);
    (void)hipOccupancyMaxActiveBlocksPerMultiprocessor(&per_cu, fwd_megakernel, NTHR, SMEM_BYTES);
    if (per_cu > 1) per_cu = 1;
    if (per_cu < 1) per_cu = 1;
    grid_blocks = cus * per_cu;
    if (ws_size < WS_END) { fprintf(stderr, "workspace too small: %zu < %zu\n", ws_size, (size_t)WS_END); grid_blocks = -1; }
    if (n_in != N_IN) { fprintf(stderr, "unexpected n_in %d\n", n_in); grid_blocks = -1; }
  }
  if (grid_blocks < 0) return;
  Params p{};
  for (int i = 0; i < N_IN; ++i) p.in[i] = d_in[i];
  p.out = (float*)d_out;
  p.ws = (char*)d_ws;
  (void)hipMemsetAsync((char*)d_ws + OFF_BAR, 0, 16384, stream);
  void* args[] = {&p};
  hipError_t e = hipLaunchCooperativeKernel((void*)fwd_megakernel, dim3(grid_blocks), dim3(NTHR), args, SMEM_BYTES, stream);
  if (e != hipSuccess) fprintf(stderr, "cooperative launch failed: %s (grid %d)\n", hipGetErrorString(e), grid_blocks);
}
```

```cpp
#include <hip/hip_runtime.h>
#include <hip/hip_cooperative_groups.h>
#include <cstdio>
#include <cstdint>
namespace cg = cooperative_groups;

#ifndef MULTI_LAUNCH
#define MULTI_LAUNCH 0
#endif

typedef unsigned short bf16_t;
typedef short bf16x8 __attribute__((ext_vector_type(8)));
typedef float f32x4 __attribute__((ext_vector_type(4)));
typedef unsigned u32x4 __attribute__((ext_vector_type(4)));

constexpr int NT = 65536, DM = 1024, SEQ = 4096, NB = 16;
constexpr int NTHR = 512, NWAV = 8;
constexpr int PROJ_LD = 2048;
constexpr int C_QLAT = 0, C_KVLAT = 256, C_KROPE = 384, C_Z = 416, C_XBC = 928, C_DT = 1952;
constexpr float EPS = 1e-6f;
constexpr float LOG2E = 1.4426950408889634f;

enum { I_X = 0, I_MEM, I_POS, I_LN_MIX, I_W_IN, I_QLAT_NORM, I_W_UQ, I_KVLAT_NORM, I_W_UKV, I_Q_NORM, I_K_NORM,
       I_CONV_W, I_CONV_B, I_DT_BIAS, I_A_LOG, I_D_SKIP, I_SSD_NORM, I_W_OUT, I_POOL_W, I_POOL_B, I_POOL_SCALE,
       I_LN_XQ, I_LN_MEM, I_XQ_W, I_XKV_W, I_XQ_NORM, I_XK_NORM, I_XO_W, I_LN_FFN, I_RG_W, I_RG_B, I_RE_W, I_RE_B,
       I_EXP_G, I_EXP_U, I_EXP_D, N_IN };

constexpr size_t MiB = 1ull << 20;
constexpr size_t OFF_WIN_T = 0;
constexpr size_t OFF_WUQ_T = OFF_WIN_T + 2048ull * 1024 * 2;
constexpr size_t OFF_WUKV_T = OFF_WUQ_T + 1024ull * 256 * 2;
constexpr size_t OFF_WOUT_T = OFF_WUKV_T + 1024ull * 128 * 2;
constexpr size_t OFF_POOL_T = OFF_WOUT_T + 1024ull * 1024 * 2;
constexpr size_t OFF_XQ_T = OFF_POOL_T + 4ull * 256 * 256 * 2;
constexpr size_t OFF_XKV_T = OFF_XQ_T + 2ull * 256 * 1024 * 2;
constexpr size_t OFF_XO_T = OFF_XKV_T + 2ull * 512 * 1024 * 2;
constexpr size_t OFF_WGU_T = OFF_XO_T + 2ull * 1024 * 256 * 2;
constexpr size_t OFF_WD_T = OFF_WGU_T + 64ull * 512 * 1024 * 2;
constexpr size_t OFF_R1 = OFF_WD_T + 64ull * 1024 * 256 * 2;
constexpr size_t OFF_R2 = OFF_R1 + 128 * MiB;
constexpr size_t OFF_R3 = OFF_R2 + 256 * MiB;
constexpr size_t OFF_R4 = OFF_R3 + 256 * MiB;
constexpr size_t OFF_MISC = OFF_R4 + 128 * MiB;
constexpr size_t OFF_Q = OFF_R3, OFF_K = OFF_R3 + 96 * MiB, OFF_VT = OFF_R3 + 192 * MiB;
constexpr size_t OFF_XCB = OFF_R3, OFF_XQ = OFF_R3 + 128 * MiB, OFF_XO = OFF_R3 + 160 * MiB, OFF_HBUF = OFF_R3 + 192 * MiB;
constexpr size_t OFF_RS0 = OFF_MISC;
constexpr size_t OFF_SSQ_Q = OFF_RS0 + NT * 4ull;
constexpr size_t OFF_SSQ_KV = OFF_SSQ_Q + NT * 32ull;
constexpr size_t OFF_DTRAW = OFF_SSQ_KV + NT * 16ull;
constexpr size_t OFF_DT = OFF_DTRAW + NT * 32ull;
constexpr size_t OFF_SSQA = OFF_DT + NT * 32ull;
constexpr size_t OFF_SSQB = OFF_SSQA + NT * 128ull;
constexpr size_t OFF_RS3 = OFF_SSQB + NT * 128ull;
constexpr size_t OFF_RS2 = OFF_RS3 + NT * 4ull;
constexpr size_t OFF_MEMB = OFF_RS2 + NT * 4ull;
constexpr size_t OFF_RSM = OFF_MEMB + 4096ull * 1024 * 2;
constexpr size_t OFF_MEMK = OFF_RSM + 4096 * 4ull;
constexpr size_t OFF_MEMVT = OFF_MEMK + 2ull * 4096 * 256 * 2;
constexpr size_t OFF_GATE = OFF_MEMVT + 2ull * 4096 * 256 * 2;
constexpr size_t OFF_LIST = OFF_GATE + NT * 8ull;
constexpr size_t OFF_CTL = OFF_LIST + 32ull * 65536 * 4;
constexpr size_t OFF_WR = OFF_CTL + 4096;
constexpr size_t OFF_BAR = OFF_WR + 2ull * 2 * 48 * 1024 * 2;
constexpr size_t WS_END = OFF_BAR + 16384;

constexpr int CTL_CNT = 0;
constexpr int CTL_QCTR = 64;

constexpr int LDS_ST = 72;
constexpr int CS_LD = 132;
constexpr int SMEM_BYTES = 160 * 1024;
constexpr int SMEM_MAIN = SMEM_BYTES - 1024;

struct Params {
  const void* in[N_IN];
  float* out;
  char* ws;
  int phase_lo, phase_hi;
};

#ifndef PROBE_MASK
#define PROBE_MASK 0u
#endif
struct Ctx { const Params& p; char* ws; char* smem; int tid, bid, nblk; float f; int pass; };
__device__ __forceinline__ int opq(int i) { asm volatile("" : "+s"(i)); return i; }
#define INP(i) ((const float*)c.p.in[opq(i)])

__device__ __forceinline__ bf16_t f2bf(float f) {
  unsigned u = __float_as_uint(f);
  u += 0x7fffu + ((u >> 16) & 1u);
  return (bf16_t)(u >> 16);
}
__device__ __forceinline__ float bf2f(bf16_t h) { return __uint_as_float(((unsigned)h) << 16); }
__device__ __forceinline__ unsigned pack2(float lo, float hi) { return (unsigned)f2bf(lo) | ((unsigned)f2bf(hi) << 16); }
__device__ __forceinline__ float bflo(unsigned u) { return __uint_as_float(u << 16); }
__device__ __forceinline__ float bfhi(unsigned u) { return __uint_as_float(u & 0xffff0000u); }
__device__ __forceinline__ float silu_f(float x) { return x / (1.f + __expf(-x)); }
template <int M> __device__ __forceinline__ float sxor(float v) {
  static_assert(M >= 1 && M < 32, "swizzle xor mask");
  return __int_as_float(__builtin_amdgcn_ds_swizzle(__float_as_int(v), (M << 10) | 0x1f));
}
__device__ __forceinline__ float lane_get(float v, int src_lane) { return __int_as_float(__builtin_amdgcn_ds_bpermute(src_lane << 2, __float_as_int(v))); }
__device__ __forceinline__ float wave_sum(float v, int lane) {
  v += sxor<1>(v); v += sxor<2>(v); v += sxor<4>(v); v += sxor<8>(v); v += sxor<16>(v);
  v += lane_get(v, lane ^ 32);
  return v;
}
typedef short s16x4 __attribute__((ext_vector_type(4)));
__device__ __forceinline__ bf16x8 tr_frag(const bf16_t* M, int ld, int k0, int n0, int l15, int lq) {
  const bf16_t* p0 = M + (k0 + 8 * lq + (l15 >> 2)) * ld + n0 + 4 * (l15 & 3);
  const s16x4 a = __builtin_amdgcn_ds_read_tr16_b64_v4i16((__attribute__((address_space(3))) s16x4*)p0);
  const s16x4 b = __builtin_amdgcn_ds_read_tr16_b64_v4i16((__attribute__((address_space(3))) s16x4*)(p0 + 4 * ld));
  return (bf16x8){a[0], a[1], a[2], a[3], b[0], b[1], b[2], b[3]};
}
__device__ __forceinline__ unsigned cvt_pk_bf16(float lo, float hi) { unsigned r; asm volatile("v_cvt_pk_bf16_f32 %0, %1, %2" : "=v"(r) : "v"(lo), "v"(hi)); return r; }
__device__ __forceinline__ f32x4 zero4() { float z = 0.f; asm volatile("" : "+v"(z)); return (f32x4){z, z, z, z}; }
__device__ __forceinline__ f32x4 mfma16(bf16x8 a, bf16x8 b, f32x4 c) { return __builtin_amdgcn_mfma_f32_16x16x32_bf16(a, b, c, 0, 0, 0); }

__device__ __forceinline__ void gemm_core(const char* Ab, const unsigned (&ao)[2], const char* Bb, const unsigned (&bo)[2], int K, char* smem, int tid) {
  const int t = tid, lane = t & 63, w = t >> 6;
  const int wr = w >> 1, wc = w & 1;
  const int l15 = lane & 15, lq = lane >> 4;
  bf16_t* As = (bf16_t*)smem;
  bf16_t* Bs = As + 2 * 128 * LDS_ST;
  const int srow = t >> 3, scol = (t & 7) * 8;
  const int nk = K >> 6;
  u32x4 ra0[2], rb0[2], ra1[2], rb1[2];
#define G_LOAD(RA, RB, KT) { const unsigned kk_ = (unsigned)((KT) < nk ? (KT) : nk - 1) * 128u; \
    _Pragma("unroll") for (int i = 0; i < 2; ++i) { RA[i] = *(const u32x4*)(Ab + (size_t)(ao[i] + kk_)); RB[i] = *(const u32x4*)(Bb + (size_t)(bo[i] + kk_)); } }
#define G_STORE(RA, RB, ST) { bf16_t* An_ = As + (ST) * 128 * LDS_ST; bf16_t* Bn_ = Bs + (ST) * 128 * LDS_ST; \
    _Pragma("unroll") for (int i = 0; i < 2; ++i) { *(u32x4*)(An_ + (srow + 64 * i) * LDS_ST + scol) = RA[i]; *(u32x4*)(Bn_ + (srow + 64 * i) * LDS_ST + scol) = RB[i]; } }
#define G_COMPUTE(ST) { const bf16_t* Ac = As + (ST) * 128 * LDS_ST; const bf16_t* Bc = Bs + (ST) * 128 * LDS_ST; \
    _Pragma("unroll") for (int ks = 0; ks < 2; ++ks) { bf16x8 af[2], bfr[4]; \
      _Pragma("unroll") for (int mt = 0; mt < 2; ++mt) af[mt] = *(const bf16x8*)(Ac + (wr * 32 + mt * 16 + l15) * LDS_ST + ks * 32 + lq * 8); \
      _Pragma("unroll") for (int nt = 0; nt < 4; ++nt) bfr[nt] = *(const bf16x8*)(Bc + (wc * 64 + nt * 16 + l15) * LDS_ST + ks * 32 + lq * 8); \
      _Pragma("unroll") for (int mt = 0; mt < 2; ++mt) _Pragma("unroll") for (int nt = 0; nt < 4; ++nt) acc[mt][nt] = mfma16(af[mt], bfr[nt], acc[mt][nt]); } }
  G_LOAD(ra0, rb0, 0)
  G_LOAD(ra1, rb1, 1)
  G_STORE(ra0, rb0, 0)
  __syncthreads();
  f32x4 acc[2][4];
#pragma unroll
  for (int i = 0; i < 2; ++i)
#pragma unroll
    for (int j = 0; j < 4; ++j) acc[i][j] = zero4();
  for (int kt = 0; kt < nk; kt += 2) {
    G_LOAD(ra0, rb0, kt + 2)
    __builtin_amdgcn_sched_barrier(0);
    G_COMPUTE(0)
    G_STORE(ra1, rb1, 1)
    __syncthreads();
    G_LOAD(ra1, rb1, kt + 3)
    __builtin_amdgcn_sched_barrier(0);
    G_COMPUTE(1)
    G_STORE(ra0, rb0, 0)
    __syncthreads();
  }
#undef G_LOAD
#undef G_STORE
#undef G_COMPUTE
  float* Cs = (float*)smem;
#pragma unroll
  for (int mt = 0; mt < 2; ++mt)
#pragma unroll
    for (int nt = 0; nt < 4; ++nt)
#pragma unroll
      for (int r = 0; r < 4; ++r)
        Cs[(wr * 32 + mt * 16 + lq * 4 + r) * CS_LD + wc * 64 + nt * 16 + l15] = acc[mt][nt][r];
  __syncthreads();
}

__device__ __forceinline__ void gemm_dense(const bf16_t* A, long lda, const bf16_t* Bt, long ldb, int K, char* smem, int tid) {
  const int t = tid;
  const int srow = t >> 3, scol = (t & 7) * 8;
  unsigned ao[2], bo[2];
#pragma unroll
  for (int i = 0; i < 2; ++i) { ao[i] = (unsigned)(((srow + 64 * i) * lda + scol) * 2); bo[i] = (unsigned)(((srow + 64 * i) * ldb + scol) * 2); }
  gemm_core((const char*)A, ao, (const char*)Bt, bo, K, smem, tid);
}

template <int N>
__device__ __forceinline__ void store_bf16_row(bf16_t* dst, const float (&v)[N]) {
#pragma unroll
  for (int j = 0; j < N; j += 8) {
    uint4 u;
    u.x = pack2(v[j], v[j + 1]); u.y = pack2(v[j + 2], v[j + 3]); u.z = pack2(v[j + 4], v[j + 5]); u.w = pack2(v[j + 6], v[j + 7]);
    *(uint4*)(dst + j) = u;
  }
}


#define LAS3 __attribute__((address_space(3)))
constexpr int FG_HTB = 128 * 64 * 2;
__device__ __forceinline__ int fg_lds_byte(int r, int c) { const int st = (r >> 4) * 2 + (c >> 5), rr = r & 15, cc = c & 31, ob = rr * 64 + cc * 2; return st * 1024 + (ob ^ (((ob >> 9) & 1) << 5)); }
__device__ __forceinline__ void fg_stage_rc(int b, int& R, int& C) { const int st = b / 1024, sb = b % 1024, swz = sb ^ (((sb >> 9) & 1) << 5); R = (st >> 1) * 16 + swz / 64; C = (st & 1) * 32 + (swz % 64) / 2; }
__device__ __forceinline__ int fg_perm32(int rho) { const int n = rho >> 4, i = rho & 15; return 8 * (i >> 2) + 4 * n + (i & 3); }
struct FUnit { int pm, pn, e, pos0, nvalid; };

template <class Epi, class Sched>
__device__ __forceinline__ void fast_gemm(LAS3 unsigned char* lds, const Sched& S, const Epi& E, int K, int tid_) {
  const int tid = tid_, wid = __builtin_amdgcn_readfirstlane(tid >> 6), lane = tid & 63, wr = wid >> 2, wc = wid & 3, fr = lane & 15, fq = lane >> 4;
  const int nt = K / 64;
  int R0, C0, R1, C1; fg_stage_rc(tid * 16, R0, C0); fg_stage_rc(tid * 16 + 8192, R1, C1);
  const unsigned ldb = S.ldb();
  unsigned voffB[2];
  voffB[0] = (unsigned)(((R0 & ~31) + fg_perm32(R0 & 31)) * ldb + C0) * 2u;
  voffB[1] = (unsigned)(((R1 & ~31) + fg_perm32(R1 & 31)) * ldb + C1) * 2u;
  const size_t kstep = 128;
  const size_t hstepB = (size_t)128 * ldb * 2;
  const unsigned ldsw = (unsigned)wid * 1024u;
  const int aoff = fg_lds_byte(wr * 64 + fr, fq * 8), boff = fg_lds_byte(wc * 32 + fr, fq * 8);
#define FG_SA(b, h) (((b) * 2 + (h)) * FG_HTB)
#define FG_SB(b, h) ((4 + (b) * 2 + (h)) * FG_HTB)
#define FG_STAGE(bufoff, gbase, voff) do { _Pragma("unroll") for (int _i = 0; _i < 2; ++_i) \
    __builtin_amdgcn_global_load_lds((const unsigned*)((const char*)(gbase) + (voff)[_i]), (LAS3 unsigned*)(lds + (bufoff) + ldsw + _i * 8192), 16, 0, 0); } while (0)
#define FG_LDA(dst, b, h) do { _Pragma("unroll") for (int m = 0; m < 4; ++m) _Pragma("unroll") for (int k = 0; k < 2; ++k) dst[m][k] = *(const LAS3 bf16x8*)(lds + FG_SA(b, h) + aoff + m * 2048 + k * 1024); } while (0)
#define FG_LDB(dst, b, h) do { _Pragma("unroll") for (int n = 0; n < 2; ++n) _Pragma("unroll") for (int k = 0; k < 2; ++k) dst[n][k] = *(const LAS3 bf16x8*)(lds + FG_SB(b, h) + boff + n * 2048 + k * 1024); } while (0)
#define FG_MMA(ai, bj, At, Bt) do { __builtin_amdgcn_s_setprio(1); _Pragma("unroll") for (int m = 0; m < 4; ++m) _Pragma("unroll") for (int n = 0; n < 2; ++n) _Pragma("unroll") for (int k = 0; k < 2; ++k) \
    acc[ai][bj][m][n] = __builtin_amdgcn_mfma_f32_16x16x32_bf16(Bt[n][k], At[m][k], acc[ai][bj][m][n], 0, 0, 0); __builtin_amdgcn_s_setprio(0); } while (0)
#define FG_WAIT_V(n) asm volatile("s_waitcnt vmcnt(" #n ")" ::: "memory")
#define FG_WAIT_L(n) asm volatile("s_waitcnt lgkmcnt(" #n ")" ::: "memory")
#define FG_BAR __builtin_amdgcn_s_barrier()
#define FG_SCHED __builtin_amdgcn_sched_barrier(0)
  FUnit cur, nxt; int ui = 0;
  if (!S.next(0, cur)) return;
  f32x4 acc[2][2][4][2];
#pragma unroll
  for (int a = 0; a < 2; ++a)
#pragma unroll
    for (int b = 0; b < 2; ++b)
#pragma unroll
      for (int m = 0; m < 4; ++m)
#pragma unroll
        for (int n = 0; n < 2; ++n) acc[a][b][m][n] = zero4();
  bf16x8 At[4][2], B0[2][2], B1[2][2];
  constexpr bool GA = Sched::GATHER;
  const unsigned lda = S.lda();
  const size_t hstepA = (size_t)128 * lda * 2;
  unsigned voffA[2];
  voffA[0] = (unsigned)(R0 * lda + C0) * 2u; voffA[1] = (unsigned)(R1 * lda + C1) * 2u;
  unsigned vaC[2][2], vaN[2][2];
  const char* cA = S.a_ptr(cur);
  if (GA) S.a_offs(cur, tid, vaC);
  const char* cB = S.b_ptr(cur);
#define FG_STAGE_A(bufoff, UPTR, KOFF, H, VG) do { if (GA) FG_STAGE(bufoff, (UPTR) + (KOFF), (VG)[H]); else FG_STAGE(bufoff, (UPTR) + (KOFF) + (H) * hstepA, voffA); } while (0)
  FG_STAGE(FG_SB(0, 0), cB, voffB); FG_STAGE_A(FG_SA(0, 0), cA, 0, 0, vaC); FG_STAGE(FG_SB(0, 1), cB + hstepB, voffB); FG_STAGE_A(FG_SA(0, 1), cA, 0, 1, vaC);
  if (wr == 1) FG_BAR;
  FG_WAIT_V(4); FG_BAR;
  FG_STAGE(FG_SB(1, 0), cB + kstep, voffB); FG_STAGE_A(FG_SA(1, 0), cA, kstep, 0, vaC); FG_STAGE(FG_SB(1, 1), cB + hstepB + kstep, voffB);
  FG_WAIT_V(6); FG_BAR;
  for (;;) {
    const bool has_next = S.next(ui + 1, nxt);
    if (!has_next) nxt = cur;
    if (GA) S.a_offs(nxt, tid, vaN);
    const char* nA = has_next ? S.a_ptr(nxt) : cA;
    const char* nB = has_next ? S.b_ptr(nxt) : cB;
#pragma unroll 1
    for (int t = 0; t < nt; t += 2) {
      const bool last = (t == nt - 2);
      const size_t k1 = (size_t)(t + 1) * kstep;
      const char* a2 = last ? nA : cA + (size_t)(t + 2) * kstep;
      const char* b2 = last ? nB : cB + (size_t)(t + 2) * kstep;
      const char* b3 = b2 + kstep;
      FG_LDB(B0, 0, 0); FG_SCHED; FG_LDA(At, 0, 0); FG_STAGE_A(FG_SA(1, 1), cA, k1, 1, vaC);
      FG_WAIT_L(8); FG_BAR; FG_WAIT_L(0); FG_MMA(0, 0, At, B0); FG_BAR; FG_SCHED;
      if (GA && last) {
#pragma unroll
        for (int h = 0; h < 2; ++h)
#pragma unroll
          for (int i = 0; i < 2; ++i) vaC[h][i] = vaN[h][i];
      }
      FG_LDB(B1, 0, 1); FG_STAGE(FG_SB(0, 0), b2, voffB);
      FG_BAR; FG_WAIT_L(0); FG_MMA(0, 1, At, B1); FG_BAR;
      FG_LDA(At, 0, 1); FG_STAGE_A(FG_SA(0, 0), a2, 0, 0, vaC);
      FG_BAR; FG_WAIT_L(0); FG_MMA(1, 0, At, B0); FG_BAR; FG_SCHED;
      FG_STAGE(FG_SB(0, 1), b2 + hstepB, voffB);
      FG_WAIT_V(6); FG_BAR; FG_MMA(1, 1, At, B1); FG_BAR;
      FG_LDB(B0, 1, 0); FG_SCHED; FG_LDA(At, 1, 0); FG_STAGE_A(FG_SA(0, 1), a2, 0, 1, vaC);
      FG_WAIT_L(8); FG_BAR; FG_WAIT_L(0); FG_MMA(0, 0, At, B0); FG_BAR; FG_SCHED;
      FG_LDB(B1, 1, 1); FG_STAGE(FG_SB(1, 0), b3, voffB);
      FG_BAR; FG_WAIT_L(0); FG_MMA(0, 1, At, B1); FG_BAR;
      FG_LDA(At, 1, 1); FG_STAGE_A(FG_SA(1, 0), a2, kstep, 0, vaC);
      FG_BAR; FG_WAIT_L(0); FG_MMA(1, 0, At, B0); FG_BAR; FG_SCHED;
      FG_STAGE(FG_SB(1, 1), b3 + hstepB, voffB);
      FG_WAIT_V(6); FG_BAR; FG_MMA(1, 1, At, B1); FG_BAR;
    }
    E(acc, cur, wr, wc, fr, fq, lane);
    if (!has_next) break;
#pragma unroll
    for (int a = 0; a < 2; ++a)
#pragma unroll
      for (int b = 0; b < 2; ++b)
#pragma unroll
        for (int m = 0; m < 4; ++m)
#pragma unroll
          for (int n = 0; n < 2; ++n) acc[a][b][m][n] = zero4();
    cur = nxt; cA = nA; cB = nB; ++ui;
  }
  FG_WAIT_V(0);
  if (wr == 0) FG_BAR;
  FG_BAR;
}

struct DenseOrder {
  const char* A; const char* Bt; int lda_, ldb_, nM, nN, nwg, G, c, a_col_bytes_per_pn;
  __device__ __forceinline__ void init(const void* A_, int ldaa, const void* Bt_, int ldbb, int M, int N, int G_, int c_, int acol) {
    A = (const char*)A_; Bt = (const char*)Bt_; lda_ = ldaa; ldb_ = ldbb; nM = M / 256; nN = N / 256; nwg = nM * nN; G = G_; c = c_; a_col_bytes_per_pn = acol; }
  __device__ __forceinline__ bool next(int i, FUnit& u) const {
    const long L = (long)i * G + c; if (L >= nwg) return false;
    int wgid = (int)L; { const int q = nwg / 8, r = nwg % 8, xcd = wgid % 8, off = wgid / 8; wgid = (xcd < r ? xcd * (q + 1) : r * (q + 1) + (xcd - r) * q) + off; }
    const int nig = 8 * nN, gid = wgid / nig, fm = gid * 8, gsz = (nM - fm) < 8 ? (nM - fm) : 8;
    u.pm = fm + ((wgid % nig) % gsz); u.pn = (wgid % nig) / gsz; u.e = 0; u.pos0 = 0; u.nvalid = 256; return true;
  }
  static constexpr bool GATHER = false;
  __device__ __forceinline__ unsigned lda() const { return (unsigned)lda_; }
  __device__ __forceinline__ unsigned ldb() const { return (unsigned)ldb_; }
  __device__ __forceinline__ const char* a_ptr(const FUnit& u) const { return A + (size_t)u.pm * 256 * lda_ * 2 + (size_t)u.pn * a_col_bytes_per_pn; }
  __device__ __forceinline__ void a_offs(const FUnit&, int, unsigned (&)[2][2]) const {}
  __device__ __forceinline__ const char* b_ptr(const FUnit& u) const { return Bt + (size_t)u.pn * 256 * ldb_ * 2; }
};

struct EpiProj {
  char* ws;
  __device__ __forceinline__ void operator()(const f32x4 (&acc)[2][2][4][2], const FUnit& u, int wr, int wc, int fr, int fq, int lane) const {
    const float* rs0 = (const float*)(ws + OFF_RS0);
    bf16_t* proj = (bf16_t*)(ws + OFF_R2);
#pragma unroll
    for (int ai = 0; ai < 2; ++ai)
#pragma unroll
      for (int m = 0; m < 4; ++m) {
        const int row = u.pm * 256 + ai * 128 + wr * 64 + m * 16 + fr;
        const float sc = rs0[row];
#pragma unroll
        for (int bj = 0; bj < 2; ++bj) {
          const int col0 = u.pn * 256 + bj * 128 + wc * 32 + fq * 8;
          const f32x4 v0 = acc[ai][bj][m][0] * sc, v1 = acc[ai][bj][m][1] * sc;
          u32x4 w4; w4.x = cvt_pk_bf16(v0[0], v0[1]); w4.y = cvt_pk_bf16(v0[2], v0[3]); w4.z = cvt_pk_bf16(v1[0], v1[1]); w4.w = cvt_pk_bf16(v1[2], v1[3]);
          *(u32x4*)(proj + (long)row * PROJ_LD + col0) = w4;
          if (u.pn == 7 && bj == 1 && wc == 1 && fq == 0) {
            float* d = (float*)(ws + OFF_DTRAW) + (long)row * 8;
            *(f32x4*)d = v0; *(f32x4*)(d + 4) = v1;
          }
          if (u.pn == 0 || (u.pn == 1 && bj == 0)) {
            float ss = v0[0] * v0[0] + v0[1] * v0[1] + v0[2] * v0[2] + v0[3] * v0[3] + v1[0] * v1[0] + v1[1] * v1[1] + v1[2] * v1[2] + v1[3] * v1[3];
            ss += sxor<16>(ss); ss += lane_get(ss, lane ^ 32);
            if (fq == 0) {
              if (u.pn == 0) ((float*)(ws + OFF_SSQ_Q))[row * 8 + bj * 4 + wc] = ss;
              else ((float*)(ws + OFF_SSQ_KV))[row * 4 + wc] = ss;
            }
          }
        }
      }
  }
};

template <int MODE>
struct EpiRes {
  char* ws; const float* xin; float* out; float* ssq; const float* pb; const float* psc; float f;
  __device__ __forceinline__ void operator()(const f32x4 (&acc)[2][2][4][2], const FUnit& u, int wr, int wc, int fr, int fq, int lane) const {
    bf16_t* xcb = (bf16_t*)(ws + OFF_XCB);
#pragma unroll
    for (int bj = 0; bj < 2; ++bj) {
      const int col0 = u.pn * 256 + bj * 128 + wc * 32 + fq * 8;
      f32x4 b0 = zero4(), b1 = b0, s0 = (f32x4){1.f, 1.f, 1.f, 1.f}, s1 = s0;
      if (MODE == 2) { b0 = *(const f32x4*)(pb + col0); b1 = *(const f32x4*)(pb + col0 + 4); s0 = *(const f32x4*)(psc + col0); s1 = *(const f32x4*)(psc + col0 + 4); }
#pragma unroll
      for (int ai = 0; ai < 2; ++ai)
#pragma unroll
        for (int m = 0; m < 4; ++m) {
          const int row = u.pm * 256 + ai * 128 + wr * 64 + m * 16 + fr;
          const float* bp = (MODE == 0 ? xin : out) + (long)row * 1024 + col0;
          f32x4 a0 = acc[ai][bj][m][0], a1 = acc[ai][bj][m][1];
          if (MODE == 2) { a0 = (a0 + b0) * s0; a1 = (a1 + b1) * s1; }
          const float ff = (MODE == 0) ? 1.f : f;
          const f32x4 v0 = *(const f32x4*)bp + a0 * ff, v1 = *(const f32x4*)(bp + 4) + a1 * ff;
          float* op = out + (long)row * 1024 + col0;
          *(f32x4*)op = v0; *(f32x4*)(op + 4) = v1;
          u32x4 w4; w4.x = cvt_pk_bf16(v0[0], v0[1]); w4.y = cvt_pk_bf16(v0[2], v0[3]); w4.z = cvt_pk_bf16(v1[0], v1[1]); w4.w = cvt_pk_bf16(v1[2], v1[3]);
          *(u32x4*)(xcb + (long)row * 1024 + col0) = w4;
          float ss = v0[0] * v0[0] + v0[1] * v0[1] + v0[2] * v0[2] + v0[3] * v0[3] + v1[0] * v1[0] + v1[1] * v1[1] + v1[2] * v1[2] + v1[3] * v1[3];
          ss += sxor<16>(ss); ss += lane_get(ss, lane ^ 32);
          if (fq == 0) ssq[row * 32 + (u.pn * 2 + bj) * 4 + wc] = ss;
        }
    }
  }
};

struct TJob { const float* src; int K, N; bf16_t* dst; int dst_ld, grp, grp_pad, goff; const float* gain; };
__device__ __forceinline__ void tstrip_load(const TJob& j, int tk, int tn, int t, float4 (&v)[8]) {
  const int k0 = tk * 64, n0 = tn * 256, c4 = (t & 63) * 4;
#pragma unroll
  for (int i = 0; i < 8; ++i) {
    const int r = (t >> 6) + 8 * i;
    float4 x = make_float4(0.f, 0.f, 0.f, 0.f);
    if (n0 + c4 < j.N) x = *(const float4*)(j.src + (long)(k0 + r) * j.N + n0 + c4);
    const float g = j.gain ? j.gain[k0 + r] : 1.f;
    v[i] = make_float4(x.x * g, x.y * g, x.z * g, x.w * g);
  }
}
__device__ __forceinline__ void tstrip_to_lds(int t, const float4 (&v)[8], float* tl) {
  const int c4 = (t & 63) * 4;
#pragma unroll
  for (int i = 0; i < 8; ++i) {
    const int r = (t >> 6) + 8 * i;
    tl[r * 257 + c4 + 0] = v[i].x; tl[r * 257 + c4 + 1] = v[i].y; tl[r * 257 + c4 + 2] = v[i].z; tl[r * 257 + c4 + 3] = v[i].w;
  }
}
__device__ __forceinline__ void tstrip_store(const TJob& j, int tk, int tn, int t, const float* tl) {
  const int k0 = tk * 64, n0 = tn * 256;
  const int n = n0 + (t >> 1);
  if (n < j.N) {
    const int drow = (n / j.grp) * j.grp_pad + j.goff + (n % j.grp);
    const int kk = (t & 1) * 32;
    bf16_t* d = j.dst + (long)drow * j.dst_ld + k0 + kk;
#pragma unroll
    for (int q = 0; q < 4; ++q) {
      unsigned u[4];
#pragma unroll
      for (int jj = 0; jj < 4; ++jj) u[jj] = pack2(tl[(kk + q * 8 + 2 * jj) * 257 + (t >> 1)], tl[(kk + q * 8 + 2 * jj + 1) * 257 + (t >> 1)]);
      *(uint4*)(d + q * 8) = make_uint4(u[0], u[1], u[2], u[3]);
    }
  }
}

constexpr int N_TJOBS = 5 + 4 + 6 + 192;
__device__ __forceinline__ TJob get_tjob(int idx, const Ctx& c, char* ws) {
  constexpr int BIG = 1 << 30;
  TJob j;
  if (idx == 0) j = {INP(I_W_IN), 1024, 1960, (bf16_t*)(ws + OFF_WIN_T), 1024, BIG, 0, 0, INP(I_LN_MIX)};
  else if (idx == 1) j = {INP(I_W_UQ), 256, 768, (bf16_t*)(ws + OFF_WUQ_T), 256, 96, 128, 0, INP(I_QLAT_NORM)};
  else if (idx == 2) j = {INP(I_W_UKV), 128, 1024, (bf16_t*)(ws + OFF_WUKV_T), 128, BIG, 0, 0, INP(I_KVLAT_NORM)};
  else if (idx == 3) j = {INP(I_W_OUT), 512, 1024, (bf16_t*)(ws + OFF_WOUT_T), 1024, BIG, 0, 0, nullptr};
  else if (idx == 4) j = {INP(I_W_OUT) + 512 * 1024, 512, 1024, (bf16_t*)(ws + OFF_WOUT_T) + 512, 1024, BIG, 0, 0, INP(I_SSD_NORM)};
  else if (idx < 9) { const int g = idx - 5; j = {INP(I_POOL_W) + g * 65536, 256, 256, (bf16_t*)(ws + OFF_POOL_T) + g * 65536, 256, BIG, 0, 0, INP(I_LN_MIX) + 1024 + g * 256}; }
  else if (idx < 15) {
    const int l = (idx - 9) / 3, k = (idx - 9) % 3;
    if (k == 0) j = {INP(I_XQ_W) + l * 1024 * 256, 1024, 256, (bf16_t*)(ws + OFF_XQ_T) + l * 256 * 1024, 1024, BIG, 0, 0, INP(I_LN_XQ) + l * 1024};
    else if (k == 1) j = {INP(I_XKV_W) + l * 1024 * 512, 1024, 512, (bf16_t*)(ws + OFF_XKV_T) + l * 512 * 1024, 1024, BIG, 0, 0, INP(I_LN_MEM) + l * 1024};
    else j = {INP(I_XO_W) + l * 256 * 1024, 256, 1024, (bf16_t*)(ws + OFF_XO_T) + l * 1024 * 256, 256, BIG, 0, 0, nullptr};
  } else {
    const int le = (idx - 15) / 3, k = (idx - 15) % 3, l = le >> 5;
    const long wo = (long)le * 1024 * 256;
    if (k == 0) j = {INP(I_EXP_G) + wo, 1024, 256, (bf16_t*)(ws + OFF_WGU_T) + (long)le * 512 * 1024, 1024, 4, 8, 0, INP(I_LN_FFN) + l * 1024};
    else if (k == 1) j = {INP(I_EXP_U) + wo, 1024, 256, (bf16_t*)(ws + OFF_WGU_T) + (long)le * 512 * 1024, 1024, 4, 8, 4, INP(I_LN_FFN) + l * 1024};
    else j = {INP(I_EXP_D) + wo, 256, 1024, (bf16_t*)(ws + OFF_WD_T) + (long)le * 1024 * 256, 256, BIG, 0, 0, nullptr};
  }
  return j;
}

__device__ __forceinline__ void phase_prep(const Ctx& c) {
  char* ws = c.ws; char* smem = c.smem; const int bid = c.bid, nblk = c.nblk;
  float* tl = (float*)smem;
  {
    int ji = 0, base = 0, f = bid;
    TJob j = get_tjob(0, c, ws);
    int tilesN = (j.N + 255) / 256, ntiles = tilesN * (j.K / 64);
    float4 v[8];
    bool have = false; TJob jc = j; int tkc = 0, tnc = 0;
#define T_SEEK() { while (ji < N_TJOBS && f >= base + ntiles) { base += ntiles; ++ji; if (ji < N_TJOBS) { j = get_tjob(ji, c, ws); tilesN = (j.N + 255) / 256; ntiles = tilesN * (j.K / 64); } } }
    T_SEEK()
    if (ji < N_TJOBS) { jc = j; tkc = (f - base) / tilesN; tnc = (f - base) % tilesN; tstrip_load(jc, tkc, tnc, c.tid, v); have = true; }
    while (have) {
      tstrip_to_lds(c.tid, v, tl);
      __syncthreads();
      const TJob jd = jc; const int tkd = tkc, tnd = tnc;
      f += nblk;
      T_SEEK()
      have = ji < N_TJOBS;
      if (have) { jc = j; tkc = (f - base) / tilesN; tnc = (f - base) % tilesN; tstrip_load(jc, tkc, tnc, c.tid, v); }
      tstrip_store(jd, tkd, tnd, c.tid, tl);
      __syncthreads();
    }
#undef T_SEEK
  }
  {
    const int gt = bid * NTHR + c.tid, gn = nblk * NTHR;
    uint4 z = make_uint4(0, 0, 0, 0);
    bf16_t* w1 = (bf16_t*)(ws + OFF_WIN_T) + 1960l * 1024;
    for (int i = gt; i < 88 * 1024 / 8; i += gn) *(uint4*)(w1 + i * 8) = z;
    bf16_t* w2 = (bf16_t*)(ws + OFF_WUQ_T);
    for (int i = gt; i < 8 * 32 * 256 / 8; i += gn) {
      const int e = i * 8, h = e / (32 * 256), rem = e % (32 * 256);
      *(uint4*)(w2 + (long)(h * 128 + 96) * 256 + rem) = z;
    }
    if (gt < 128) ((int*)(ws + OFF_CTL))[gt] = 0;
    bf16_t* wr = (bf16_t*)(ws + OFF_WR);
    for (int i = gt; i < 2 * 48 * 1024; i += gn) {
      const int l = i / (48 * 1024), o = (i / 1024) % 48, k = i % 1024;
      float w = 0.f;
      if (o < 4) w = INP(I_RG_W)[(l * 1024 + k) * 4 + o];
      else if (o < 36) w = INP(I_RE_W)[(l * 1024 + k) * 32 + (o - 4)];
      const bf16_t hi = f2bf(w);
      wr[((l * 2 + 0) * 48 + o) * 1024 + k] = hi;
      wr[((l * 2 + 1) * 48 + o) * 1024 + k] = f2bf(w - bf2f(hi));
    }
  }
  {
    const int lane = c.tid & 63;
    const int gw = bid * NWAV + (c.tid >> 6), nw = nblk * NWAV;
    for (int row0 = gw * 2; row0 < NT + 4096; row0 += nw * 2) {
      float4 v[2][4];
#pragma unroll
      for (int q = 0; q < 2; ++q) {
        const int row = row0 + q; const bool ism = row >= NT; const int r = ism ? row - NT : row;
        const float* src = (ism ? INP(I_MEM) : INP(I_X)) + (long)r * 1024;
#pragma unroll
        for (int i = 0; i < 4; ++i) v[q][i] = *(const float4*)(src + i * 256 + lane * 4);
      }
#pragma unroll
      for (int q = 0; q < 2; ++q) {
        const int row = row0 + q; const bool ism = row >= NT; const int r = ism ? row - NT : row;
        bf16_t* dst = (bf16_t*)(ws + (ism ? OFF_MEMB : OFF_R1)) + (long)r * 1024;
        float ss = 0.f;
#pragma unroll
        for (int i = 0; i < 4; ++i) {
          const float4 x = v[q][i];
          ss += x.x * x.x + x.y * x.y + x.z * x.z + x.w * x.w;
          *(uint2*)(dst + i * 256 + lane * 4) = make_uint2(pack2(x.x, x.y), pack2(x.z, x.w));
        }
        ss = wave_sum(ss, lane);
        if (lane == 0) ((float*)(ws + (ism ? OFF_RSM : OFF_RS0)))[r] = rsqrtf(ss * (1.f / 1024.f) + EPS);
      }
    }
  }
}

__device__ __forceinline__ float cs_ssq(const float* crow, int n) {
  float ss = 0.f;
  for (int j = 0; j < n; j += 4) { const float4 c = *(const float4*)(crow + j); ss += c.x * c.x + c.y * c.y + c.z * c.z + c.w * c.w; }
  return ss;
}
__device__ __forceinline__ void cs_store_scaled(bf16_t* dst, const float* crow, int n, float sc, const float* g) {
  for (int j = 0; j < n; j += 8) {
    float4 a = *(const float4*)(crow + j), b = *(const float4*)(crow + j + 4);
    if (g) {
      const float4 ga = *(const float4*)(g + j), gb = *(const float4*)(g + j + 4);
      a.x *= ga.x; a.y *= ga.y; a.z *= ga.z; a.w *= ga.w; b.x *= gb.x; b.y *= gb.y; b.z *= gb.z; b.w *= gb.w;
    }
    *(uint4*)(dst + j) = make_uint4(pack2(a.x * sc, a.y * sc), pack2(a.z * sc, a.w * sc), pack2(b.x * sc, b.y * sc), pack2(b.z * sc, b.w * sc));
  }
}
__device__ __forceinline__ float row_rs32(const float* ssq, int row) {
  const float4* q = (const float4*)(ssq + (long)row * 32);
  float s = 0.f;
#pragma unroll
  for (int i = 0; i < 8; ++i) { const float4 v = q[i]; s += (v.x + v.y) + (v.z + v.w); }
  return rsqrtf(s * (1.f / 1024.f) + EPS);
}
__device__ __forceinline__ void rope_cs(float pos, int i, float& c, float& s) {
  const float ang = pos * exp2f(-(float)i * 0.8304820237218406f);
  float u = ang * 0.15915494309189535f;
  u -= rintf(u);
  c = __builtin_amdgcn_cosf(u);
  s = __builtin_amdgcn_sinf(u);
}

__device__ __forceinline__ void phase_gemm_in(const Ctx& c) {
  char* ws = c.ws; char* smem = c.smem; const int bid = c.bid, nblk = c.nblk;
  {
    DenseOrder S; S.init(ws + OFF_R1, 1024, ws + OFF_WIN_T, 1024, NT, 2048, nblk, bid, 0);
    EpiProj E{ws};
    fast_gemm(( LAS3 unsigned char*)smem, S, E, 1024, c.tid);
  }
  __syncthreads();
  const int t = c.tid, er = t >> 1, eh = t & 1;
  const float* crow = (const float*)smem + er * CS_LD + eh * 64;
  for (int it = bid; it < 2 * 32 * 4; it += nblk) {
    const int l = it >> 7, mt = (it >> 2) & 31, nt = it & 3;
    gemm_dense((const bf16_t*)(ws + OFF_MEMB) + (long)mt * 128 * 1024, 1024,
               (const bf16_t*)(ws + OFF_XKV_T) + (long)l * 512 * 1024 + (long)nt * 128 * 1024, 1024, 1024, smem, c.tid);
    if (t < 256) {
      const int row = mt * 128 + er;
      const float sc = ((const float*)(ws + OFF_RSM))[row];
      if (nt < 2) {
        const int head = nt * 2 + eh;
        const float ss = cs_ssq(crow, 64) * sc * sc;
        const float r = rsqrtf(ss * (1.f / 64.f) + EPS) * sc;
        cs_store_scaled((bf16_t*)(ws + OFF_MEMK) + (long)l * 4096 * 256 + (long)row * 256 + head * 64, crow, 64, r, INP(I_XK_NORM) + l * 64);
      } else {
        const int head = (nt - 2) * 2 + eh;
        cs_store_scaled((bf16_t*)(ws + OFF_MEMVT) + (long)l * 4096 * 256 + (long)row * 256 + head * 64, crow, 64, sc, nullptr);
      }
    }
    __syncthreads();
  }
}

__device__ __forceinline__ void phase_up(const Ctx& c) {
  char* ws = c.ws; char* smem = c.smem; const int bid = c.bid, nblk = c.nblk; (void)smem; (void)bid; (void)nblk;
  const int t = c.tid, er = t >> 1, eh = t & 1;
  const float* crow = (const float*)smem + er * CS_LD + eh * 64;
  const bf16_t* proj = (const bf16_t*)(ws + OFF_R2);
  const int* positions = (const int*)c.p.in[opq(I_POS)];
  const int n_items = 512 * 8 * 2;
  for (int item = bid; item < n_items; item += nblk) {
    const int which = item >= 4096;
    const int it = item & 4095;
    const int mt = it >> 3, h = it & 7;
    const int row = mt * 128 + er;
    const int b = row >> 12, s = row & 4095;
    {
      const int kk = which ? 128 : 256;
      gemm_dense(proj + (long)mt * 128 * PROJ_LD + (which ? C_KVLAT : C_QLAT), PROJ_LD,
                 (const bf16_t*)(ws + (which ? OFF_WUKV_T : OFF_WUQ_T)) + (long)h * 128 * kk, kk, kk, smem, c.tid);
    }
    if (t < 256) {
    if (!which) {
      const float* sq = (const float*)(ws + OFF_SSQ_Q) + row * 8;
      const float rq = rsqrtf(((sq[0] + sq[1]) + (sq[2] + sq[3]) + (sq[4] + sq[5]) + (sq[6] + sq[7])) * (1.f / 256.f) + EPS);
      float ss = cs_ssq(crow, eh ? 32 : 64) * rq * rq;
      ss += sxor<1>(ss);
      const float r = rsqrtf(ss * (1.f / 96.f) + EPS) * rq * (0.10206207261596577f * LOG2E);
      const float* g = INP(I_Q_NORM) + eh * 64;
      bf16_t* dst = (bf16_t*)(ws + OFF_Q) + ((long)(b * 8 + h) * 4096 + s) * 96 + eh * 64;
      if (!eh) {
        cs_store_scaled(dst, crow, 64, r, g);
      } else {
        const float pos = (float)positions[row];
        for (int i0 = 0; i0 < 16; i0 += 8) {
          float o1[8], o2[8];
#pragma unroll
          for (int i = 0; i < 8; ++i) {
            float c, sn; rope_cs(pos, i0 + i, c, sn);
            const float u1 = crow[i0 + i] * r * g[i0 + i], u2 = crow[16 + i0 + i] * r * g[16 + i0 + i];
            o1[i] = u1 * c - u2 * sn; o2[i] = u2 * c + u1 * sn;
          }
          *(uint4*)(dst + i0) = make_uint4(pack2(o1[0], o1[1]), pack2(o1[2], o1[3]), pack2(o1[4], o1[5]), pack2(o1[6], o1[7]));
          *(uint4*)(dst + 16 + i0) = make_uint4(pack2(o2[0], o2[1]), pack2(o2[2], o2[3]), pack2(o2[4], o2[5]), pack2(o2[6], o2[7]));
        }
      }
    } else {
      const float* sk = (const float*)(ws + OFF_SSQ_KV) + row * 4;
      const float rkv = rsqrtf(((sk[0] + sk[1]) + (sk[2] + sk[3])) * (1.f / 128.f) + EPS);
      if (!eh) {
        const bf16_t* kp = proj + (long)row * PROJ_LD + C_KROPE;
        float ss = cs_ssq(crow, 64) * rkv * rkv;
        for (int j = 0; j < 32; j += 8) {
          const uint4 u = *(const uint4*)(kp + j);
          ss += bflo(u.x) * bflo(u.x) + bfhi(u.x) * bfhi(u.x) + bflo(u.y) * bflo(u.y) + bfhi(u.y) * bfhi(u.y)
              + bflo(u.z) * bflo(u.z) + bfhi(u.z) * bfhi(u.z) + bflo(u.w) * bflo(u.w) + bfhi(u.w) * bfhi(u.w);
        }
        const float r = rsqrtf(ss * (1.f / 96.f) + EPS);
        const float* g = INP(I_K_NORM);
        bf16_t* dst = (bf16_t*)(ws + OFF_K) + ((long)(b * 8 + h) * 4096 + s) * 96;
        cs_store_scaled(dst, crow, 64, r * rkv, g);
        const float pos = (float)positions[row];
        for (int i0 = 0; i0 < 16; i0 += 8) {
          const uint4 ua = *(const uint4*)(kp + i0), ub = *(const uint4*)(kp + 16 + i0);
          const float k1[8] = {bflo(ua.x), bfhi(ua.x), bflo(ua.y), bfhi(ua.y), bflo(ua.z), bfhi(ua.z), bflo(ua.w), bfhi(ua.w)};
          const float k2[8] = {bflo(ub.x), bfhi(ub.x), bflo(ub.y), bfhi(ub.y), bflo(ub.z), bfhi(ub.z), bflo(ub.w), bfhi(ub.w)};
          float o1[8], o2[8];
#pragma unroll
          for (int i = 0; i < 8; ++i) {
            float c, sn; rope_cs(pos, i0 + i, c, sn);
            const float u1 = k1[i] * r * g[64 + i0 + i], u2 = k2[i] * r * g[80 + i0 + i];
            o1[i] = u1 * c - u2 * sn; o2[i] = u2 * c + u1 * sn;
          }
          *(uint4*)(dst + 64 + i0) = make_uint4(pack2(o1[0], o1[1]), pack2(o1[2], o1[3]), pack2(o1[4], o1[5]), pack2(o1[6], o1[7]));
          *(uint4*)(dst + 80 + i0) = make_uint4(pack2(o2[0], o2[1]), pack2(o2[2], o2[3]), pack2(o2[4], o2[5]), pack2(o2[6], o2[7]));
        }
      } else {
        cs_store_scaled((bf16_t*)(ws + OFF_VT) + ((long)(b * 8 + h) * 4096 + s) * 64, crow, 64, rkv, nullptr);
      }
    }
    }
    __syncthreads();
  }
  {
    const long gt = (long)bid * NTHR + t, gn = (long)nblk * NTHR;
    const float* cw = INP(I_CONV_W);
    const float* cb = INP(I_CONV_B);
    bf16_t* xc = (bf16_t*)(ws + OFF_R4);
    for (long i = gt; i < (long)NT * 128; i += gn) {
      const int tok = (int)(i >> 7), ch = (int)(i & 127) * 8;
      const int s = tok & 4095;
      float a[8];
#pragma unroll
      for (int j = 0; j < 8; ++j) a[j] = cb[ch + j];
#pragma unroll
      for (int k = 0; k < 4; ++k) {
        const int ds = k - 3;
        if (s + ds >= 0) {
          uint4 u = *(const uint4*)(proj + (long)(tok + ds) * PROJ_LD + C_XBC + ch);
          const float* w = cw + k * 1024 + ch;
          a[0] += w[0] * bflo(u.x); a[1] += w[1] * bfhi(u.x); a[2] += w[2] * bflo(u.y); a[3] += w[3] * bfhi(u.y);
          a[4] += w[4] * bflo(u.z); a[5] += w[5] * bfhi(u.z); a[6] += w[6] * bflo(u.w); a[7] += w[7] * bfhi(u.w);
        }
      }
#pragma unroll
      for (int j = 0; j < 8; ++j) a[j] = silu_f(a[j]);
      *(uint4*)(xc + (long)tok * 1024 + ch) = make_uint4(pack2(a[0], a[1]), pack2(a[2], a[3]), pack2(a[4], a[5]), pack2(a[6], a[7]));
    }
    const float* dtr = (const float*)(ws + OFF_DTRAW);
    float* dt = (float*)(ws + OFF_DT);
    for (long i = gt; i < (long)NT * 8; i += gn) {
      const float x = dtr[i] + INP(I_DT_BIAS)[i & 7];
      dt[i] = x > 20.f ? x : log1pf(__expf(x));
    }
  }
}

typedef float f32x16 __attribute__((ext_vector_type(16)));
__device__ __forceinline__ f32x16 mfma32(bf16x8 a, bf16x8 b, f32x16 c) { return __builtin_amdgcn_mfma_f32_32x32x16_bf16(a, b, c, 0, 0, 0); }
template <int DQK, bool CAUSAL>
__device__ __forceinline__ void attn_block(const bf16_t* Q, long ldq, const bf16_t* K, long ldk, const bf16_t* V, long ldv, int ntiles, int q0,
                           bf16_t* O, long ldo, char* smem, int tid) {
  constexpr int KLD = DQK + 8, VLD = 160, NK16 = DQK / 16, KCH = DQK / 8;
  constexpr int KBUF = 64 * KLD + 64 * VLD;
  constexpr int NKC = (64 * KCH + NTHR - 1) / NTHR;
  const int t = tid, lane = t & 63, w = t >> 6, l31 = lane & 31, hh = lane >> 5, l15 = lane & 15;
  bf16_t* KV = (bf16_t*)smem;
  bf16x8 qf[NK16];
#pragma unroll
  for (int ks = 0; ks < NK16; ++ks) qf[ks] = *(const bf16x8*)(Q + (long)(w * 32 + l31) * ldq + ks * 16 + hh * 8);
  f32x16 oacc[2];
#pragma unroll
  for (int dt = 0; dt < 2; ++dt)
#pragma unroll
    for (int i = 0; i < 16; ++i) oacc[dt][i] = 0.f;
  float mrow = -1e30f, lrow = 0.f;
  u32x4 kr[NKC], vr;
  const int vrow = t >> 3, vcc = t & 7;
#define A_LOAD(KT) { \
    _Pragma("unroll") for (int i = 0; i < NKC; ++i) { const int c_ = t + NTHR * i; if (c_ < 64 * KCH) kr[i] = *(const u32x4*)(K + (long)((KT) * 64 + c_ / KCH) * ldk + (c_ % KCH) * 8); } \
    vr = *(const u32x4*)(V + (long)((KT) * 64 + vrow) * ldv + vcc * 8); }
#define A_STORE(ST) { bf16_t* Kd_ = KV + (ST) * KBUF; bf16_t* Vd_ = Kd_ + 64 * KLD; \
    _Pragma("unroll") for (int i = 0; i < NKC; ++i) { const int c_ = t + NTHR * i; if (c_ < 64 * KCH) *(u32x4*)(Kd_ + (c_ / KCH) * KLD + (c_ % KCH) * 8) = kr[i]; } \
    *(u32x4*)(Vd_ + vrow * VLD + vcc * 8) = vr; }
  A_LOAD(0)
  A_STORE(0)
  if (ntiles > 1) A_LOAD(1)
  __syncthreads();
  const int qrow = q0 + w * 32 + l31;
  for (int kt = 0; kt < ntiles; ++kt) {
    const bf16_t* Ks = KV + (kt & 1) * KBUF;
    const bf16_t* Vs = Ks + 64 * KLD;
    f32x16 sacc[2];
#pragma unroll
    for (int T = 0; T < 2; ++T) {
#pragma unroll
      for (int i = 0; i < 16; ++i) sacc[T][i] = 0.f;
#pragma unroll
      for (int ks = 0; ks < NK16; ++ks) {
        const bf16x8 kf = *(const bf16x8*)(Ks + (T * 32 + l31) * KLD + ks * 16 + hh * 8);
        sacc[T] = mfma32(kf, qf[ks], sacc[T]);
      }
    }
    if (CAUSAL && (kt * 64 + 63 > q0 + w * 32)) {
#pragma unroll
      for (int T = 0; T < 2; ++T)
#pragma unroll
        for (int i = 0; i < 16; ++i) {
          const int key = kt * 64 + T * 32 + (i & 3) + 8 * (i >> 2) + 4 * hh;
          if (key > qrow) sacc[T][i] = -1e30f;
        }
    }
    float mx = sacc[0][0];
#pragma unroll
    for (int T = 0; T < 2; ++T)
#pragma unroll
      for (int i = 0; i < 16; ++i) mx = fmaxf(mx, sacc[T][i]);
    mx = fmaxf(mx, lane_get(mx, lane ^ 32));
    const float mn = fmaxf(mrow, mx);
    const float alpha = __builtin_amdgcn_exp2f(mrow - mn);
    mrow = mn;
    float ps = 0.f;
#pragma unroll
    for (int T = 0; T < 2; ++T)
#pragma unroll
      for (int i = 0; i < 16; ++i) { const float pv = __builtin_amdgcn_exp2f(sacc[T][i] - mn); sacc[T][i] = pv; ps += pv; }
    lrow = lrow * alpha + ps;
#pragma unroll
    for (int dt = 0; dt < 2; ++dt)
#pragma unroll
      for (int i = 0; i < 16; ++i) oacc[dt][i] *= alpha;
#pragma unroll
    for (int T = 0; T < 2; ++T)
#pragma unroll
      for (int s2 = 0; s2 < 2; ++s2) {
        union { unsigned u[4]; bf16x8 v; } pf;
#pragma unroll
        for (int j = 0; j < 4; ++j) pf.u[j] = cvt_pk_bf16(sacc[T][8 * s2 + 2 * j], sacc[T][8 * s2 + 2 * j + 1]);
        const int kb = T * 32 + 16 * s2 + 4 * hh + (l15 >> 2);
#pragma unroll
        for (int dt = 0; dt < 2; ++dt) {
          const bf16_t* vp = Vs + kb * VLD + dt * 32 + 16 * ((lane >> 4) & 1) + 4 * (l15 & 3);
          const s16x4 va = __builtin_amdgcn_ds_read_tr16_b64_v4i16((__attribute__((address_space(3))) s16x4*)vp);
          const s16x4 vb = __builtin_amdgcn_ds_read_tr16_b64_v4i16((__attribute__((address_space(3))) s16x4*)(vp + 8 * VLD));
          const bf16x8 vf = (bf16x8){va[0], va[1], va[2], va[3], vb[0], vb[1], vb[2], vb[3]};
          oacc[dt] = mfma32(vf, pf.v, oacc[dt]);
        }
      }
    if (kt + 1 < ntiles) {
      A_STORE((kt + 1) & 1)
      if (kt + 2 < ntiles) A_LOAD(kt + 2)
    }
    __syncthreads();
  }
#undef A_LOAD
#undef A_STORE
  lrow += lane_get(lrow, lane ^ 32);
  const float inv = 1.f / lrow;
  bf16_t* orow = O + (long)(w * 32 + l31) * ldo;
#pragma unroll
  for (int dt = 0; dt < 2; ++dt)
#pragma unroll
    for (int g4 = 0; g4 < 4; ++g4) {
      uint2 o2;
      o2.x = cvt_pk_bf16(oacc[dt][4 * g4] * inv, oacc[dt][4 * g4 + 1] * inv);
      o2.y = cvt_pk_bf16(oacc[dt][4 * g4 + 2] * inv, oacc[dt][4 * g4 + 3] * inv);
      *(uint2*)(orow + dt * 32 + 8 * g4 + 4 * hh) = o2;
    }
}

__device__ __forceinline__ void ssd_item(const Ctx& c, int b, int h) {
  char* ws = c.ws; char* smem = c.smem;
  const int t = c.tid, lane = t & 63, w = t >> 6, l15 = lane & 15, lq = lane >> 4;
  const int g = h >> 2;
  const int pw = w & 3, nq = (w >> 2) * 4;
  bf16_t* Cl = (bf16_t*)smem;
  bf16_t* Bl = Cl + 128 * 136;
  bf16_t* Ml = Bl + 128 * 136;
  bf16_t* Sl = Ml + 128 * 136;
  bf16_t* Xl = Sl + 64 * 136;
  float* fa = (float*)(Xl + 128 * 72);
  const bf16_t* xc = (const bf16_t*)(ws + OFF_R4);
  const bf16_t* proj = (const bf16_t*)(ws + OFF_R2);
  const float* dtp = (const float*)(ws + OFF_DT);
  bf16_t* AY = (bf16_t*)(ws + OFF_R1);
  const float a_h = -__expf(INP(I_A_LOG)[h]);
  const float dsk = INP(I_D_SKIP)[h];
  f32x4 st[4];
#pragma unroll
  for (int i = 0; i < 4; ++i) st[i] = zero4();
  u32x4 pc[4], pb[4], px[2]; float pd[2], pa0 = 0.f, pa1 = 0.f;
#define S_LOAD(CK) { const long tn_ = (long)b * 4096 + (CK) * 128; \
    _Pragma("unroll") for (int i = 0; i < 4; ++i) { const int ch = t + NTHR * i, r = ch >> 4, cc = ch & 15; \
      pc[i] = *(const u32x4*)(xc + (tn_ + r) * 1024 + 768 + g * 128 + cc * 8); pb[i] = *(const u32x4*)(xc + (tn_ + r) * 1024 + 512 + g * 128 + cc * 8); } \
    _Pragma("unroll") for (int i = 0; i < 2; ++i) { const int ch = t + NTHR * i, r = ch >> 3, cc = ch & 7; \
      px[i] = *(const u32x4*)(xc + (tn_ + r) * 1024 + h * 64 + cc * 8); pd[i] = dtp[(tn_ + r) * 8 + h]; } \
    if (w == 0) { pa0 = dtp[(tn_ + 2 * lane) * 8 + h]; pa1 = dtp[(tn_ + 2 * lane + 1) * 8 + h]; } }
  S_LOAD(0)
  for (int ck = 0; ck < 32; ++ck) {
    const long t0 = (long)b * 4096 + ck * 128;
#pragma unroll
    for (int i = 0; i < 4; ++i) {
      const int ch = t + NTHR * i, r = ch >> 4, cc = ch & 15;
      *(u32x4*)(Cl + r * 136 + cc * 8) = pc[i];
      *(u32x4*)(Bl + r * 136 + cc * 8) = pb[i];
    }
#pragma unroll
    for (int i = 0; i < 2; ++i) {
      const int ch = t + NTHR * i, r = ch >> 3, cc = ch & 7;
      const u32x4 u = px[i]; const float d = pd[i];
      *(uint4*)(Xl + r * 72 + cc * 8) = make_uint4(pack2(bflo(u.x) * d, bfhi(u.x) * d), pack2(bflo(u.y) * d, bfhi(u.y) * d),
                                                   pack2(bflo(u.z) * d, bfhi(u.z) * d), pack2(bflo(u.w) * d, bfhi(u.w) * d));
    }
    if (w == 0) {
      const float a0 = pa0 * a_h, a1 = pa1 * a_h;
      const float pr = a0 + a1;
      float sc = pr;
#pragma unroll
      for (int o = 1; o < 64; o <<= 1) { const float n = lane_get(sc, (lane - o) & 63); if (lane >= o) sc += n; }
      const float alast = __int_as_float(__builtin_amdgcn_readlane(__float_as_int(sc), 63));
      const float c0 = sc - pr + a0, c1 = sc;
      fa[2 * lane] = c0; fa[2 * lane + 1] = c1;
      fa[128 + 2 * lane] = __expf(c0); fa[128 + 2 * lane + 1] = __expf(c1);
      fa[256 + 2 * lane] = __expf(alast - c0); fa[256 + 2 * lane + 1] = __expf(alast - c1);
    }
#pragma unroll
    for (int i = 0; i < 4; ++i)
#pragma unroll
      for (int r = 0; r < 4; ++r) Sl[(pw * 16 + lq * 4 + r) * 136 + (nq + i) * 16 + l15] = f2bf(st[i][r]);
    __syncthreads();
    if (ck + 1 < 32) S_LOAD(ck + 1)
    __builtin_amdgcn_sched_barrier(0);
    bf16x8 cf[4];
#pragma unroll
    for (int ks = 0; ks < 4; ++ks) cf[ks] = *(const bf16x8*)(Cl + (w * 16 + l15) * 136 + ks * 32 + lq * 8);
    f32x4 yacc[4];
#pragma unroll
    for (int pt = 0; pt < 4; ++pt) {
      yacc[pt] = zero4();
      if (ck > 0) {
#pragma unroll
        for (int ks = 0; ks < 4; ++ks) {
          const bf16x8 sf = *(const bf16x8*)(Sl + (pt * 16 + l15) * 136 + ks * 32 + lq * 8);
          yacc[pt] = mfma16(cf[ks], sf, yacc[pt]);
        }
#pragma unroll
        for (int r = 0; r < 4; ++r) yacc[pt][r] *= fa[128 + w * 16 + lq * 4 + r];
      }
    }
#pragma unroll
    for (int stl = 0; stl < 8; ++stl) {
      if (stl <= w) {
        f32x4 gacc = zero4();
#pragma unroll
        for (int ks = 0; ks < 4; ++ks) {
          const bf16x8 bfv = *(const bf16x8*)(Bl + (stl * 16 + l15) * 136 + ks * 32 + lq * 8);
          gacc = mfma16(cf[ks], bfv, gacc);
        }
#pragma unroll
        for (int r = 0; r < 4; ++r) {
          const int tt = w * 16 + lq * 4 + r, ss = stl * 16 + l15;
          float m = 0.f;
          if (ss <= tt) m = gacc[r] * __expf(fa[tt] - fa[ss]);
          Ml[tt * 136 + ss] = f2bf(m);
        }
      } else if (stl <= (w | 1)) {
#pragma unroll
        for (int r = 0; r < 4; ++r) Ml[(w * 16 + lq * 4 + r) * 136 + stl * 16 + l15] = 0;
      }
    }
    __builtin_amdgcn_fence(__ATOMIC_RELEASE, "wavefront");
    __builtin_amdgcn_wave_barrier();
    __builtin_amdgcn_fence(__ATOMIC_ACQUIRE, "wavefront");
#pragma unroll
    for (int ks = 0; ks < 4; ++ks) {
      if (ks * 32 <= w * 16 + 15) {
        const bf16x8 mf = *(const bf16x8*)(Ml + (w * 16 + l15) * 136 + ks * 32 + lq * 8);
#pragma unroll
        for (int pt = 0; pt < 4; ++pt) {
          const bf16x8 xf = tr_frag(Xl, 72, ks * 32, pt * 16, l15, lq);
          yacc[pt] = mfma16(mf, xf, yacc[pt]);
        }
      }
    }
    {
      __builtin_amdgcn_fence(__ATOMIC_RELEASE, "wavefront");
      __builtin_amdgcn_wave_barrier();
      float* Yf = (float*)(Ml + (w * 16) * 136);
#pragma unroll
      for (int pt = 0; pt < 4; ++pt)
#pragma unroll
        for (int r = 0; r < 4; ++r) Yf[(lq * 4 + r) * 68 + pt * 16 + l15] = yacc[pt][r];
      __builtin_amdgcn_fence(__ATOMIC_RELEASE, "wavefront");
      __builtin_amdgcn_wave_barrier();
      __builtin_amdgcn_fence(__ATOMIC_ACQUIRE, "wavefront");
      const int rr = lane >> 2, seg = (lane & 3) * 16;
      const long tok = t0 + w * 16 + rr;
      const bf16_t* xp = xc + tok * 1024 + h * 64 + seg;
      const bf16_t* zp = proj + tok * PROJ_LD + C_Z + h * 64 + seg;
      bf16_t* op = AY + tok * 1024 + 512 + h * 64 + seg;
#pragma unroll
      for (int j = 0; j < 2; ++j) {
        const uint4 xu = *(const uint4*)(xp + j * 8), zu = *(const uint4*)(zp + j * 8);
        const float4 ya = *(const float4*)(Yf + rr * 68 + seg + j * 8), yb = *(const float4*)(Yf + rr * 68 + seg + j * 8 + 4);
        const float xf_[8] = {bflo(xu.x), bfhi(xu.x), bflo(xu.y), bfhi(xu.y), bflo(xu.z), bfhi(xu.z), bflo(xu.w), bfhi(xu.w)};
        const float zf_[8] = {bflo(zu.x), bfhi(zu.x), bflo(zu.y), bfhi(zu.y), bflo(zu.z), bfhi(zu.z), bflo(zu.w), bfhi(zu.w)};
        const float yf_[8] = {ya.x, ya.y, ya.z, ya.w, yb.x, yb.y, yb.z, yb.w};
        float o[8];
#pragma unroll
        for (int e = 0; e < 8; ++e) o[e] = (yf_[e] + xf_[e] * dsk) * silu_f(zf_[e]);
        *(uint4*)(op + j * 8) = make_uint4(pack2(o[0], o[1]), pack2(o[2], o[3]), pack2(o[4], o[5]), pack2(o[6], o[7]));
      }
    }
    if (ck + 1 < 32) {
      const float dec = fa[128 + 127];
#pragma unroll
      for (int i = 0; i < 4; ++i)
#pragma unroll
        for (int r = 0; r < 4; ++r) st[i][r] *= dec;
#pragma unroll
      for (int ks = 0; ks < 4; ++ks) {
        const bf16x8 xr = tr_frag(Xl, 72, ks * 32, pw * 16, l15, lq);
        bf16x8 xf;
#pragma unroll
        for (int j = 0; j < 8; ++j) xf[j] = (short)f2bf(bf2f((bf16_t)xr[j]) * fa[256 + ks * 32 + lq * 8 + j]);
#pragma unroll
        for (int i = 0; i < 4; ++i) {
          const bf16x8 bfv = tr_frag(Bl, 136, ks * 32, (nq + i) * 16, l15, lq);
          st[i] = mfma16(xf, bfv, st[i]);
        }
      }
    }
    __syncthreads();
  }
#undef S_LOAD
}

__device__ __forceinline__ void phase_mix(const Ctx& c0) {
  int* sitem = (int*)(c0.smem + SMEM_MAIN);
  int* qctr = (int*)(c0.ws + OFF_CTL) + CTL_QCTR + c0.pass;
  const int n_items = 128 + 2048;
  for (;;) {
    int tid = c0.tid; asm volatile("" : "+v"(tid));
    size_t wz = 0; asm volatile("" : "+s"(wz));
    char* ws = c0.ws + wz;
    const Ctx c{c0.p, ws, c0.smem, tid, c0.bid, c0.nblk, c0.f, c0.pass};
    char* smem = c.smem;
    if (tid == 0) *sitem = atomicAdd(qctr, 1);
    __syncthreads();
    const int item = *sitem;
    __syncthreads();
    if (item >= n_items) break;
#ifndef TEST_NO_SSD
    if (item < 128) {
      ssd_item(c, item >> 3, item & 7);
    } else
#endif
    {
#ifndef TEST_NO_ATTN
      const int it = item - 128;
      const int qb = 15 - (it >> 7), bh = it & 127;
      const bf16_t* Q = (const bf16_t*)(ws + OFF_Q) + ((long)bh * 4096 + qb * 256) * 96;
      const bf16_t* K = (const bf16_t*)(ws + OFF_K) + (long)bh * 4096 * 96;
      const bf16_t* Vv = (const bf16_t*)(ws + OFF_VT) + (long)bh * 4096 * 64;
      const int b = bh >> 3, h = bh & 7;
      bf16_t* O = (bf16_t*)(ws + OFF_R1) + ((long)b * 4096 + qb * 256) * 1024 + h * 64;
      attn_block<96, true>(Q, 96, K, 96, Vv, 64, 4 * qb + 4, qb * 256, O, 1024, smem, c.tid);
#endif
    }
  }
}

__device__ __forceinline__ void phase_ynorm(const Ctx& c) {
  bf16_t* AY = (bf16_t*)(c.ws + OFF_R1);
  const int bid = c.bid, nblk = c.nblk;
  const int lane = c.tid & 63;
  const int gw = bid * NWAV + (c.tid >> 6), nw = nblk * NWAV;
  for (int row0 = gw * 4; row0 < NT; row0 += nw * 4) {
    uint4 u[4];
#pragma unroll
    for (int q = 0; q < 4; ++q) u[q] = *(const uint4*)(AY + (long)(row0 + q) * 1024 + 512 + lane * 8);
#pragma unroll
    for (int q = 0; q < 4; ++q) {
      float v[8] = {bflo(u[q].x), bfhi(u[q].x), bflo(u[q].y), bfhi(u[q].y), bflo(u[q].z), bfhi(u[q].z), bflo(u[q].w), bfhi(u[q].w)};
      float ss = 0.f;
#pragma unroll
      for (int j = 0; j < 8; ++j) ss += v[j] * v[j];
      ss = wave_sum(ss, lane);
      const float r = rsqrtf(ss * (1.f / 512.f) + EPS);
      *(uint4*)(AY + (long)(row0 + q) * 1024 + 512 + lane * 8) = make_uint4(pack2(v[0] * r, v[1] * r), pack2(v[2] * r, v[3] * r), pack2(v[4] * r, v[5] * r), pack2(v[6] * r, v[7] * r));
    }
  }
}

__device__ __forceinline__ void phase_gemm_out(const Ctx& c) {
  char* ws = c.ws;
  DenseOrder S; S.init(ws + OFF_R1, 1024, ws + OFF_WOUT_T, 1024, NT, 1024, c.nblk, c.bid, 0);
  EpiRes<0> E{ws, INP(I_X), c.p.out, (float*)(ws + OFF_SSQA), nullptr, nullptr, 1.f};
  fast_gemm((LAS3 unsigned char*)c.smem, S, E, 1024, c.tid);
}

__device__ __forceinline__ void phase_pool_gemm(const Ctx& c) {
  char* ws = c.ws;
  DenseOrder S; S.init(ws + OFF_R1, 1024, ws + OFF_POOL_T, 256, NT, 1024, c.nblk, c.bid, 512);
  EpiRes<2> E{ws, nullptr, c.p.out, (float*)(ws + OFF_SSQA), INP(I_POOL_B), INP(I_POOL_SCALE), c.f};
  fast_gemm((LAS3 unsigned char*)c.smem, S, E, 256, c.tid);
}

__device__ __forceinline__ void phase_xq(const Ctx& c, int l) {
  char* ws = c.ws; char* smem = c.smem; const int bid = c.bid, nblk = c.nblk; (void)smem; (void)bid; (void)nblk;
  const int t = c.tid, er = t >> 1, eh = t & 1;
  const float* Cs = (const float*)smem;
  for (int item = bid; item < 512 * 2; item += nblk) {
    const int mt = item >> 1, nt = item & 1;
    gemm_dense((const bf16_t*)(ws + OFF_XCB) + (long)mt * 128 * 1024, 1024,
               (const bf16_t*)(ws + OFF_XQ_T) + (long)l * 256 * 1024 + (long)nt * 128 * 1024, 1024, 1024, smem, c.tid);
    if (t < 256) {
      const int row = mt * 128 + er;
      const float rs = row_rs32((const float*)(ws + OFF_SSQA), row);
      const float* crow = Cs + er * CS_LD + eh * 64;
      const float ss = cs_ssq(crow, 64) * rs * rs;
      const float r = rsqrtf(ss * (1.f / 64.f) + EPS) * rs * (0.125f * LOG2E);
      const float* g = INP(I_XQ_NORM) + l * 64;
      cs_store_scaled((bf16_t*)(ws + OFF_XQ) + (long)row * 256 + (nt * 2 + eh) * 64, crow, 64, r, g);
    }
    __syncthreads();
  }
}

__device__ __forceinline__ void phase_xattn(const Ctx& c, int l) {
  char* ws = c.ws; char* smem = c.smem; const int bid = c.bid, nblk = c.nblk; (void)smem; (void)bid; (void)nblk;
  for (int item = bid; item < 256 * 4; item += nblk) {
    const int mt = item >> 2, h = item & 3;
    const int b = mt >> 4;
    const bf16_t* Q = (const bf16_t*)(ws + OFF_XQ) + (long)mt * 256 * 256 + h * 64;
    const bf16_t* K = (const bf16_t*)(ws + OFF_MEMK) + (long)l * 4096 * 256 + (long)b * 256 * 256 + h * 64;
    const bf16_t* Vv = (const bf16_t*)(ws + OFF_MEMVT) + (long)l * 4096 * 256 + (long)b * 256 * 256 + h * 64;
    bf16_t* O = (bf16_t*)(ws + OFF_XO) + (long)mt * 256 * 256 + h * 64;
    attn_block<64, false>(Q, 256, K, 256, Vv, 256, 4, 0, O, 256, smem, c.tid);
  }
}

__device__ __forceinline__ void phase_xo(const Ctx& c, int l) {
  char* ws = c.ws;
  DenseOrder S; S.init(ws + OFF_XO, 256, ws + OFF_XO_T + (size_t)l * 1024 * 256 * 2, 256, NT, 1024, c.nblk, c.bid, 0);
  EpiRes<1> E{ws, nullptr, c.p.out, (float*)(ws + OFF_SSQB), nullptr, nullptr, c.f};
  fast_gemm((LAS3 unsigned char*)c.smem, S, E, 256, c.tid);
}

__device__ __forceinline__ void phase_router(const Ctx& c, int l) {
  char* ws = c.ws; char* smem = c.smem; const int bid = c.bid, nblk = c.nblk;
  const int t = c.tid, lane = t & 63, w = t >> 6, l15 = lane & 15, lq = lane >> 4;
  bf16_t* Ah = (bf16_t*)smem;
  bf16_t* Al = Ah + 128 * 72;
  bf16_t* Wh = Al + 128 * 72;
  bf16_t* Wl = Wh + 48 * 72;
  float* rsl = (float*)(Wl + 48 * 72);
  float* lg = rsl + 128;
  const float* lnf = INP(I_LN_FFN) + l * 1024;
  const bf16_t* wrh = (const bf16_t*)(ws + OFF_WR) + (size_t)(l * 2) * 48 * 1024;
  const bf16_t* wrl = wrh + 48 * 1024;
  int* cnt = (int*)(ws + OFF_CTL) + CTL_CNT + l * 32;
  int* list = (int*)(ws + OFF_LIST);
  float* gate = (float*)(ws + OFF_GATE);
  for (int item = bid; item < NT / 128; item += nblk) {
    const int tok0 = item * 128;
    if (t < 128) {
      const float r = row_rs32((const float*)(ws + OFF_SSQB), tok0 + t);
      rsl[t] = r; ((float*)(ws + OFF_RS2))[tok0 + t] = r;
    }
    f32x4 acc[3];
#pragma unroll
    for (int i = 0; i < 3; ++i) acc[i] = zero4();
    const int lr = t >> 4, lc = (t & 15) * 4;
    float4 xv[4];
#pragma unroll
    for (int i = 0; i < 4; ++i) xv[i] = *(const float4*)(c.p.out + (long)(tok0 + lr + 32 * i) * 1024 + lc);
    __syncthreads();
    for (int kc = 0; kc < 16; ++kc) {
      const float4 gn = *(const float4*)(lnf + kc * 64 + lc);
#pragma unroll
      for (int i = 0; i < 4; ++i) {
        const float rs = rsl[lr + 32 * i];
        const float h0 = xv[i].x * rs * gn.x, h1 = xv[i].y * rs * gn.y, h2 = xv[i].z * rs * gn.z, h3 = xv[i].w * rs * gn.w;
        const bf16_t b0 = f2bf(h0), b1 = f2bf(h1), b2 = f2bf(h2), b3 = f2bf(h3);
        *(uint2*)(Ah + (lr + 32 * i) * 72 + lc) = make_uint2((unsigned)b0 | ((unsigned)b1 << 16), (unsigned)b2 | ((unsigned)b3 << 16));
        *(uint2*)(Al + (lr + 32 * i) * 72 + lc) = make_uint2(pack2(h0 - bf2f(b0), h1 - bf2f(b1)), pack2(h2 - bf2f(b2), h3 - bf2f(b3)));
      }
      if (t < 384) { const int r = t >> 3, cc = (t & 7) * 8; *(uint4*)(Wh + r * 72 + cc) = *(const uint4*)(wrh + r * 1024 + kc * 64 + cc); }
      else if (t < 384 + 128) { const int u = t - 384; for (int q = u; q < 384; q += 128) { const int r = q >> 3, cc = (q & 7) * 8; *(uint4*)(Wl + r * 72 + cc) = *(const uint4*)(wrl + r * 1024 + kc * 64 + cc); } }
      if (kc + 1 < 16) {
#pragma unroll
        for (int i = 0; i < 4; ++i) xv[i] = *(const float4*)(c.p.out + (long)(tok0 + lr + 32 * i) * 1024 + (kc + 1) * 64 + lc);
      }
      __syncthreads();
#pragma unroll
      for (int ks = 0; ks < 2; ++ks) {
        const bf16x8 ah = *(const bf16x8*)(Ah + (w * 16 + l15) * 72 + ks * 32 + lq * 8);
        const bf16x8 al = *(const bf16x8*)(Al + (w * 16 + l15) * 72 + ks * 32 + lq * 8);
#pragma unroll
        for (int nt = 0; nt < 3; ++nt) {
          const bf16x8 wh = *(const bf16x8*)(Wh + (nt * 16 + l15) * 72 + ks * 32 + lq * 8);
          const bf16x8 wl = *(const bf16x8*)(Wl + (nt * 16 + l15) * 72 + ks * 32 + lq * 8);
          acc[nt] = mfma16(ah, wh, acc[nt]);
          acc[nt] = mfma16(al, wh, acc[nt]);
          acc[nt] = mfma16(ah, wl, acc[nt]);
        }
      }
      __syncthreads();
    }
#pragma unroll
    for (int nt = 0; nt < 3; ++nt)
#pragma unroll
      for (int r = 0; r < 4; ++r) lg[(w * 16 + lq * 4 + r) * 49 + nt * 16 + l15] = acc[nt][r];
    __syncthreads();
    if (t < 128) {
      const int tok = tok0 + t;
      const float* L = lg + t * 49;
      float gl[4];
#pragma unroll
      for (int i = 0; i < 4; ++i) gl[i] = L[i] + INP(I_RG_B)[l * 4 + i];
      int gi = 0; float gm = gl[0];
#pragma unroll
      for (int i = 1; i < 4; ++i) if (gl[i] > gm) { gm = gl[i]; gi = i; }
      float gsum = 0.f;
#pragma unroll
      for (int i = 0; i < 4; ++i) gsum += __expf(gl[i] - gm);
      const float gp = 1.f / gsum;
      float e0 = -3e38f, e1 = -3e38f; int i0 = 0, i1 = 0;
      for (int j = 0; j < 8; ++j) {
        const float v = L[4 + gi * 8 + j] + INP(I_RE_B)[l * 32 + gi * 8 + j];
        if (v > e0) { e1 = e0; i1 = i0; e0 = v; i0 = j; }
        else if (v > e1) { e1 = v; i1 = j; }
      }
      const float p1 = __expf(e1 - e0);
      const float g0 = gp / (1.f + p1), g1 = gp * p1 / (1.f + p1);
      const int x0 = gi * 8 + i0, x1 = gi * 8 + i1;
      if (c.f != 0.f) {
        const int pos0 = atomicAdd(&cnt[x0], 1);
        list[x0 * 65536 + pos0] = tok * 2;
        const int pos1 = atomicAdd(&cnt[x1], 1);
        list[x1 * 65536 + pos1] = tok * 2 + 1;
        gate[tok * 2] = g0; gate[tok * 2 + 1] = g1;
      }
    }
    __syncthreads();
  }
}

__device__ __forceinline__ int expert_prefix(const int* cnt, int* pre, int tid) {
  if (tid == 0) {
    int s = 0;
    for (int e = 0; e < 32; ++e) { pre[e] = s; s += (cnt[e] + 255) >> 8; }
    pre[32] = s;
  }
  __syncthreads();
  return pre[32];
}

struct ExpertOrder {
  static constexpr bool GATHER = true;
  const char* A; const char* W; const int* list; const int* cnt; const int* pre; int lda_, ldb_, nN, total, G, c, which; size_t wstride;
  __device__ __forceinline__ bool next(int i, FUnit& u) const {
    const long L = (long)i * G + c; if (L >= (long)total * nN) return false;
    const int tile = (int)(L / nN); u.pn = (int)(L % nN); u.pm = tile;
    int e = 0;
    for (int j = 1; j < 32; ++j) if (pre[j] <= tile) e = j;
    e = __builtin_amdgcn_readfirstlane(e);
    u.e = e; u.pos0 = __builtin_amdgcn_readfirstlane((tile - pre[e]) * 256);
    u.nvalid = __builtin_amdgcn_readfirstlane(min(256, cnt[e] - u.pos0)); return true;
  }
  __device__ __forceinline__ unsigned lda() const { return (unsigned)lda_; }
  __device__ __forceinline__ unsigned ldb() const { return (unsigned)ldb_; }
  __device__ __forceinline__ const char* a_ptr(const FUnit&) const { return A; }
  __device__ __forceinline__ const char* b_ptr(const FUnit& u) const { return W + (size_t)u.e * wstride + (size_t)u.pn * 256 * ldb_ * 2; }
  __device__ __forceinline__ void a_offs(const FUnit& u, int tid, unsigned (&va)[2][2]) const {
    int R0, C0, R1, C1; fg_stage_rc(tid * 16, R0, C0); fg_stage_rc(tid * 16 + 8192, R1, C1);
    const int* lp = list + u.e * 65536 + u.pos0;
#pragma unroll
    for (int h = 0; h < 2; ++h) {
      const int p0 = lp[min(128 * h + R0, u.nvalid - 1)], p1 = lp[min(128 * h + R1, u.nvalid - 1)];
      const int r0 = which == 0 ? (p0 >> 1) : p0, r1 = which == 0 ? (p1 >> 1) : p1;
      va[h][0] = (unsigned)(r0 * lda_ + C0) * 2u; va[h][1] = (unsigned)(r1 * lda_ + C1) * 2u;
    }
  }
};

struct EpiExpUp {
  char* ws; const int* list;
  __device__ __forceinline__ void operator()(const f32x4 (&acc)[2][2][4][2], const FUnit& u, int wr, int wc, int fr, int fq, int lane) const {
    const float* rs2 = (const float*)(ws + OFF_RS2);
    bf16_t* hb = (bf16_t*)(ws + OFF_HBUF);
#pragma unroll
    for (int ai = 0; ai < 2; ++ai)
#pragma unroll
      for (int m = 0; m < 4; ++m) {
        const int rl = ai * 128 + wr * 64 + m * 16 + fr;
        const int pair = list[u.e * 65536 + u.pos0 + min(rl, u.nvalid - 1)];
        const float rs = rs2[pair >> 1];
        if (rl < u.nvalid) {
#pragma unroll
          for (int bj = 0; bj < 2; ++bj) {
            const f32x4 g4 = acc[ai][bj][m][0] * rs, u4 = acc[ai][bj][m][1] * rs;
            const int col = u.pn * 128 + bj * 64 + wc * 16 + fq * 4;
            uint2 w2; w2.x = cvt_pk_bf16(silu_f(g4[0]) * u4[0], silu_f(g4[1]) * u4[1]); w2.y = cvt_pk_bf16(silu_f(g4[2]) * u4[2], silu_f(g4[3]) * u4[3]);
            *(uint2*)(hb + (long)pair * 256 + col) = w2;
          }
        }
      }
  }
};
struct EpiExpDown {
  char* ws; const int* list;
  __device__ __forceinline__ void operator()(const f32x4 (&acc)[2][2][4][2], const FUnit& u, int wr, int wc, int fr, int fq, int lane) const {
    const float* gate = (const float*)(ws + OFF_GATE);
    bf16_t* yb = (bf16_t*)(ws + OFF_R2);
#pragma unroll
    for (int ai = 0; ai < 2; ++ai)
#pragma unroll
      for (int m = 0; m < 4; ++m) {
        const int rl = ai * 128 + wr * 64 + m * 16 + fr;
        const int pair = list[u.e * 65536 + u.pos0 + min(rl, u.nvalid - 1)];
        const float gt = gate[pair];
        if (rl < u.nvalid) {
#pragma unroll
          for (int bj = 0; bj < 2; ++bj) {
            const f32x4 v0 = acc[ai][bj][m][0] * gt, v1 = acc[ai][bj][m][1] * gt;
            const int col0 = u.pn * 256 + bj * 128 + wc * 32 + fq * 8;
            u32x4 w4; w4.x = cvt_pk_bf16(v0[0], v0[1]); w4.y = cvt_pk_bf16(v0[2], v0[3]); w4.z = cvt_pk_bf16(v1[0], v1[1]); w4.w = cvt_pk_bf16(v1[2], v1[3]);
            *(u32x4*)(yb + (long)pair * 1024 + col0) = w4;
          }
        }
      }
  }
};

template <int WHICH>
__device__ __forceinline__ void phase_expert(const Ctx& c, int l) {
  char* ws = c.ws; char* smem = c.smem;
  int* pre = (int*)(smem + SMEM_MAIN + 16);
  const int* cnt = (const int*)(ws + OFF_CTL) + CTL_CNT + l * 32;
  const int* list = (const int*)(ws + OFF_LIST);
  const int ttiles = expert_prefix(cnt, pre, c.tid);
  ExpertOrder S;
  S.list = list; S.cnt = cnt; S.pre = pre; S.total = ttiles; S.G = c.nblk; S.c = c.bid; S.which = WHICH;
  if (WHICH == 0) {
    S.A = ws + OFF_XCB; S.lda_ = 1024; S.W = ws + OFF_WGU_T + (size_t)l * 32 * 512 * 1024 * 2; S.ldb_ = 1024; S.nN = 2; S.wstride = (size_t)512 * 1024 * 2;
    EpiExpUp E{ws, list};
    fast_gemm((LAS3 unsigned char*)smem, S, E, 1024, c.tid);
  } else {
    S.A = ws + OFF_HBUF; S.lda_ = 256; S.W = ws + OFF_WD_T + (size_t)l * 32 * 1024 * 256 * 2; S.ldb_ = 256; S.nN = 4; S.wstride = (size_t)1024 * 256 * 2;
    EpiExpDown E{ws, list};
    fast_gemm((LAS3 unsigned char*)smem, S, E, 256, c.tid);
  }
}

__device__ __forceinline__ void phase_combine(const Ctx& c, int l) {
  char* ws = c.ws; const int bid = c.bid, nblk = c.nblk;
  const int lane = c.tid & 63;
  const int gw = bid * NWAV + (c.tid >> 6), nw = nblk * NWAV;
  const bf16_t* yb = (const bf16_t*)(ws + OFF_R2);
  bf16_t* xnb = (bf16_t*)(ws + OFF_R4);
  for (int row0 = gw * 2; row0 < NT; row0 += nw * 2) {
    float4 x[2][4]; uint2 ya[2][4], yc[2][4];
#pragma unroll
    for (int q = 0; q < 2; ++q)
#pragma unroll
      for (int i = 0; i < 4; ++i) {
        const int cc = i * 256 + lane * 4; const long row = row0 + q;
        x[q][i] = *(const float4*)(c.p.out + row * 1024 + cc);
        ya[q][i] = *(const uint2*)(yb + (row * 2) * 1024 + cc); yc[q][i] = *(const uint2*)(yb + (row * 2 + 1) * 1024 + cc);
      }
#pragma unroll
    for (int q = 0; q < 2; ++q) {
      const long row = row0 + q;
      float ss = 0.f;
#pragma unroll
      for (int i = 0; i < 4; ++i) {
        const int cc = i * 256 + lane * 4;
        float4 v = x[q][i];
        v.x += c.f * (bflo(ya[q][i].x) + bflo(yc[q][i].x)); v.y += c.f * (bfhi(ya[q][i].x) + bfhi(yc[q][i].x));
        v.z += c.f * (bflo(ya[q][i].y) + bflo(yc[q][i].y)); v.w += c.f * (bfhi(ya[q][i].y) + bfhi(yc[q][i].y));
        *(float4*)(c.p.out + row * 1024 + cc) = v;
        x[q][i] = v;
        ss += v.x * v.x + v.y * v.y + v.z * v.z + v.w * v.w;
      }
      if (l == 0) {
        ss = wave_sum(ss, lane);
        const float r = rsqrtf(ss * (1.f / 1024.f) + EPS);
#pragma unroll
        for (int i = 0; i < 4; ++i)
          *(uint2*)(xnb + row * 1024 + i * 256 + lane * 4) = make_uint2(pack2(x[q][i].x * r, x[q][i].y * r), pack2(x[q][i].z * r, x[q][i].w * r));
      }
    }
  }
}

__device__ __forceinline__ void phase_pool_dlt(const Ctx& c) {
  char* ws = c.ws; char* smem = c.smem; const int bid = c.bid, nblk = c.nblk; (void)smem; (void)bid; (void)nblk;
  const bf16_t* xnb = (const bf16_t*)(ws + OFF_R4);
  bf16_t* dl = (bf16_t*)(ws + OFF_R1);
  const long gt = (long)bid * NTHR + c.tid, gn = (long)nblk * NTHR;
  for (long i = gt; i < (long)NT * 128; i += gn) {
    const int tok = (int)(i >> 7), ch = (int)(i & 127) * 8;
    const int s = tok & 4095;
    const int wnd = 2 << (ch >> 8);
    const int n = min(s + 1, wnd);
    float a[8] = {0.f, 0.f, 0.f, 0.f, 0.f, 0.f, 0.f, 0.f};
    float self[8];
    for (int k = 0; k < n; ++k) {
      const uint4 u = *(const uint4*)(xnb + (long)(tok - k) * 1024 + ch);
      const float f[8] = {bflo(u.x), bfhi(u.x), bflo(u.y), bfhi(u.y), bflo(u.z), bfhi(u.z), bflo(u.w), bfhi(u.w)};
#pragma unroll
      for (int j = 0; j < 8; ++j) { a[j] += f[j]; if (k == 0) self[j] = f[j]; }
    }
    const float inv = 1.f / (float)n;
#pragma unroll
    for (int j = 0; j < 8; ++j) a[j] = a[j] * inv - self[j];
    *(uint4*)(dl + (long)tok * 1024 + ch) = make_uint4(pack2(a[0], a[1]), pack2(a[2], a[3]), pack2(a[4], a[5]), pack2(a[6], a[7]));
  }
}

#define XB_TMO      128
#define XB_XCNT(j)  (256  + 64 * (j))
#define XB_XSUB(j)  (1280 + 64 * (j))
#define XB_XGEN(j)  (2304 + 64 * (j))
#define XB_TOP      3328
#define XB_TOPGEN   3392
#define XCD_BAR_WORDS 3456
#define XB_SPIN_CAP (1u << 22)
#define LAS __attribute__((address_space(3)))
__device__ __forceinline__ unsigned xb_ld(unsigned* p)              { return __hip_atomic_load(p, __ATOMIC_RELAXED, __HIP_MEMORY_SCOPE_AGENT); }
__device__ __forceinline__ unsigned xb_add(unsigned* p, unsigned v) { return __hip_atomic_fetch_add(p, v, __ATOMIC_RELAXED, __HIP_MEMORY_SCOPE_AGENT); }
__device__ __forceinline__ unsigned xb_xcc_id() { return (unsigned)__builtin_amdgcn_s_getreg((3 << 11) | 20) & 0xFu; }
#define XB_SPIN(cond, bar) do { unsigned _sp = 0; while (cond) { __builtin_amdgcn_s_sleep(1); \
    if ((++_sp & 255u) == 0u) { if (xb_ld(&(bar)[XB_TMO])) break; if (_sp > XB_SPIN_CAP) { atomicAdd(&(bar)[XB_TMO], 1u); break; } } } } while (0)
struct XcdBarrier { unsigned* bar; unsigned x; volatile LAS unsigned* st; };
__device__ __forceinline__ XcdBarrier xcd_barrier_post(unsigned* bar, volatile LAS unsigned* st) {
  XcdBarrier b; b.bar = bar; b.x = xb_xcc_id(); b.st = st;
  if (threadIdx.x == 0) (void)xb_add(&bar[XB_XCNT(b.x)], 1u);
  return b;
}
__device__ __forceinline__ void xcd_barrier_complete(unsigned* bar, unsigned x, unsigned& nloc, unsigned& nx) {
  const unsigned G = gridDim.x * gridDim.y * gridDim.z;
  unsigned sum, cnt, mine, sp = 0u;
  for (;;) {
    sum = 0u; cnt = 0u; mine = 0u;
#pragma unroll
    for (unsigned j = 0; j < 16; ++j) { const unsigned cc = xb_ld(&bar[XB_XCNT(j)]); sum += cc; cnt += (cc > 0u) ? 1u : 0u; mine = (j == x) ? cc : mine; }
    if (sum == G) break;
    __builtin_amdgcn_s_sleep(1);
    if ((++sp & 255u) == 0u) { if (xb_ld(&bar[XB_TMO])) break; if (sp > XB_SPIN_CAP) { atomicAdd(&bar[XB_TMO], 1u); break; } }
  }
  nloc = mine > 0u ? mine : 1u; nx = cnt > 0u ? cnt : 1u;
}
__device__ __forceinline__ void xcd_barrier(const XcdBarrier& b) {
  asm volatile("s_waitcnt vmcnt(0)" ::: "memory");
  __syncthreads();
  if (threadIdx.x == 0) {
    unsigned* bar = b.bar;
    __builtin_amdgcn_s_waitcnt(0);
    unsigned nloc = b.st[0], nx = b.st[1];
    if (nloc == 0u) { xcd_barrier_complete(bar, b.x, nloc, nx); b.st[0] = nloc; b.st[1] = nx; }
    const unsigned old = xb_add(&bar[XB_XSUB(b.x)], 1u);
    const unsigned gen = old / nloc;
    if (old + 1u == (gen + 1u) * nloc) {
      __builtin_amdgcn_fence(__ATOMIC_RELEASE, "agent");
      asm volatile("s_waitcnt vmcnt(0)" ::: "memory");
      const unsigned og = xb_add(&bar[XB_TOP], 1u);
      const unsigned tg = og / nx;
      if (og + 1u == (tg + 1u) * nx) xb_add(&bar[XB_TOPGEN], 1u);
      else XB_SPIN(xb_ld(&bar[XB_TOPGEN]) == tg, bar);
      __builtin_amdgcn_fence(__ATOMIC_ACQUIRE, "agent");
      xb_add(&bar[XB_XGEN(b.x)], 1u);
      asm volatile("s_waitcnt vmcnt(0)" ::: "memory");
    } else {
      XB_SPIN(xb_ld(&bar[XB_XGEN(b.x)]) == gen, bar);
      __builtin_amdgcn_fence(__ATOMIC_ACQUIRE, "agent");
      asm volatile("s_waitcnt vmcnt(0)" ::: "memory");
    }
  }
  __syncthreads();
}

constexpr int N_PHASES = 22;
#define RUN_PHASE(PH, CALL) do { \
    constexpr int nrep_ = ((PROBE_MASK >> (PH)) & 1u) ? 2 : 1; \
    _Pragma("unroll 1") for (int rep_ = 0; rep_ < nrep_; ++rep_) { \
      int tid = threadIdx.x; asm volatile("" : "+v"(tid)); \
      size_t wz = 0; asm volatile("" : "+s"(wz)); \
      char* ws = p.ws + wz; \
      int bid = blockIdx.x; asm volatile("" : "+s"(bid)); \
      int nblk = gridDim.x; asm volatile("" : "+s"(nblk)); \
      const Ctx c{p, ws, smem, tid, bid, nblk, (PROBE_MASK != 0u && rep_) ? 0.f : 1.f, rep_}; \
      CALL; \
      if ((PH) + 1 < N_PHASES || rep_ + 1 < nrep_) xcd_barrier(xb); \
    } } while (0)

__global__ void __launch_bounds__(NTHR, 2) fwd_megakernel(Params p) {
  extern __shared__ __attribute__((aligned(16))) char smem[];
  volatile LAS unsigned* xst = (volatile LAS unsigned*)(smem + SMEM_MAIN + 256);
  if (threadIdx.x < 4) xst[threadIdx.x] = 0u;
  __syncthreads();
  const XcdBarrier xb = xcd_barrier_post((unsigned*)(p.ws + OFF_BAR), xst);
  RUN_PHASE(0, phase_prep(c));
  RUN_PHASE(1, phase_gemm_in(c));
  RUN_PHASE(2, phase_up(c));
  RUN_PHASE(3, phase_mix(c));
  RUN_PHASE(4, phase_ynorm(c));
  RUN_PHASE(5, phase_gemm_out(c));
  RUN_PHASE(6, phase_xq(c, 0));
  RUN_PHASE(7, phase_xattn(c, 0));
  RUN_PHASE(8, phase_xo(c, 0));
  RUN_PHASE(9, phase_router(c, 0));
  RUN_PHASE(10, phase_expert<0>(c, 0));
  RUN_PHASE(11, phase_expert<1>(c, 0));
  RUN_PHASE(12, phase_combine(c, 0));
  RUN_PHASE(13, phase_pool_dlt(c));
  RUN_PHASE(14, phase_pool_gemm(c));
  RUN_PHASE(15, phase_xq(c, 1));
  RUN_PHASE(16, phase_xattn(c, 1));
  RUN_PHASE(17, phase_xo(c, 1));
  RUN_PHASE(18, phase_router(c, 1));
  RUN_PHASE(19, phase_expert<0>(c, 1));
  RUN_PHASE(20, phase_expert<1>(c, 1));
  RUN_PHASE(21, phase_combine(c, 1));
}

extern "C" void kernel_launch(void* const* d_in, const int* in_sizes, int n_in, void* d_out,
                              int out_size, void* d_ws, size_t ws_size, hipStream_t stream) {
  static int grid_blocks = 0;
  if (!grid_blocks) {
    int dev = 0, cus = 0, per_cu = 0;
    (void)hipGetDevice(&dev);
    (void)hipDeviceGetAttribute(&cus, hipDeviceAttributeMultiprocessorCount, dev);
    (void)hipFuncSetAttribute((const void*)fwd_megakernel, hipFuncAttributeMaxDynamicSharedMemorySize, SMEM_BYTES);
    (void)hipOccupancyMaxActiveBlocksPerMultiprocessor(&per_cu, fwd_megakernel, NTHR, SMEM_BYTES);
    if (per_cu > 1) per_cu = 1;
    if (per_cu < 1) per_cu = 1;
    grid_blocks = cus * per_cu;
    if (ws_size < WS_END) { fprintf(stderr, "workspace too small: %zu < %zu\n", ws_size, (size_t)WS_END); grid_blocks = -1; }
    if (n_in != N_IN) { fprintf(stderr, "unexpected n_in %d\n", n_in); grid_blocks = -1; }
  }
  if (grid_blocks < 0) return;
  Params p{};
  for (int i = 0; i < N_IN; ++i) p.in[i] = d_in[i];
  p.out = (float*)d_out;
  p.ws = (char*)d_ws;
  (void)hipMemsetAsync((char*)d_ws + OFF_BAR, 0, 16384, stream);
  void* args[] = {&p};
  hipError_t e = hipLaunchCooperativeKernel((void*)fwd_megakernel, dim3(grid_blocks), dim3(NTHR), args, SMEM_BYTES, stream);
  if (e != hipSuccess) fprintf(stderr, "cooperative launch failed: %s (grid %d)\n", hipGetErrorString(e), grid_blocks);
}
```

```cpp
#include <hip/hip_runtime.h>
#include <hip/hip_cooperative_groups.h>
#include <cstdio>
#include <cstdint>
namespace cg = cooperative_groups;

#ifndef MULTI_LAUNCH
#define MULTI_LAUNCH 0
#endif

typedef unsigned short bf16_t;
typedef short bf16x8 __attribute__((ext_vector_type(8)));
typedef float f32x4 __attribute__((ext_vector_type(4)));
typedef unsigned u32x4 __attribute__((ext_vector_type(4)));

constexpr int NT = 65536, DM = 1024, SEQ = 4096, NB = 16;
constexpr int NTHR = 512, NWAV = 8;
constexpr int PROJ_LD = 2048;
constexpr int C_QLAT = 0, C_KVLAT = 256, C_KROPE = 384, C_Z = 416, C_XBC = 928, C_DT = 1952;
constexpr float EPS = 1e-6f;
constexpr float LOG2E = 1.4426950408889634f;

enum { I_X = 0, I_MEM, I_POS, I_LN_MIX, I_W_IN, I_QLAT_NORM, I_W_UQ, I_KVLAT_NORM, I_W_UKV, I_Q_NORM, I_K_NORM,
       I_CONV_W, I_CONV_B, I_DT_BIAS, I_A_LOG, I_D_SKIP, I_SSD_NORM, I_W_OUT, I_POOL_W, I_POOL_B, I_POOL_SCALE,
       I_LN_XQ, I_LN_MEM, I_XQ_W, I_XKV_W, I_XQ_NORM, I_XK_NORM, I_XO_W, I_LN_FFN, I_RG_W, I_RG_B, I_RE_W, I_RE_B,
       I_EXP_G, I_EXP_U, I_EXP_D, N_IN };

constexpr size_t MiB = 1ull << 20;
constexpr size_t OFF_WIN_T = 0;
constexpr size_t OFF_WUQ_T = OFF_WIN_T + 2048ull * 1024 * 2;
constexpr size_t OFF_WUKV_T = OFF_WUQ_T + 1024ull * 256 * 2;
constexpr size_t OFF_WOUT_T = OFF_WUKV_T + 1024ull * 256 * 2;
constexpr size_t OFF_POOL_T = OFF_WOUT_T + 1024ull * 1024 * 2;
constexpr size_t OFF_XQ_T = OFF_POOL_T + 4ull * 256 * 256 * 2;
constexpr size_t OFF_XKV_T = OFF_XQ_T + 2ull * 256 * 1024 * 2;
constexpr size_t OFF_XO_T = OFF_XKV_T + 2ull * 512 * 1024 * 2;
constexpr size_t OFF_WGU_T = OFF_XO_T + 2ull * 1024 * 256 * 2;
constexpr size_t OFF_WD_T = OFF_WGU_T + 64ull * 512 * 1024 * 2;
constexpr size_t OFF_R1 = OFF_WD_T + 64ull * 1024 * 256 * 2;
constexpr size_t OFF_R2 = OFF_R1 + 128 * MiB;
constexpr size_t OFF_R3 = OFF_R2 + 256 * MiB;
constexpr size_t OFF_R4 = OFF_R3 + 256 * MiB;
constexpr size_t OFF_MISC = OFF_R4 + 128 * MiB;
constexpr size_t OFF_Q = OFF_R3, OFF_K = OFF_R3 + 96 * MiB, OFF_VT = OFF_R3 + 192 * MiB;
constexpr size_t OFF_XCB = OFF_R3, OFF_XQ = OFF_R3 + 128 * MiB, OFF_XO = OFF_R3 + 160 * MiB;
constexpr size_t OFF_RS0 = OFF_MISC;
constexpr size_t OFF_SSQ_Q = OFF_RS0 + NT * 4ull;
constexpr size_t OFF_SSQ_KV = OFF_SSQ_Q + NT * 32ull;
constexpr size_t OFF_DTRAW = OFF_SSQ_KV + NT * 16ull;
constexpr size_t OFF_DT = OFF_DTRAW + NT * 32ull;
constexpr size_t OFF_SSQA = OFF_DT + NT * 32ull;
constexpr size_t OFF_SSQB = OFF_SSQA + NT * 128ull;
constexpr size_t OFF_RS3 = OFF_SSQB + NT * 128ull;
constexpr size_t OFF_RS2 = OFF_RS3 + NT * 4ull;
constexpr size_t OFF_MEMB = OFF_RS2 + NT * 4ull;
constexpr size_t OFF_RSM = OFF_MEMB + 4096ull * 1024 * 2;
constexpr size_t OFF_MEMK = OFF_RSM + 4096 * 4ull;
constexpr size_t OFF_MEMVT = OFF_MEMK + 2ull * 4096 * 256 * 2;
constexpr size_t OFF_GATE = OFF_MEMVT + 2ull * 4096 * 256 * 2;
constexpr size_t OFF_PINFO = OFF_GATE + NT * 8ull;
constexpr size_t OFF_LIST = OFF_PINFO + NT * 8ull;
constexpr size_t OFF_CTL = OFF_LIST + 32ull * 65536 * 4;
constexpr size_t OFF_WR = OFF_CTL + 4096;
constexpr size_t OFF_BAR = OFF_WR + 2ull * 2 * 48 * 1024 * 2;
constexpr size_t OFF_HBUF = OFF_BAR + 16384;
constexpr size_t WS_END = OFF_HBUF + 544ull * 256 * 256 * 2;
constexpr size_t OFF_YBUF = OFF_R2 - 16 * MiB;

constexpr int CTL_CNT = 0;
constexpr int CTL_QCTR = 64;

constexpr int LDS_ST = 72;
constexpr int CS_LD = 132;
constexpr int SMEM_BYTES = 160 * 1024;
constexpr int SMEM_MAIN = SMEM_BYTES - 1024;

struct Params {
  const void* in[N_IN];
  float* out;
  char* ws;
  int phase_lo, phase_hi;
};

#ifndef PROBE_MASK
#define PROBE_MASK 0u
#endif
struct Ctx { const Params& p; char* ws; char* smem; int tid, bid, nblk; float f; int pass; };
__device__ __forceinline__ int opq(int i) { asm volatile("" : "+s"(i)); return i; }
#define INP(i) ((const float*)c.p.in[opq(i)])

__device__ __forceinline__ bf16_t f2bf(float f) {
  unsigned u = __float_as_uint(f);
  u += 0x7fffu + ((u >> 16) & 1u);
  return (bf16_t)(u >> 16);
}
__device__ __forceinline__ float bf2f(bf16_t h) { return __uint_as_float(((unsigned)h) << 16); }
__device__ __forceinline__ unsigned pack2(float lo, float hi) { return (unsigned)f2bf(lo) | ((unsigned)f2bf(hi) << 16); }
__device__ __forceinline__ float bflo(unsigned u) { return __uint_as_float(u << 16); }
__device__ __forceinline__ float bfhi(unsigned u) { return __uint_as_float(u & 0xffff0000u); }
__device__ __forceinline__ float silu_f(float x) { return x / (1.f + __expf(-x)); }
template <int M> __device__ __forceinline__ float sxor(float v) {
  static_assert(M >= 1 && M < 32, "swizzle xor mask");
  return __int_as_float(__builtin_amdgcn_ds_swizzle(__float_as_int(v), (M << 10) | 0x1f));
}
__device__ __forceinline__ float lane_get(float v, int src_lane) { return __int_as_float(__builtin_amdgcn_ds_bpermute(src_lane << 2, __float_as_int(v))); }
__device__ __forceinline__ float wave_sum(float v, int lane) {
  v += sxor<1>(v); v += sxor<2>(v); v += sxor<4>(v); v += sxor<8>(v); v += sxor<16>(v);
  v += lane_get(v, lane ^ 32);
  return v;
}
typedef short s16x4 __attribute__((ext_vector_type(4)));
__device__ __forceinline__ bf16x8 tr_frag(const bf16_t* M, int ld, int k0, int n0, int l15, int lq) {
  const bf16_t* p0 = M + (k0 + 8 * lq + (l15 >> 2)) * ld + n0 + 4 * (l15 & 3);
  const s16x4 a = __builtin_amdgcn_ds_read_tr16_b64_v4i16((__attribute__((address_space(3))) s16x4*)p0);
  const s16x4 b = __builtin_amdgcn_ds_read_tr16_b64_v4i16((__attribute__((address_space(3))) s16x4*)(p0 + 4 * ld));
  return (bf16x8){a[0], a[1], a[2], a[3], b[0], b[1], b[2], b[3]};
}
__device__ __forceinline__ unsigned cvt_pk_bf16(float lo, float hi) { unsigned r; asm volatile("v_cvt_pk_bf16_f32 %0, %1, %2" : "=v"(r) : "v"(lo), "v"(hi)); return r; }
__device__ __forceinline__ f32x4 zero4() { float z = 0.f; asm volatile("" : "+v"(z)); return (f32x4){z, z, z, z}; }
__device__ __forceinline__ f32x4 mfma16(bf16x8 a, bf16x8 b, f32x4 c) { return __builtin_amdgcn_mfma_f32_16x16x32_bf16(a, b, c, 0, 0, 0); }

__device__ __forceinline__ void gemm_core(const char* Ab, const unsigned (&ao)[2], const char* Bb, const unsigned (&bo)[2], int K, char* smem, int tid) {
  const int t = tid, lane = t & 63, w = t >> 6;
  const int wr = w >> 1, wc = w & 1;
  const int l15 = lane & 15, lq = lane >> 4;
  bf16_t* As = (bf16_t*)smem;
  bf16_t* Bs = As + 2 * 128 * LDS_ST;
  const int srow = t >> 3, scol = (t & 7) * 8;
  const int nk = K >> 6;
  u32x4 ra0[2], rb0[2], ra1[2], rb1[2];
#define G_LOAD(RA, RB, KT) { const unsigned kk_ = (unsigned)((KT) < nk ? (KT) : nk - 1) * 128u; \
    _Pragma("unroll") for (int i = 0; i < 2; ++i) { RA[i] = *(const u32x4*)(Ab + (size_t)(ao[i] + kk_)); RB[i] = *(const u32x4*)(Bb + (size_t)(bo[i] + kk_)); } }
#define G_STORE(RA, RB, ST) { bf16_t* An_ = As + (ST) * 128 * LDS_ST; bf16_t* Bn_ = Bs + (ST) * 128 * LDS_ST; \
    _Pragma("unroll") for (int i = 0; i < 2; ++i) { *(u32x4*)(An_ + (srow + 64 * i) * LDS_ST + scol) = RA[i]; *(u32x4*)(Bn_ + (srow + 64 * i) * LDS_ST + scol) = RB[i]; } }
#define G_COMPUTE(ST) { const bf16_t* Ac = As + (ST) * 128 * LDS_ST; const bf16_t* Bc = Bs + (ST) * 128 * LDS_ST; \
    _Pragma("unroll") for (int ks = 0; ks < 2; ++ks) { bf16x8 af[2], bfr[4]; \
      _Pragma("unroll") for (int mt = 0; mt < 2; ++mt) af[mt] = *(const bf16x8*)(Ac + (wr * 32 + mt * 16 + l15) * LDS_ST + ks * 32 + lq * 8); \
      _Pragma("unroll") for (int nt = 0; nt < 4; ++nt) bfr[nt] = *(const bf16x8*)(Bc + (wc * 64 + nt * 16 + l15) * LDS_ST + ks * 32 + lq * 8); \
      _Pragma("unroll") for (int mt = 0; mt < 2; ++mt) _Pragma("unroll") for (int nt = 0; nt < 4; ++nt) acc[mt][nt] = mfma16(af[mt], bfr[nt], acc[mt][nt]); } }
  G_LOAD(ra0, rb0, 0)
  G_LOAD(ra1, rb1, 1)
  G_STORE(ra0, rb0, 0)
  __syncthreads();
  f32x4 acc[2][4];
#pragma unroll
  for (int i = 0; i < 2; ++i)
#pragma unroll
    for (int j = 0; j < 4; ++j) acc[i][j] = zero4();
  for (int kt = 0; kt < nk; kt += 2) {
    G_LOAD(ra0, rb0, kt + 2)
    __builtin_amdgcn_sched_barrier(0);
    G_COMPUTE(0)
    G_STORE(ra1, rb1, 1)
    __syncthreads();
    G_LOAD(ra1, rb1, kt + 3)
    __builtin_amdgcn_sched_barrier(0);
    G_COMPUTE(1)
    G_STORE(ra0, rb0, 0)
    __syncthreads();
  }
#undef G_LOAD
#undef G_STORE
#undef G_COMPUTE
  float* Cs = (float*)smem;
#pragma unroll
  for (int mt = 0; mt < 2; ++mt)
#pragma unroll
    for (int nt = 0; nt < 4; ++nt)
#pragma unroll
      for (int r = 0; r < 4; ++r)
        Cs[(wr * 32 + mt * 16 + lq * 4 + r) * CS_LD + wc * 64 + nt * 16 + l15] = acc[mt][nt][r];
  __syncthreads();
}

__device__ __forceinline__ void gemm_dense(const bf16_t* A, long lda, const bf16_t* Bt, long ldb, int K, char* smem, int tid) {
  const int t = tid;
  const int srow = t >> 3, scol = (t & 7) * 8;
  unsigned ao[2], bo[2];
#pragma unroll
  for (int i = 0; i < 2; ++i) { ao[i] = (unsigned)(((srow + 64 * i) * lda + scol) * 2); bo[i] = (unsigned)(((srow + 64 * i) * ldb + scol) * 2); }
  gemm_core((const char*)A, ao, (const char*)Bt, bo, K, smem, tid);
}

template <int N>
__device__ __forceinline__ void store_bf16_row(bf16_t* dst, const float (&v)[N]) {
#pragma unroll
  for (int j = 0; j < N; j += 8) {
    uint4 u;
    u.x = pack2(v[j], v[j + 1]); u.y = pack2(v[j + 2], v[j + 3]); u.z = pack2(v[j + 4], v[j + 5]); u.w = pack2(v[j + 6], v[j + 7]);
    *(uint4*)(dst + j) = u;
  }
}


#define LAS3 __attribute__((address_space(3)))
constexpr int FG_HTB = 128 * 64 * 2;
__device__ __forceinline__ int fg_lds_byte(int r, int c) { const int st = (r >> 4) * 2 + (c >> 5), rr = r & 15, cc = c & 31, ob = rr * 64 + cc * 2; return st * 1024 + (ob ^ (((ob >> 9) & 1) << 5)); }
__device__ __forceinline__ void fg_stage_rc(int b, int& R, int& C) { const int st = b / 1024, sb = b % 1024, swz = sb ^ (((sb >> 9) & 1) << 5); R = (st >> 1) * 16 + swz / 64; C = (st & 1) * 32 + (swz % 64) / 2; }
__device__ __forceinline__ int fg_perm32(int rho) { const int n = rho >> 4, i = rho & 15; return 8 * (i >> 2) + 4 * n + (i & 3); }
struct FUnit { int pm, pn, e, pos0, nvalid; };

template <class Epi, class Sched>
__device__ __forceinline__ void fast_gemm(LAS3 unsigned char* lds, const Sched& S, const Epi& E, int K, int tid_) {
  const int tid = tid_, wid = __builtin_amdgcn_readfirstlane(tid >> 6), lane = tid & 63, wr = wid >> 2, wc = wid & 3, fr = lane & 15, fq = lane >> 4;
  const int nt = K / 64;
  int R0, C0, R1, C1; fg_stage_rc(tid * 16, R0, C0); fg_stage_rc(tid * 16 + 8192, R1, C1);
  const unsigned ldb = S.ldb();
  unsigned voffB[2];
  voffB[0] = (unsigned)(((R0 & ~31) + fg_perm32(R0 & 31)) * ldb + C0) * 2u;
  voffB[1] = (unsigned)(((R1 & ~31) + fg_perm32(R1 & 31)) * ldb + C1) * 2u;
  const size_t kstep = 128;
  const size_t hstepB = (size_t)128 * ldb * 2;
  const unsigned ldsw = (unsigned)wid * 1024u;
  const int aoff = fg_lds_byte(wr * 64 + fr, fq * 8), boff = fg_lds_byte(wc * 32 + fr, fq * 8);
#define FG_SA(b, h) (((b) * 2 + (h)) * FG_HTB)
#define FG_SB(b, h) ((4 + (b) * 2 + (h)) * FG_HTB)
#define FG_STAGE(bufoff, gbase, voff) do { _Pragma("unroll") for (int _i = 0; _i < 2; ++_i) \
    __builtin_amdgcn_global_load_lds((const unsigned*)((const char*)(gbase) + (voff)[_i]), (LAS3 unsigned*)(lds + (bufoff) + ldsw + _i * 8192), 16, 0, 0); } while (0)
#define FG_LDA(dst, b, h) do { _Pragma("unroll") for (int m = 0; m < 4; ++m) _Pragma("unroll") for (int k = 0; k < 2; ++k) dst[m][k] = *(const LAS3 bf16x8*)(lds + FG_SA(b, h) + aoff + m * 2048 + k * 1024); } while (0)
#define FG_LDB(dst, b, h) do { _Pragma("unroll") for (int n = 0; n < 2; ++n) _Pragma("unroll") for (int k = 0; k < 2; ++k) dst[n][k] = *(const LAS3 bf16x8*)(lds + FG_SB(b, h) + boff + n * 2048 + k * 1024); } while (0)
#define FG_MMA(ai, bj, At, Bt) do { __builtin_amdgcn_s_setprio(1); _Pragma("unroll") for (int m = 0; m < 4; ++m) _Pragma("unroll") for (int n = 0; n < 2; ++n) _Pragma("unroll") for (int k = 0; k < 2; ++k) \
    acc[ai][bj][m][n] = __builtin_amdgcn_mfma_f32_16x16x32_bf16(Bt[n][k], At[m][k], acc[ai][bj][m][n], 0, 0, 0); __builtin_amdgcn_s_setprio(0); } while (0)
#define FG_WAIT_V(n) asm volatile("s_waitcnt vmcnt(" #n ")" ::: "memory")
#define FG_WAIT_L(n) asm volatile("s_waitcnt lgkmcnt(" #n ")" ::: "memory")
#define FG_BAR __builtin_amdgcn_s_barrier()
#define FG_SCHED __builtin_amdgcn_sched_barrier(0)
  FUnit cur, nxt; int ui = 0;
  if (!S.next(0, cur)) return;
  f32x4 acc[2][2][4][2];
#pragma unroll
  for (int a = 0; a < 2; ++a)
#pragma unroll
    for (int b = 0; b < 2; ++b)
#pragma unroll
      for (int m = 0; m < 4; ++m)
#pragma unroll
        for (int n = 0; n < 2; ++n) acc[a][b][m][n] = zero4();
  bf16x8 At[4][2], B0[2][2], B1[2][2];
  constexpr bool GA = Sched::GATHER;
  const unsigned lda = S.lda();
  const size_t hstepA = (size_t)128 * lda * 2;
  unsigned voffA[2];
  voffA[0] = (unsigned)(R0 * lda + C0) * 2u; voffA[1] = (unsigned)(R1 * lda + C1) * 2u;
  unsigned vaC[2][2], vaN[2][2];
  const char* cA = S.a_ptr(cur);
  if (GA) S.a_offs(cur, tid, vaC);
  const char* cB = S.b_ptr(cur);
#define FG_STAGE_A(bufoff, UPTR, KOFF, H, VG) do { if (GA) FG_STAGE(bufoff, (UPTR) + (KOFF), (VG)[H]); else FG_STAGE(bufoff, (UPTR) + (KOFF) + (H) * hstepA, voffA); } while (0)
  FG_STAGE(FG_SB(0, 0), cB, voffB); FG_STAGE_A(FG_SA(0, 0), cA, 0, 0, vaC); FG_STAGE(FG_SB(0, 1), cB + hstepB, voffB); FG_STAGE_A(FG_SA(0, 1), cA, 0, 1, vaC);
  if (wr == 1) FG_BAR;
  FG_WAIT_V(4); FG_BAR;
  FG_STAGE(FG_SB(1, 0), cB + kstep, voffB); FG_STAGE_A(FG_SA(1, 0), cA, kstep, 0, vaC); FG_STAGE(FG_SB(1, 1), cB + hstepB + kstep, voffB);
  FG_WAIT_V(6); FG_BAR;
  for (;;) {
    const bool has_next = S.next(ui + 1, nxt);
    if (!has_next) nxt = cur;
    if (GA) S.a_offs(nxt, tid, vaN);
    const char* nA = has_next ? S.a_ptr(nxt) : cA;
    const char* nB = has_next ? S.b_ptr(nxt) : cB;
#pragma unroll 1
    for (int t = 0; t < nt; t += 2) {
      const bool last = (t == nt - 2);
      const size_t k1 = (size_t)(t + 1) * kstep;
      const char* a2 = last ? nA : cA + (size_t)(t + 2) * kstep;
      const char* b2 = last ? nB : cB + (size_t)(t + 2) * kstep;
      const char* b3 = b2 + kstep;
      FG_LDB(B0, 0, 0); FG_SCHED; FG_LDA(At, 0, 0); FG_STAGE_A(FG_SA(1, 1), cA, k1, 1, vaC);
      FG_WAIT_L(8); FG_BAR; FG_WAIT_L(0); FG_MMA(0, 0, At, B0); FG_BAR; FG_SCHED;
      if (GA && last) {
#pragma unroll
        for (int h = 0; h < 2; ++h)
#pragma unroll
          for (int i = 0; i < 2; ++i) vaC[h][i] = vaN[h][i];
      }
      FG_LDB(B1, 0, 1); FG_STAGE(FG_SB(0, 0), b2, voffB);
      FG_BAR; FG_WAIT_L(0); FG_MMA(0, 1, At, B1); FG_BAR;
      FG_LDA(At, 0, 1); FG_STAGE_A(FG_SA(0, 0), a2, 0, 0, vaC);
      FG_BAR; FG_WAIT_L(0); FG_MMA(1, 0, At, B0); FG_BAR; FG_SCHED;
      FG_STAGE(FG_SB(0, 1), b2 + hstepB, voffB);
      FG_WAIT_V(6); FG_BAR; FG_MMA(1, 1, At, B1); FG_BAR;
      FG_LDB(B0, 1, 0); FG_SCHED; FG_LDA(At, 1, 0); FG_STAGE_A(FG_SA(0, 1), a2, 0, 1, vaC);
      FG_WAIT_L(8); FG_BAR; FG_WAIT_L(0); FG_MMA(0, 0, At, B0); FG_BAR; FG_SCHED;
      FG_LDB(B1, 1, 1); FG_STAGE(FG_SB(1, 0), b3, voffB);
      FG_BAR; FG_WAIT_L(0); FG_MMA(0, 1, At, B1); FG_BAR;
      FG_LDA(At, 1, 1); FG_STAGE_A(FG_SA(1, 0), a2, kstep, 0, vaC);
      FG_BAR; FG_WAIT_L(0); FG_MMA(1, 0, At, B0); FG_BAR; FG_SCHED;
      FG_STAGE(FG_SB(1, 1), b3 + hstepB, voffB);
      FG_WAIT_V(6); FG_BAR; FG_MMA(1, 1, At, B1); FG_BAR;
    }
    {
      int fr2 = fr, fq2 = fq, ln2 = lane; asm volatile("" : "+v"(fr2), "+v"(fq2), "+v"(ln2));
      E(acc, cur, wr, wc, fr2, fq2, ln2);
    }
    if (!has_next) break;
#pragma unroll
    for (int a = 0; a < 2; ++a)
#pragma unroll
      for (int b = 0; b < 2; ++b)
#pragma unroll
        for (int m = 0; m < 4; ++m)
#pragma unroll
          for (int n = 0; n < 2; ++n) acc[a][b][m][n] = zero4();
    cur = nxt; cA = nA; cB = nB; ++ui;
  }
  FG_WAIT_V(0);
  if (wr == 0) FG_BAR;
  FG_BAR;
}

struct DenseOrder {
  const char* A; const char* Bt; int lda_, ldb_, nM, nN, nwg, G, c, a_col_bytes_per_pn;
  __device__ __forceinline__ void init(const void* A_, int ldaa, const void* Bt_, int ldbb, int M, int N, int G_, int c_, int acol) {
    A = (const char*)A_; Bt = (const char*)Bt_; lda_ = ldaa; ldb_ = ldbb; nM = M / 256; nN = N / 256; nwg = nM * nN; G = G_; c = c_; a_col_bytes_per_pn = acol; }
  __device__ __forceinline__ bool next(int i, FUnit& u) const {
    const long L = (long)i * G + c; if (L >= nwg) return false;
    int wgid = (int)L; { const int q = nwg / 8, r = nwg % 8, xcd = wgid % 8, off = wgid / 8; wgid = (xcd < r ? xcd * (q + 1) : r * (q + 1) + (xcd - r) * q) + off; }
    const int nig = 8 * nN, gid = wgid / nig, fm = gid * 8, gsz = (nM - fm) < 8 ? (nM - fm) : 8;
    u.pm = fm + ((wgid % nig) % gsz); u.pn = (wgid % nig) / gsz; u.e = 0; u.pos0 = 0; u.nvalid = 256; return true;
  }
  static constexpr bool GATHER = false;
  __device__ __forceinline__ unsigned lda() const { return (unsigned)lda_; }
  __device__ __forceinline__ unsigned ldb() const { return (unsigned)ldb_; }
  __device__ __forceinline__ const char* a_ptr(const FUnit& u) const { return A + (size_t)u.pm * 256 * lda_ * 2 + (size_t)u.pn * a_col_bytes_per_pn; }
  __device__ __forceinline__ void a_offs(const FUnit&, int, unsigned (&)[2][2]) const {}
  __device__ __forceinline__ const char* b_ptr(const FUnit& u) const { return Bt + (size_t)u.pn * 256 * ldb_ * 2; }
};

struct EpiProj {
  char* ws;
  __device__ __forceinline__ void operator()(const f32x4 (&acc)[2][2][4][2], const FUnit& u, int wr, int wc, int fr, int fq, int lane) const {
    const float* rs0 = (const float*)(ws + OFF_RS0);
    bf16_t* proj = (bf16_t*)(ws + OFF_R2);
#pragma unroll
    for (int ai = 0; ai < 2; ++ai)
#pragma unroll
      for (int m = 0; m < 4; ++m) {
        const int row = u.pm * 256 + ai * 128 + wr * 64 + m * 16 + fr;
        const float sc = rs0[row];
#pragma unroll
        for (int bj = 0; bj < 2; ++bj) {
          const int col0 = u.pn * 256 + bj * 128 + wc * 32 + fq * 8;
          const f32x4 v0 = acc[ai][bj][m][0] * sc, v1 = acc[ai][bj][m][1] * sc;
          u32x4 w4; w4.x = cvt_pk_bf16(v0[0], v0[1]); w4.y = cvt_pk_bf16(v0[2], v0[3]); w4.z = cvt_pk_bf16(v1[0], v1[1]); w4.w = cvt_pk_bf16(v1[2], v1[3]);
          *(u32x4*)(proj + (long)row * PROJ_LD + col0) = w4;
          if (u.pn == 7 && bj == 1 && wc == 1 && fq == 0) {
            float* d = (float*)(ws + OFF_DTRAW) + (long)row * 8;
            *(f32x4*)d = v0; *(f32x4*)(d + 4) = v1;
          }
          if (u.pn == 0 || (u.pn == 1 && bj == 0)) {
            float ss = v0[0] * v0[0] + v0[1] * v0[1] + v0[2] * v0[2] + v0[3] * v0[3] + v1[0] * v1[0] + v1[1] * v1[1] + v1[2] * v1[2] + v1[3] * v1[3];
            ss += sxor<16>(ss); ss += lane_get(ss, lane ^ 32);
            if (fq == 0) {
              if (u.pn == 0) ((float*)(ws + OFF_SSQ_Q))[row * 8 + bj * 4 + wc] = ss;
              else ((float*)(ws + OFF_SSQ_KV))[row * 4 + wc] = ss;
            }
          }
        }
      }
  }
};

template <int MODE>
struct EpiRes {
  char* ws; const float* xin; float* ssq; const float* pb; const float* psc; float f;
  __device__ __forceinline__ void operator()(const f32x4 (&acc)[2][2][4][2], const FUnit& u, int wr, int wc, int fr, int fq, int lane) const {
    bf16_t* xcb = (bf16_t*)(ws + OFF_XCB);
#pragma unroll
    for (int bj = 0; bj < 2; ++bj) {
      const int col0 = u.pn * 256 + bj * 128 + wc * 32 + fq * 8;
      f32x4 b0 = zero4(), b1 = b0, s0 = (f32x4){1.f, 1.f, 1.f, 1.f}, s1 = s0;
      if (MODE == 2) { b0 = *(const f32x4*)(pb + col0); b1 = *(const f32x4*)(pb + col0 + 4); s0 = *(const f32x4*)(psc + col0); s1 = *(const f32x4*)(psc + col0 + 4); }
#pragma unroll
      for (int ai = 0; ai < 2; ++ai)
#pragma unroll
        for (int m = 0; m < 4; ++m) {
          const int row = u.pm * 256 + ai * 128 + wr * 64 + m * 16 + fr;
          f32x4 a0 = acc[ai][bj][m][0], a1 = acc[ai][bj][m][1];
          if (MODE == 2) { a0 = (a0 + b0) * s0; a1 = (a1 + b1) * s1; }
          f32x4 v0, v1;
          if (MODE == 0) {
            const float* bp = xin + (long)row * 1024 + col0;
            v0 = *(const f32x4*)bp + a0; v1 = *(const f32x4*)(bp + 4) + a1;
          } else {
            const u32x4 bu = *(const u32x4*)(xcb + (long)row * 1024 + col0);
            v0 = (f32x4){bflo(bu.x), bfhi(bu.x), bflo(bu.y), bfhi(bu.y)} + a0 * f;
            v1 = (f32x4){bflo(bu.z), bfhi(bu.z), bflo(bu.w), bfhi(bu.w)} + a1 * f;
          }
          u32x4 w4; w4.x = cvt_pk_bf16(v0[0], v0[1]); w4.y = cvt_pk_bf16(v0[2], v0[3]); w4.z = cvt_pk_bf16(v1[0], v1[1]); w4.w = cvt_pk_bf16(v1[2], v1[3]);
          *(u32x4*)(xcb + (long)row * 1024 + col0) = w4;
          const float r0 = bflo(w4.x), r1 = bfhi(w4.x), r2 = bflo(w4.y), r3 = bfhi(w4.y), r4 = bflo(w4.z), r5 = bfhi(w4.z), r6 = bflo(w4.w), r7 = bfhi(w4.w);
          float ss = r0 * r0 + r1 * r1 + r2 * r2 + r3 * r3 + r4 * r4 + r5 * r5 + r6 * r6 + r7 * r7;
          ss += sxor<16>(ss); ss += lane_get(ss, lane ^ 32);
          if (fq == 0) ssq[row * 32 + (u.pn * 2 + bj) * 4 + wc] = ss;
        }
    }
  }
};

struct TJob { const float* src; int K, N; bf16_t* dst; int dst_ld, grp, grp_pad, goff; const float* gain; };
__device__ __forceinline__ void tstrip_load(const TJob& j, int tk, int tn, int t, float4 (&v)[8]) {
  const int k0 = tk * 64, n0 = tn * 256, c4 = (t & 63) * 4;
#pragma unroll
  for (int i = 0; i < 8; ++i) {
    const int r = (t >> 6) + 8 * i;
    float4 x = make_float4(0.f, 0.f, 0.f, 0.f);
    if (n0 + c4 < j.N) x = *(const float4*)(j.src + (long)(k0 + r) * j.N + n0 + c4);
    const float g = j.gain ? j.gain[k0 + r] : 1.f;
    v[i] = make_float4(x.x * g, x.y * g, x.z * g, x.w * g);
  }
}
__device__ __forceinline__ void tstrip_to_lds(int t, const float4 (&v)[8], float* tl) {
  const int c4 = (t & 63) * 4;
#pragma unroll
  for (int i = 0; i < 8; ++i) {
    const int r = (t >> 6) + 8 * i;
    tl[r * 257 + c4 + 0] = v[i].x; tl[r * 257 + c4 + 1] = v[i].y; tl[r * 257 + c4 + 2] = v[i].z; tl[r * 257 + c4 + 3] = v[i].w;
  }
}
__device__ __forceinline__ void tstrip_store(const TJob& j, int tk, int tn, int t, const float* tl) {
  const int k0 = tk * 64, n0 = tn * 256;
  const int n = n0 + (t >> 1);
  if (n < j.N) {
    const int drow = (n / j.grp) * j.grp_pad + j.goff + (n % j.grp);
    const int kk = (t & 1) * 32;
    bf16_t* d = j.dst + (long)drow * j.dst_ld + k0 + kk;
#pragma unroll
    for (int q = 0; q < 4; ++q) {
      unsigned u[4];
#pragma unroll
      for (int jj = 0; jj < 4; ++jj) u[jj] = pack2(tl[(kk + q * 8 + 2 * jj) * 257 + (t >> 1)], tl[(kk + q * 8 + 2 * jj + 1) * 257 + (t >> 1)]);
      *(uint4*)(d + q * 8) = make_uint4(u[0], u[1], u[2], u[3]);
    }
  }
}

constexpr int N_TJOBS = 5 + 4 + 6 + 192;
__device__ __forceinline__ TJob get_tjob(int idx, const Ctx& c, char* ws) {
  constexpr int BIG = 1 << 30;
  TJob j;
  if (idx == 0) j = {INP(I_W_IN), 1024, 1960, (bf16_t*)(ws + OFF_WIN_T), 1024, BIG, 0, 0, INP(I_LN_MIX)};
  else if (idx == 1) j = {INP(I_W_UQ), 256, 768, (bf16_t*)(ws + OFF_WUQ_T), 256, 96, 128, 0, INP(I_QLAT_NORM)};
  else if (idx == 2) j = {INP(I_W_UKV), 128, 1024, (bf16_t*)(ws + OFF_WUKV_T), 256, BIG, 0, 0, INP(I_KVLAT_NORM)};
  else if (idx == 3) j = {INP(I_W_OUT), 512, 1024, (bf16_t*)(ws + OFF_WOUT_T), 1024, BIG, 0, 0, nullptr};
  else if (idx == 4) j = {INP(I_W_OUT) + 512 * 1024, 512, 1024, (bf16_t*)(ws + OFF_WOUT_T) + 512, 1024, BIG, 0, 0, INP(I_SSD_NORM)};
  else if (idx < 9) { const int g = idx - 5; j = {INP(I_POOL_W) + g * 65536, 256, 256, (bf16_t*)(ws + OFF_POOL_T) + g * 65536, 256, BIG, 0, 0, INP(I_LN_MIX) + 1024 + g * 256}; }
  else if (idx < 15) {
    const int l = (idx - 9) / 3, k = (idx - 9) % 3;
    if (k == 0) j = {INP(I_XQ_W) + l * 1024 * 256, 1024, 256, (bf16_t*)(ws + OFF_XQ_T) + l * 256 * 1024, 1024, BIG, 0, 0, INP(I_LN_XQ) + l * 1024};
    else if (k == 1) j = {INP(I_XKV_W) + l * 1024 * 512, 1024, 512, (bf16_t*)(ws + OFF_XKV_T) + l * 512 * 1024, 1024, BIG, 0, 0, INP(I_LN_MEM) + l * 1024};
    else j = {INP(I_XO_W) + l * 256 * 1024, 256, 1024, (bf16_t*)(ws + OFF_XO_T) + l * 1024 * 256, 256, BIG, 0, 0, nullptr};
  } else {
    const int le = (idx - 15) / 3, k = (idx - 15) % 3, l = le >> 5;
    const long wo = (long)le * 1024 * 256;
    if (k == 0) j = {INP(I_EXP_G) + wo, 1024, 256, (bf16_t*)(ws + OFF_WGU_T) + (long)le * 512 * 1024, 1024, 4, 8, 0, INP(I_LN_FFN) + l * 1024};
    else if (k == 1) j = {INP(I_EXP_U) + wo, 1024, 256, (bf16_t*)(ws + OFF_WGU_T) + (long)le * 512 * 1024, 1024, 4, 8, 4, INP(I_LN_FFN) + l * 1024};
    else j = {INP(I_EXP_D) + wo, 256, 1024, (bf16_t*)(ws + OFF_WD_T) + (long)le * 1024 * 256, 256, BIG, 0, 0, nullptr};
  }
  return j;
}

__device__ __forceinline__ void phase_prep(const Ctx& c) {
  char* ws = c.ws; char* smem = c.smem; const int bid = c.bid, nblk = c.nblk;
  float* tl = (float*)smem;
  {
    int ji = 0, base = 0, f = bid;
    TJob j = get_tjob(0, c, ws);
    int tilesN = (j.N + 255) / 256, ntiles = tilesN * (j.K / 64);
    float4 v[8];
    bool have = false; TJob jc = j; int tkc = 0, tnc = 0;
#define T_SEEK() { while (ji < N_TJOBS && f >= base + ntiles) { base += ntiles; ++ji; if (ji < N_TJOBS) { j = get_tjob(ji, c, ws); tilesN = (j.N + 255) / 256; ntiles = tilesN * (j.K / 64); } } }
    T_SEEK()
    if (ji < N_TJOBS) { jc = j; tkc = (f - base) / tilesN; tnc = (f - base) % tilesN; tstrip_load(jc, tkc, tnc, c.tid, v); have = true; }
    while (have) {
      tstrip_to_lds(c.tid, v, tl);
      __syncthreads();
      const TJob jd = jc; const int tkd = tkc, tnd = tnc;
      f += nblk;
      T_SEEK()
      have = ji < N_TJOBS;
      if (have) { jc = j; tkc = (f - base) / tilesN; tnc = (f - base) % tilesN; tstrip_load(jc, tkc, tnc, c.tid, v); }
      tstrip_store(jd, tkd, tnd, c.tid, tl);
      __syncthreads();
    }
#undef T_SEEK
  }
  {
    const int gt = bid * NTHR + c.tid, gn = nblk * NTHR;
    uint4 z = make_uint4(0, 0, 0, 0);
    bf16_t* w1 = (bf16_t*)(ws + OFF_WIN_T) + 1960l * 1024;
    for (int i = gt; i < 88 * 1024 / 8; i += gn) *(uint4*)(w1 + i * 8) = z;
    bf16_t* w2 = (bf16_t*)(ws + OFF_WUQ_T);
    for (int i = gt; i < 8 * 32 * 256 / 8; i += gn) {
      const int e = i * 8, h = e / (32 * 256), rem = e % (32 * 256);
      *(uint4*)(w2 + (long)(h * 128 + 96) * 256 + rem) = z;
    }
    bf16_t* w3 = (bf16_t*)(ws + OFF_WUKV_T);
    for (int i = gt; i < 1024 * 128 / 8; i += gn) *(uint4*)(w3 + (long)(i >> 4) * 256 + 128 + (i & 15) * 8) = z;
    if (gt < 128) ((int*)(ws + OFF_CTL))[gt] = 0;
    bf16_t* wr = (bf16_t*)(ws + OFF_WR);
    for (int i = gt; i < 2 * 48 * 1024; i += gn) {
      const int l = i / (48 * 1024), o = (i / 1024) % 48, k = i % 1024;
      float w = 0.f;
      if (o < 4) w = INP(I_RG_W)[(l * 1024 + k) * 4 + o];
      else if (o < 36) w = INP(I_RE_W)[(l * 1024 + k) * 32 + (o - 4)];
      const bf16_t hi = f2bf(w);
      wr[((l * 2 + 0) * 48 + o) * 1024 + k] = hi;
      wr[((l * 2 + 1) * 48 + o) * 1024 + k] = f2bf(w - bf2f(hi));
    }
  }
  {
    const int lane = c.tid & 63;
    const int gw = bid * NWAV + (c.tid >> 6), nw = nblk * NWAV;
    for (int row0 = gw * 2; row0 < NT + 4096; row0 += nw * 2) {
      float4 v[2][4];
#pragma unroll
      for (int q = 0; q < 2; ++q) {
        const int row = row0 + q; const bool ism = row >= NT; const int r = ism ? row - NT : row;
        const float* src = (ism ? INP(I_MEM) : INP(I_X)) + (long)r * 1024;
#pragma unroll
        for (int i = 0; i < 4; ++i) v[q][i] = *(const float4*)(src + i * 256 + lane * 4);
      }
#pragma unroll
      for (int q = 0; q < 2; ++q) {
        const int row = row0 + q; const bool ism = row >= NT; const int r = ism ? row - NT : row;
        bf16_t* dst = (bf16_t*)(ws + (ism ? OFF_MEMB : OFF_R1)) + (long)r * 1024;
        float ss = 0.f;
#pragma unroll
        for (int i = 0; i < 4; ++i) {
          const float4 x = v[q][i];
          ss += x.x * x.x + x.y * x.y + x.z * x.z + x.w * x.w;
          *(uint2*)(dst + i * 256 + lane * 4) = make_uint2(pack2(x.x, x.y), pack2(x.z, x.w));
        }
        ss = wave_sum(ss, lane);
        if (lane == 0) ((float*)(ws + (ism ? OFF_RSM : OFF_RS0)))[r] = rsqrtf(ss * (1.f / 1024.f) + EPS);
      }
    }
  }
}

__device__ __forceinline__ float cs_ssq(const float* crow, int n) {
  float ss = 0.f;
  for (int j = 0; j < n; j += 4) { const float4 c = *(const float4*)(crow + j); ss += c.x * c.x + c.y * c.y + c.z * c.z + c.w * c.w; }
  return ss;
}
__device__ __forceinline__ void cs_store_scaled(bf16_t* dst, const float* crow, int n, float sc, const float* g) {
  for (int j = 0; j < n; j += 8) {
    float4 a = *(const float4*)(crow + j), b = *(const float4*)(crow + j + 4);
    if (g) {
      const float4 ga = *(const float4*)(g + j), gb = *(const float4*)(g + j + 4);
      a.x *= ga.x; a.y *= ga.y; a.z *= ga.z; a.w *= ga.w; b.x *= gb.x; b.y *= gb.y; b.z *= gb.z; b.w *= gb.w;
    }
    *(uint4*)(dst + j) = make_uint4(pack2(a.x * sc, a.y * sc), pack2(a.z * sc, a.w * sc), pack2(b.x * sc, b.y * sc), pack2(b.z * sc, b.w * sc));
  }
}
__device__ __forceinline__ float row_rs32(const float* ssq, int row) {
  const float4* q = (const float4*)(ssq + (long)row * 32);
  float s = 0.f;
#pragma unroll
  for (int i = 0; i < 8; ++i) { const float4 v = q[i]; s += (v.x + v.y) + (v.z + v.w); }
  return rsqrtf(s * (1.f / 1024.f) + EPS);
}
__device__ __forceinline__ void rope_cs(float pos, int i, float& c, float& s) {
  const float ang = pos * exp2f(-(float)i * 0.8304820237218406f);
  float u = ang * 0.15915494309189535f;
  u -= rintf(u);
  c = __builtin_amdgcn_cosf(u);
  s = __builtin_amdgcn_sinf(u);
}


constexpr int XS_BASE = 128 * 1024, XS_PART = XS_BASE, XS_ROW = XS_BASE + 2 * 256 * 8 * 4;
__device__ __forceinline__ void xs_barrier() { asm volatile("s_waitcnt lgkmcnt(0)" ::: "memory"); __builtin_amdgcn_s_barrier(); asm volatile("" ::: "memory"); }
__device__ __forceinline__ void xs_put_parts(const f32x4 (&acc)[2][2][4][2], float* part, int wr, int wc, int fr, int fq, int lane) {
#pragma unroll
  for (int ai = 0; ai < 2; ++ai)
#pragma unroll
    for (int m = 0; m < 4; ++m)
#pragma unroll
      for (int bj = 0; bj < 2; ++bj) {
        const f32x4 a0 = acc[ai][bj][m][0], a1 = acc[ai][bj][m][1];
        float ss = a0[0] * a0[0] + a0[1] * a0[1] + a0[2] * a0[2] + a0[3] * a0[3] + a1[0] * a1[0] + a1[1] * a1[1] + a1[2] * a1[2] + a1[3] * a1[3];
        ss += sxor<16>(ss); ss += lane_get(ss, lane ^ 32);
        if (fq == 0) part[(ai * 128 + wr * 64 + m * 16 + fr) * 8 + bj * 4 + wc] = ss;
      }
}

struct EpiXq {
  char* ws; char* smem; const float* g; int tid; mutable int par;
  __device__ __forceinline__ void operator()(const f32x4 (&acc)[2][2][4][2], const FUnit& u, int wr, int wc, int fr, int fq, int lane) const {
    float* part = (float*)(smem + XS_PART) + par * 2048; float* rowsc = (float*)(smem + XS_ROW) + par * 512;
    if (tid < 256) rowsc[tid] = row_rs32((const float*)(ws + OFF_SSQA), u.pm * 256 + tid);
    xs_put_parts(acc, part, wr, wc, fr, fq, lane);
    xs_barrier();
    bf16_t* xq = (bf16_t*)(ws + OFF_XQ);
    const f32x4 g0 = *(const f32x4*)(g + (wc & 1) * 32 + fq * 8), g1 = *(const f32x4*)(g + (wc & 1) * 32 + fq * 8 + 4);
#pragma unroll
    for (int ai = 0; ai < 2; ++ai)
#pragma unroll
      for (int m = 0; m < 4; ++m) {
        const int rl = ai * 128 + wr * 64 + m * 16 + fr;
        const float rs = rowsc[rl];
#pragma unroll
        for (int bj = 0; bj < 2; ++bj) {
          const float ssh = (part[rl * 8 + bj * 4 + (wc & 2)] + part[rl * 8 + bj * 4 + (wc | 1)]) * rs * rs;
          const float sc = rsqrtf(ssh * (1.f / 64.f) + EPS) * rs * (0.125f * LOG2E);
          const f32x4 v0 = acc[ai][bj][m][0] * g0 * sc, v1 = acc[ai][bj][m][1] * g1 * sc;
          u32x4 w4; w4.x = cvt_pk_bf16(v0[0], v0[1]); w4.y = cvt_pk_bf16(v0[2], v0[3]); w4.z = cvt_pk_bf16(v1[0], v1[1]); w4.w = cvt_pk_bf16(v1[2], v1[3]);
          *(u32x4*)(xq + (long)(u.pm * 256 + rl) * 256 + bj * 128 + wc * 32 + fq * 8) = w4;
        }
      }
    par ^= 1;
  }
};

struct EpiQ {
  char* ws; char* smem; const float* g; const int* positions; int tid; mutable int par;
  __device__ __forceinline__ void operator()(const f32x4 (&acc)[2][2][4][2], const FUnit& u, int wr, int wc, int fr, int fq, int lane) const {
    float* part = (float*)(smem + XS_PART) + par * 2048; float* rowsc = (float*)(smem + XS_ROW) + par * 512;
    if (tid < 256) {
      const float* sq = (const float*)(ws + OFF_SSQ_Q) + (long)(u.pm * 256 + tid) * 8;
      rowsc[tid] = rsqrtf(((sq[0] + sq[1]) + (sq[2] + sq[3]) + (sq[4] + sq[5]) + (sq[6] + sq[7])) * (1.f / 256.f) + EPS);
    }
    xs_put_parts(acc, part, wr, wc, fr, fq, lane);
    xs_barrier();
    if (wc < 3) {
      bf16_t* qo = (bf16_t*)(ws + OFF_Q);
      const int c0 = wc * 32 + fq * 8;
      const f32x4 g0 = *(const f32x4*)(g + c0), g1 = *(const f32x4*)(g + c0 + 4);
      const float qs = 0.10206207261596577f * LOG2E;
#pragma unroll
      for (int ai = 0; ai < 2; ++ai)
#pragma unroll
        for (int m = 0; m < 4; ++m) {
          const int rl = ai * 128 + wr * 64 + m * 16 + fr;
          const int row = u.pm * 256 + rl, b = row >> 12, sq_ = row & 4095;
          const float rq = rowsc[rl];
          float cs[8], sn[8];
          if (wc == 2) {
            const float pos = (float)positions[row];
#pragma unroll
            for (int j = 0; j < 8; ++j) rope_cs(pos, (fq & 1) * 8 + j, cs[j], sn[j]);
          }
#pragma unroll
          for (int bj = 0; bj < 2; ++bj) {
            const float ssh = (part[rl * 8 + bj * 4] + part[rl * 8 + bj * 4 + 1] + part[rl * 8 + bj * 4 + 2]) * rq * rq;
            const float sc = rsqrtf(ssh * (1.f / 96.f) + EPS) * rq * qs;
            f32x4 v0 = acc[ai][bj][m][0] * g0 * sc, v1 = acc[ai][bj][m][1] * g1 * sc;
            if (wc == 2) {
              float o[8];
#pragma unroll
              for (int j = 0; j < 8; ++j) {
                const float own = j < 4 ? v0[j] : v1[j - 4];
                const float oth = lane_get(own, lane ^ 32);
                o[j] = (fq < 2) ? (own * cs[j] - oth * sn[j]) : (own * cs[j] + oth * sn[j]);
              }
              v0 = (f32x4){o[0], o[1], o[2], o[3]}; v1 = (f32x4){o[4], o[5], o[6], o[7]};
            }
            u32x4 w4; w4.x = cvt_pk_bf16(v0[0], v0[1]); w4.y = cvt_pk_bf16(v0[2], v0[3]); w4.z = cvt_pk_bf16(v1[0], v1[1]); w4.w = cvt_pk_bf16(v1[2], v1[3]);
            *(u32x4*)(qo + ((long)(b * 8 + u.pn * 2 + bj) * 4096 + sq_) * 96 + c0) = w4;
          }
        }
    }
    par ^= 1;
  }
};

struct EpiKV {
  char* ws; char* smem; const float* g; const int* positions; int tid; mutable int par;
  __device__ __forceinline__ void operator()(const f32x4 (&acc)[2][2][4][2], const FUnit& u, int wr, int wc, int fr, int fq, int lane) const {
    float* part = (float*)(smem + XS_PART) + par * 2048; float* rowsc = (float*)(smem + XS_ROW) + par * 512;
    const bf16_t* proj = (const bf16_t*)(ws + OFF_R2);
    if (tid < 256) {
      const int row = u.pm * 256 + tid;
      const float* sk = (const float*)(ws + OFF_SSQ_KV) + (long)row * 4;
      rowsc[tid] = rsqrtf(((sk[0] + sk[1]) + (sk[2] + sk[3])) * (1.f / 128.f) + EPS);
      const bf16_t* kp = proj + (long)row * PROJ_LD + C_KROPE;
      float ss = 0.f;
#pragma unroll
      for (int j = 0; j < 32; j += 8) {
        const uint4 q4 = *(const uint4*)(kp + j);
        ss += bflo(q4.x) * bflo(q4.x) + bfhi(q4.x) * bfhi(q4.x) + bflo(q4.y) * bflo(q4.y) + bfhi(q4.y) * bfhi(q4.y)
            + bflo(q4.z) * bflo(q4.z) + bfhi(q4.z) * bfhi(q4.z) + bflo(q4.w) * bflo(q4.w) + bfhi(q4.w) * bfhi(q4.w);
      }
      rowsc[256 + tid] = ss;
    }
    xs_put_parts(acc, part, wr, wc, fr, fq, lane);
    xs_barrier();
    bf16_t* ko = (bf16_t*)(ws + OFF_K);
    bf16_t* vo = (bf16_t*)(ws + OFF_VT);
#pragma unroll
    for (int ai = 0; ai < 2; ++ai)
#pragma unroll
      for (int m = 0; m < 4; ++m) {
        const int rl = ai * 128 + wr * 64 + m * 16 + fr;
        const int row = u.pm * 256 + rl, b = row >> 12, sq_ = row & 4095;
        const float rkv = rowsc[rl], krs = rowsc[256 + rl];
        if (wc < 2) {
          const int c0 = wc * 32 + fq * 8;
          const f32x4 g0 = *(const f32x4*)(g + c0), g1 = *(const f32x4*)(g + c0 + 4);
#pragma unroll
          for (int bj = 0; bj < 2; ++bj) {
            const float ssh = (part[rl * 8 + bj * 4] + part[rl * 8 + bj * 4 + 1]) * rkv * rkv + krs;
            const float sc = rsqrtf(ssh * (1.f / 96.f) + EPS) * rkv;
            const f32x4 v0 = acc[ai][bj][m][0] * g0 * sc, v1 = acc[ai][bj][m][1] * g1 * sc;
            u32x4 w4; w4.x = cvt_pk_bf16(v0[0], v0[1]); w4.y = cvt_pk_bf16(v0[2], v0[3]); w4.z = cvt_pk_bf16(v1[0], v1[1]); w4.w = cvt_pk_bf16(v1[2], v1[3]);
            *(u32x4*)(ko + ((long)(b * 8 + u.pn * 2 + bj) * 4096 + sq_) * 96 + c0) = w4;
          }
        } else {
#pragma unroll
          for (int bj = 0; bj < 2; ++bj) {
            const f32x4 v0 = acc[ai][bj][m][0] * rkv, v1 = acc[ai][bj][m][1] * rkv;
            u32x4 w4; w4.x = cvt_pk_bf16(v0[0], v0[1]); w4.y = cvt_pk_bf16(v0[2], v0[3]); w4.z = cvt_pk_bf16(v1[0], v1[1]); w4.w = cvt_pk_bf16(v1[2], v1[3]);
            *(u32x4*)(vo + ((long)(b * 8 + u.pn * 2 + bj) * 4096 + sq_) * 64 + (wc - 2) * 32 + fq * 8) = w4;
          }
          const int hb = wc - 2;
          const float ssh = (part[rl * 8 + hb * 4] + part[rl * 8 + hb * 4 + 1]) * rkv * rkv + krs;
          const float r = rsqrtf(ssh * (1.f / 96.f) + EPS);
          const bf16_t* kp = proj + (long)row * PROJ_LD + C_KROPE;
          const int i0 = (fq & 1) * 8;
          const uint4 ua = *(const uint4*)(kp + i0), ub = *(const uint4*)(kp + 16 + i0);
          const float k1[8] = {bflo(ua.x), bfhi(ua.x), bflo(ua.y), bfhi(ua.y), bflo(ua.z), bfhi(ua.z), bflo(ua.w), bfhi(ua.w)};
          const float k2[8] = {bflo(ub.x), bfhi(ub.x), bflo(ub.y), bfhi(ub.y), bflo(ub.z), bfhi(ub.z), bflo(ub.w), bfhi(ub.w)};
          const float pos = (float)positions[row];
          float o[8];
#pragma unroll
          for (int j = 0; j < 8; ++j) {
            float cc, sn; rope_cs(pos, i0 + j, cc, sn);
            const float u1 = k1[j] * r * g[64 + i0 + j], u2 = k2[j] * r * g[80 + i0 + j];
            o[j] = (fq < 2) ? (u1 * cc - u2 * sn) : (u2 * cc + u1 * sn);
          }
          u32x4 w4; w4.x = cvt_pk_bf16(o[0], o[1]); w4.y = cvt_pk_bf16(o[2], o[3]); w4.z = cvt_pk_bf16(o[4], o[5]); w4.w = cvt_pk_bf16(o[6], o[7]);
          *(u32x4*)(ko + ((long)(b * 8 + u.pn * 2 + hb) * 4096 + sq_) * 96 + 64 + fq * 8) = w4;
        }
      }
    par ^= 1;
  }
};

__device__ __forceinline__ void phase_gemm_in(const Ctx& c) {
  char* ws = c.ws; char* smem = c.smem; const int bid = c.bid, nblk = c.nblk;
  {
    DenseOrder S; S.init(ws + OFF_R1, 1024, ws + OFF_WIN_T, 1024, NT, 2048, nblk, bid, 0);
    EpiProj E{ws};
    fast_gemm(( LAS3 unsigned char*)smem, S, E, 1024, c.tid);
  }
  __syncthreads();
  const int t = c.tid, er = t >> 1, eh = t & 1;
  const float* crow = (const float*)smem + er * CS_LD + eh * 64;
  for (int it = bid; it < 2 * 32 * 4; it += nblk) {
    const int l = it >> 7, mt = (it >> 2) & 31, nt = it & 3;
    gemm_dense((const bf16_t*)(ws + OFF_MEMB) + (long)mt * 128 * 1024, 1024,
               (const bf16_t*)(ws + OFF_XKV_T) + (long)l * 512 * 1024 + (long)nt * 128 * 1024, 1024, 1024, smem, c.tid);
    if (t < 256) {
      const int row = mt * 128 + er;
      const float sc = ((const float*)(ws + OFF_RSM))[row];
      if (nt < 2) {
        const int head = nt * 2 + eh;
        const float ss = cs_ssq(crow, 64) * sc * sc;
        const float r = rsqrtf(ss * (1.f / 64.f) + EPS) * sc;
        cs_store_scaled((bf16_t*)(ws + OFF_MEMK) + (long)l * 4096 * 256 + (long)row * 256 + head * 64, crow, 64, r, INP(I_XK_NORM) + l * 64);
      } else {
        const int head = (nt - 2) * 2 + eh;
        cs_store_scaled((bf16_t*)(ws + OFF_MEMVT) + (long)l * 4096 * 256 + (long)row * 256 + head * 64, crow, 64, sc, nullptr);
      }
    }
    __syncthreads();
  }
}

__device__ __forceinline__ void phase_up(const Ctx& c) {
  char* ws = c.ws; char* smem = c.smem; const int bid = c.bid, nblk = c.nblk; (void)smem; (void)bid; (void)nblk;
  const int t = c.tid;
  const bf16_t* proj = (const bf16_t*)(ws + OFF_R2);
  const int* positions = (const int*)c.p.in[opq(I_POS)];
  {
    DenseOrder S; S.init(ws + OFF_R2 + C_QLAT * 2, PROJ_LD, ws + OFF_WUQ_T, 256, NT, 1024, nblk, bid, 0);
    EpiQ E{ws, smem, INP(I_Q_NORM), positions, c.tid, 0};
    fast_gemm((LAS3 unsigned char*)smem, S, E, 256, c.tid);
  }
  {
    DenseOrder S; S.init(ws + OFF_R2 + C_KVLAT * 2, PROJ_LD, ws + OFF_WUKV_T, 256, NT, 1024, nblk, bid, 0);
    EpiKV E{ws, smem, INP(I_K_NORM), positions, c.tid, 0};
    fast_gemm((LAS3 unsigned char*)smem, S, E, 256, c.tid);
  }
  {
    const long gt = (long)bid * NTHR + t, gn = (long)nblk * NTHR;
    const float* cw = INP(I_CONV_W);
    const float* cb = INP(I_CONV_B);
    bf16_t* xc = (bf16_t*)(ws + OFF_R4);
    for (long i = gt; i < (long)NT * 128; i += gn) {
      const int tok = (int)(i >> 7), ch = (int)(i & 127) * 8;
      const int s = tok & 4095;
      float a[8];
#pragma unroll
      for (int j = 0; j < 8; ++j) a[j] = cb[ch + j];
#pragma unroll
      for (int k = 0; k < 4; ++k) {
        const int ds = k - 3;
        if (s + ds >= 0) {
          uint4 u = *(const uint4*)(proj + (long)(tok + ds) * PROJ_LD + C_XBC + ch);
          const float* w = cw + k * 1024 + ch;
          a[0] += w[0] * bflo(u.x); a[1] += w[1] * bfhi(u.x); a[2] += w[2] * bflo(u.y); a[3] += w[3] * bfhi(u.y);
          a[4] += w[4] * bflo(u.z); a[5] += w[5] * bfhi(u.z); a[6] += w[6] * bflo(u.w); a[7] += w[7] * bfhi(u.w);
        }
      }
#pragma unroll
      for (int j = 0; j < 8; ++j) a[j] = silu_f(a[j]);
      *(uint4*)(xc + (long)tok * 1024 + ch) = make_uint4(pack2(a[0], a[1]), pack2(a[2], a[3]), pack2(a[4], a[5]), pack2(a[6], a[7]));
    }
    const float* dtr = (const float*)(ws + OFF_DTRAW);
    float* dt = (float*)(ws + OFF_DT);
    for (long i = gt; i < (long)NT * 8; i += gn) {
      const float x = dtr[i] + INP(I_DT_BIAS)[i & 7];
      dt[i] = x > 20.f ? x : log1pf(__expf(x));
    }
  }
}

typedef float f32x16 __attribute__((ext_vector_type(16)));
__device__ __forceinline__ f32x16 mfma32(bf16x8 a, bf16x8 b, f32x16 c) { return __builtin_amdgcn_mfma_f32_32x32x16_bf16(a, b, c, 0, 0, 0); }
template <int DQK, bool CAUSAL>
__device__ __forceinline__ void attn_block(const bf16_t* Q, long ldq, const bf16_t* K, long ldk, const bf16_t* V, long ldv, int ntiles, int q0,
                           bf16_t* O, long ldo, char* smem, int tid) {
  constexpr int KLD = DQK + 8, VLD = 160, NK16 = DQK / 16, KCH = DQK / 8;
  constexpr int KBUF = 64 * KLD + 64 * VLD;
  constexpr int NKC = (64 * KCH + NTHR - 1) / NTHR;
  const int t = tid, lane = t & 63, w = t >> 6, l31 = lane & 31, hh = lane >> 5, l15 = lane & 15;
  bf16_t* KV = (bf16_t*)smem;
  bf16x8 qf[NK16];
#pragma unroll
  for (int ks = 0; ks < NK16; ++ks) qf[ks] = *(const bf16x8*)(Q + (long)(w * 32 + l31) * ldq + ks * 16 + hh * 8);
  f32x16 oacc[2];
#pragma unroll
  for (int dt = 0; dt < 2; ++dt)
#pragma unroll
    for (int i = 0; i < 16; ++i) oacc[dt][i] = 0.f;
  float mrow = -1e30f, lrow = 0.f;
  u32x4 kr[NKC], vr;
  const int vrow = t >> 3, vcc = t & 7;
#define A_LOAD(KT) { \
    _Pragma("unroll") for (int i = 0; i < NKC; ++i) { const int c_ = t + NTHR * i; if (c_ < 64 * KCH) kr[i] = *(const u32x4*)(K + (long)((KT) * 64 + c_ / KCH) * ldk + (c_ % KCH) * 8); } \
    vr = *(const u32x4*)(V + (long)((KT) * 64 + vrow) * ldv + vcc * 8); }
#define A_STORE(ST) { bf16_t* Kd_ = KV + (ST) * KBUF; bf16_t* Vd_ = Kd_ + 64 * KLD; \
    _Pragma("unroll") for (int i = 0; i < NKC; ++i) { const int c_ = t + NTHR * i; if (c_ < 64 * KCH) *(u32x4*)(Kd_ + (c_ / KCH) * KLD + (c_ % KCH) * 8) = kr[i]; } \
    *(u32x4*)(Vd_ + vrow * VLD + vcc * 8) = vr; }
  A_LOAD(0)
  A_STORE(0)
  if (ntiles > 1) A_LOAD(1)
  __syncthreads();
  const int qrow = q0 + w * 32 + l31;
  for (int kt = 0; kt < ntiles; ++kt) {
    const bf16_t* Ks = KV + (kt & 1) * KBUF;
    const bf16_t* Vs = Ks + 64 * KLD;
    f32x16 sacc[2];
#pragma unroll
    for (int T = 0; T < 2; ++T) {
#pragma unroll
      for (int i = 0; i < 16; ++i) sacc[T][i] = 0.f;
#pragma unroll
      for (int ks = 0; ks < NK16; ++ks) {
        const bf16x8 kf = *(const bf16x8*)(Ks + (T * 32 + l31) * KLD + ks * 16 + hh * 8);
        sacc[T] = mfma32(kf, qf[ks], sacc[T]);
      }
    }
    if (CAUSAL && (kt * 64 + 63 > q0 + w * 32)) {
#pragma unroll
      for (int T = 0; T < 2; ++T)
#pragma unroll
        for (int i = 0; i < 16; ++i) {
          const int key = kt * 64 + T * 32 + (i & 3) + 8 * (i >> 2) + 4 * hh;
          if (key > qrow) sacc[T][i] = -1e30f;
        }
    }
    float mx = sacc[0][0];
#pragma unroll
    for (int T = 0; T < 2; ++T)
#pragma unroll
      for (int i = 0; i < 16; ++i) mx = fmaxf(mx, sacc[T][i]);
    mx = fmaxf(mx, lane_get(mx, lane ^ 32));
    const float mn = fmaxf(mrow, mx);
    const float alpha = __builtin_amdgcn_exp2f(mrow - mn);
    mrow = mn;
    float ps = 0.f;
#pragma unroll
    for (int T = 0; T < 2; ++T)
#pragma unroll
      for (int i = 0; i < 16; ++i) { const float pv = __builtin_amdgcn_exp2f(sacc[T][i] - mn); sacc[T][i] = pv; ps += pv; }
    lrow = lrow * alpha + ps;
#pragma unroll
    for (int dt = 0; dt < 2; ++dt)
#pragma unroll
      for (int i = 0; i < 16; ++i) oacc[dt][i] *= alpha;
#pragma unroll
    for (int T = 0; T < 2; ++T)
#pragma unroll
      for (int s2 = 0; s2 < 2; ++s2) {
        union { unsigned u[4]; bf16x8 v; } pf;
#pragma unroll
        for (int j = 0; j < 4; ++j) pf.u[j] = cvt_pk_bf16(sacc[T][8 * s2 + 2 * j], sacc[T][8 * s2 + 2 * j + 1]);
        const int kb = T * 32 + 16 * s2 + 4 * hh + (l15 >> 2);
#pragma unroll
        for (int dt = 0; dt < 2; ++dt) {
          const bf16_t* vp = Vs + kb * VLD + dt * 32 + 16 * ((lane >> 4) & 1) + 4 * (l15 & 3);
          const s16x4 va = __builtin_amdgcn_ds_read_tr16_b64_v4i16((__attribute__((address_space(3))) s16x4*)vp);
          const s16x4 vb = __builtin_amdgcn_ds_read_tr16_b64_v4i16((__attribute__((address_space(3))) s16x4*)(vp + 8 * VLD));
          const bf16x8 vf = (bf16x8){va[0], va[1], va[2], va[3], vb[0], vb[1], vb[2], vb[3]};
          oacc[dt] = mfma32(vf, pf.v, oacc[dt]);
        }
      }
    if (kt + 1 < ntiles) {
      A_STORE((kt + 1) & 1)
      if (kt + 2 < ntiles) A_LOAD(kt + 2)
    }
    __syncthreads();
  }
#undef A_LOAD
#undef A_STORE
  lrow += lane_get(lrow, lane ^ 32);
  const float inv = 1.f / lrow;
  bf16_t* orow = O + (long)(w * 32 + l31) * ldo;
#pragma unroll
  for (int dt = 0; dt < 2; ++dt)
#pragma unroll
    for (int g4 = 0; g4 < 4; ++g4) {
      uint2 o2;
      o2.x = cvt_pk_bf16(oacc[dt][4 * g4] * inv, oacc[dt][4 * g4 + 1] * inv);
      o2.y = cvt_pk_bf16(oacc[dt][4 * g4 + 2] * inv, oacc[dt][4 * g4 + 3] * inv);
      *(uint2*)(orow + dt * 32 + 8 * g4 + 4 * hh) = o2;
    }
}

__device__ __forceinline__ void ssd_item(const Ctx& c, int b, int h) {
  char* ws = c.ws; char* smem = c.smem;
  const int t = c.tid, lane = t & 63, w = t >> 6, l15 = lane & 15, lq = lane >> 4;
  const int g = h >> 2;
  const int pw = w & 3, nq = (w >> 2) * 4;
  bf16_t* Cl = (bf16_t*)smem;
  bf16_t* Bl = Cl + 128 * 136;
  bf16_t* Ml = Bl + 128 * 136;
  bf16_t* Sl = Ml + 128 * 136;
  bf16_t* Xl = Sl + 64 * 136;
  float* fa = (float*)(Xl + 128 * 72);
  const bf16_t* xc = (const bf16_t*)(ws + OFF_R4);
  const bf16_t* proj = (const bf16_t*)(ws + OFF_R2);
  const float* dtp = (const float*)(ws + OFF_DT);
  bf16_t* AY = (bf16_t*)(ws + OFF_R1);
  const float a_h = -__expf(INP(I_A_LOG)[h]);
  const float dsk = INP(I_D_SKIP)[h];
  f32x4 st[4];
#pragma unroll
  for (int i = 0; i < 4; ++i) st[i] = zero4();
  u32x4 pc[4], pb[4], px[2]; float pd[2], pa0 = 0.f, pa1 = 0.f;
#define S_LOAD(CK) { const long tn_ = (long)b * 4096 + (CK) * 128; \
    _Pragma("unroll") for (int i = 0; i < 4; ++i) { const int ch = t + NTHR * i, r = ch >> 4, cc = ch & 15; \
      pc[i] = *(const u32x4*)(xc + (tn_ + r) * 1024 + 768 + g * 128 + cc * 8); pb[i] = *(const u32x4*)(xc + (tn_ + r) * 1024 + 512 + g * 128 + cc * 8); } \
    _Pragma("unroll") for (int i = 0; i < 2; ++i) { const int ch = t + NTHR * i, r = ch >> 3, cc = ch & 7; \
      px[i] = *(const u32x4*)(xc + (tn_ + r) * 1024 + h * 64 + cc * 8); pd[i] = dtp[(tn_ + r) * 8 + h]; } \
    if (w == 0) { pa0 = dtp[(tn_ + 2 * lane) * 8 + h]; pa1 = dtp[(tn_ + 2 * lane + 1) * 8 + h]; } }
  S_LOAD(0)
  for (int ck = 0; ck < 32; ++ck) {
    const long t0 = (long)b * 4096 + ck * 128;
#pragma unroll
    for (int i = 0; i < 4; ++i) {
      const int ch = t + NTHR * i, r = ch >> 4, cc = ch & 15;
      *(u32x4*)(Cl + r * 136 + cc * 8) = pc[i];
      *(u32x4*)(Bl + r * 136 + cc * 8) = pb[i];
    }
#pragma unroll
    for (int i = 0; i < 2; ++i) {
      const int ch = t + NTHR * i, r = ch >> 3, cc = ch & 7;
      const u32x4 u = px[i]; const float d = pd[i];
      *(uint4*)(Xl + r * 72 + cc * 8) = make_uint4(pack2(bflo(u.x) * d, bfhi(u.x) * d), pack2(bflo(u.y) * d, bfhi(u.y) * d),
                                                   pack2(bflo(u.z) * d, bfhi(u.z) * d), pack2(bflo(u.w) * d, bfhi(u.w) * d));
    }
    if (w == 0) {
      const float a0 = pa0 * a_h, a1 = pa1 * a_h;
      const float pr = a0 + a1;
      float sc = pr;
#pragma unroll
      for (int o = 1; o < 64; o <<= 1) { const float n = lane_get(sc, (lane - o) & 63); if (lane >= o) sc += n; }
      const float alast = __int_as_float(__builtin_amdgcn_readlane(__float_as_int(sc), 63));
      const float c0 = sc - pr + a0, c1 = sc;
      fa[2 * lane] = c0; fa[2 * lane + 1] = c1;
      fa[128 + 2 * lane] = __expf(c0); fa[128 + 2 * lane + 1] = __expf(c1);
      fa[256 + 2 * lane] = __expf(alast - c0); fa[256 + 2 * lane + 1] = __expf(alast - c1);
    }
#pragma unroll
    for (int i = 0; i < 4; ++i)
#pragma unroll
      for (int r = 0; r < 4; ++r) Sl[(pw * 16 + lq * 4 + r) * 136 + (nq + i) * 16 + l15] = f2bf(st[i][r]);
    __syncthreads();
    if (ck + 1 < 32) S_LOAD(ck + 1)
    __builtin_amdgcn_sched_barrier(0);
    bf16x8 cf[4];
#pragma unroll
    for (int ks = 0; ks < 4; ++ks) cf[ks] = *(const bf16x8*)(Cl + (w * 16 + l15) * 136 + ks * 32 + lq * 8);
    f32x4 yacc[4];
#pragma unroll
    for (int pt = 0; pt < 4; ++pt) {
      yacc[pt] = zero4();
      if (ck > 0) {
#pragma unroll
        for (int ks = 0; ks < 4; ++ks) {
          const bf16x8 sf = *(const bf16x8*)(Sl + (pt * 16 + l15) * 136 + ks * 32 + lq * 8);
          yacc[pt] = mfma16(cf[ks], sf, yacc[pt]);
        }
#pragma unroll
        for (int r = 0; r < 4; ++r) yacc[pt][r] *= fa[128 + w * 16 + lq * 4 + r];
      }
    }
#pragma unroll
    for (int stl = 0; stl < 8; ++stl) {
      if (stl <= w) {
        f32x4 gacc = zero4();
#pragma unroll
        for (int ks = 0; ks < 4; ++ks) {
          const bf16x8 bfv = *(const bf16x8*)(Bl + (stl * 16 + l15) * 136 + ks * 32 + lq * 8);
          gacc = mfma16(cf[ks], bfv, gacc);
        }
#pragma unroll
        for (int r = 0; r < 4; ++r) {
          const int tt = w * 16 + lq * 4 + r, ss = stl * 16 + l15;
          float m = 0.f;
          if (ss <= tt) m = gacc[r] * __expf(fa[tt] - fa[ss]);
          Ml[tt * 136 + ss] = f2bf(m);
        }
      } else if (stl <= (w | 1)) {
#pragma unroll
        for (int r = 0; r < 4; ++r) Ml[(w * 16 + lq * 4 + r) * 136 + stl * 16 + l15] = 0;
      }
    }
    __builtin_amdgcn_fence(__ATOMIC_RELEASE, "wavefront");
    __builtin_amdgcn_wave_barrier();
    __builtin_amdgcn_fence(__ATOMIC_ACQUIRE, "wavefront");
#pragma unroll
    for (int ks = 0; ks < 4; ++ks) {
      if (ks * 32 <= w * 16 + 15) {
        const bf16x8 mf = *(const bf16x8*)(Ml + (w * 16 + l15) * 136 + ks * 32 + lq * 8);
#pragma unroll
        for (int pt = 0; pt < 4; ++pt) {
          const bf16x8 xf = tr_frag(Xl, 72, ks * 32, pt * 16, l15, lq);
          yacc[pt] = mfma16(mf, xf, yacc[pt]);
        }
      }
    }
    {
      __builtin_amdgcn_fence(__ATOMIC_RELEASE, "wavefront");
      __builtin_amdgcn_wave_barrier();
      float* Yf = (float*)(Ml + (w * 16) * 136);
#pragma unroll
      for (int pt = 0; pt < 4; ++pt)
#pragma unroll
        for (int r = 0; r < 4; ++r) Yf[(lq * 4 + r) * 68 + pt * 16 + l15] = yacc[pt][r];
      __builtin_amdgcn_fence(__ATOMIC_RELEASE, "wavefront");
      __builtin_amdgcn_wave_barrier();
      __builtin_amdgcn_fence(__ATOMIC_ACQUIRE, "wavefront");
      const int rr = lane >> 2, seg = (lane & 3) * 16;
      const long tok = t0 + w * 16 + rr;
      const bf16_t* xp = xc + tok * 1024 + h * 64 + seg;
      const bf16_t* zp = proj + tok * PROJ_LD + C_Z + h * 64 + seg;
      bf16_t* op = AY + tok * 1024 + 512 + h * 64 + seg;
#pragma unroll
      for (int j = 0; j < 2; ++j) {
        const uint4 xu = *(const uint4*)(xp + j * 8), zu = *(const uint4*)(zp + j * 8);
        const float4 ya = *(const float4*)(Yf + rr * 68 + seg + j * 8), yb = *(const float4*)(Yf + rr * 68 + seg + j * 8 + 4);
        const float xf_[8] = {bflo(xu.x), bfhi(xu.x), bflo(xu.y), bfhi(xu.y), bflo(xu.z), bfhi(xu.z), bflo(xu.w), bfhi(xu.w)};
        const float zf_[8] = {bflo(zu.x), bfhi(zu.x), bflo(zu.y), bfhi(zu.y), bflo(zu.z), bfhi(zu.z), bflo(zu.w), bfhi(zu.w)};
        const float yf_[8] = {ya.x, ya.y, ya.z, ya.w, yb.x, yb.y, yb.z, yb.w};
        float o[8];
#pragma unroll
        for (int e = 0; e < 8; ++e) o[e] = (yf_[e] + xf_[e] * dsk) * silu_f(zf_[e]);
        *(uint4*)(op + j * 8) = make_uint4(pack2(o[0], o[1]), pack2(o[2], o[3]), pack2(o[4], o[5]), pack2(o[6], o[7]));
      }
    }
    if (ck + 1 < 32) {
      const float dec = fa[128 + 127];
#pragma unroll
      for (int i = 0; i < 4; ++i)
#pragma unroll
        for (int r = 0; r < 4; ++r) st[i][r] *= dec;
#pragma unroll
      for (int ks = 0; ks < 4; ++ks) {
        const bf16x8 xr = tr_frag(Xl, 72, ks * 32, pw * 16, l15, lq);
        bf16x8 xf;
#pragma unroll
        for (int j = 0; j < 8; ++j) xf[j] = (short)f2bf(bf2f((bf16_t)xr[j]) * fa[256 + ks * 32 + lq * 8 + j]);
#pragma unroll
        for (int i = 0; i < 4; ++i) {
          const bf16x8 bfv = tr_frag(Bl, 136, ks * 32, (nq + i) * 16, l15, lq);
          st[i] = mfma16(xf, bfv, st[i]);
        }
      }
    }
    __syncthreads();
  }
#undef S_LOAD
}

__device__ __forceinline__ void phase_mix(const Ctx& c0) {
  int* sitem = (int*)(c0.smem + SMEM_MAIN);
  int* qctr = (int*)(c0.ws + OFF_CTL) + CTL_QCTR + c0.pass;
  const int n_items = 128 + 2048;
  for (;;) {
    int tid = c0.tid; asm volatile("" : "+v"(tid));
    size_t wz = 0; asm volatile("" : "+s"(wz));
    char* ws = c0.ws + wz;
    const Ctx c{c0.p, ws, c0.smem, tid, c0.bid, c0.nblk, c0.f, c0.pass};
    char* smem = c.smem;
    if (tid == 0) *sitem = atomicAdd(qctr, 1);
    __syncthreads();
    const int item = *sitem;
    __syncthreads();
    if (item >= n_items) break;
#ifndef TEST_NO_SSD
    if (item < 128) {
      ssd_item(c, item >> 3, item & 7);
    } else
#endif
    {
#ifndef TEST_NO_ATTN
      const int it = item - 128;
      const int qb = 15 - (it >> 7), bh = it & 127;
      const bf16_t* Q = (const bf16_t*)(ws + OFF_Q) + ((long)bh * 4096 + qb * 256) * 96;
      const bf16_t* K = (const bf16_t*)(ws + OFF_K) + (long)bh * 4096 * 96;
      const bf16_t* Vv = (const bf16_t*)(ws + OFF_VT) + (long)bh * 4096 * 64;
      const int b = bh >> 3, h = bh & 7;
      bf16_t* O = (bf16_t*)(ws + OFF_R1) + ((long)b * 4096 + qb * 256) * 1024 + h * 64;
      attn_block<96, true>(Q, 96, K, 96, Vv, 64, 4 * qb + 4, qb * 256, O, 1024, smem, c.tid);
#endif
    }
  }
}

__device__ __forceinline__ void phase_ynorm(const Ctx& c) {
  bf16_t* AY = (bf16_t*)(c.ws + OFF_R1);
  const int bid = c.bid, nblk = c.nblk;
  const int lane = c.tid & 63;
  const int gw = bid * NWAV + (c.tid >> 6), nw = nblk * NWAV;
  for (int row0 = gw * 4; row0 < NT; row0 += nw * 4) {
    uint4 u[4];
#pragma unroll
    for (int q = 0; q < 4; ++q) u[q] = *(const uint4*)(AY + (long)(row0 + q) * 1024 + 512 + lane * 8);
#pragma unroll
    for (int q = 0; q < 4; ++q) {
      float v[8] = {bflo(u[q].x), bfhi(u[q].x), bflo(u[q].y), bfhi(u[q].y), bflo(u[q].z), bfhi(u[q].z), bflo(u[q].w), bfhi(u[q].w)};
      float ss = 0.f;
#pragma unroll
      for (int j = 0; j < 8; ++j) ss += v[j] * v[j];
      ss = wave_sum(ss, lane);
      const float r = rsqrtf(ss * (1.f / 512.f) + EPS);
      *(uint4*)(AY + (long)(row0 + q) * 1024 + 512 + lane * 8) = make_uint4(pack2(v[0] * r, v[1] * r), pack2(v[2] * r, v[3] * r), pack2(v[4] * r, v[5] * r), pack2(v[6] * r, v[7] * r));
    }
  }
}

__device__ __forceinline__ void phase_gemm_out(const Ctx& c) {
  char* ws = c.ws;
  DenseOrder S; S.init(ws + OFF_R1, 1024, ws + OFF_WOUT_T, 1024, NT, 1024, c.nblk, c.bid, 0);
  EpiRes<0> E{ws, INP(I_X), (float*)(ws + OFF_SSQA), nullptr, nullptr, 1.f};
  fast_gemm((LAS3 unsigned char*)c.smem, S, E, 1024, c.tid);
}

__device__ __forceinline__ void phase_pool_gemm(const Ctx& c) {
  char* ws = c.ws;
  DenseOrder S; S.init(ws + OFF_R1, 1024, ws + OFF_POOL_T, 256, NT, 1024, c.nblk, c.bid, 512);
  EpiRes<2> E{ws, nullptr, (float*)(ws + OFF_SSQA), INP(I_POOL_B), INP(I_POOL_SCALE), c.f};
  fast_gemm((LAS3 unsigned char*)c.smem, S, E, 256, c.tid);
}

__device__ __forceinline__ void phase_xq(const Ctx& c, int l) {
  char* ws = c.ws;
  DenseOrder S; S.init(ws + OFF_XCB, 1024, ws + OFF_XQ_T + (size_t)l * 256 * 1024 * 2, 1024, NT, 256, c.nblk, c.bid, 0);
  EpiXq E{ws, c.smem, INP(I_XQ_NORM) + l * 64, c.tid, 0};
  fast_gemm((LAS3 unsigned char*)c.smem, S, E, 1024, c.tid);
}

__device__ __forceinline__ void phase_xattn(const Ctx& c, int l) {
  char* ws = c.ws; char* smem = c.smem; const int bid = c.bid, nblk = c.nblk; (void)smem; (void)bid; (void)nblk;
  for (int item = bid; item < 256 * 4; item += nblk) {
    const int mt = item >> 2, h = item & 3;
    const int b = mt >> 4;
    const bf16_t* Q = (const bf16_t*)(ws + OFF_XQ) + (long)mt * 256 * 256 + h * 64;
    const bf16_t* K = (const bf16_t*)(ws + OFF_MEMK) + (long)l * 4096 * 256 + (long)b * 256 * 256 + h * 64;
    const bf16_t* Vv = (const bf16_t*)(ws + OFF_MEMVT) + (long)l * 4096 * 256 + (long)b * 256 * 256 + h * 64;
    bf16_t* O = (bf16_t*)(ws + OFF_XO) + (long)mt * 256 * 256 + h * 64;
    attn_block<64, false>(Q, 256, K, 256, Vv, 256, 4, 0, O, 256, smem, c.tid);
  }
}

__device__ __forceinline__ void phase_xo(const Ctx& c, int l) {
  char* ws = c.ws;
  DenseOrder S; S.init(ws + OFF_XO, 256, ws + OFF_XO_T + (size_t)l * 1024 * 256 * 2, 256, NT, 1024, c.nblk, c.bid, 0);
  EpiRes<1> E{ws, nullptr, (float*)(ws + OFF_SSQB), nullptr, nullptr, c.f};
  fast_gemm((LAS3 unsigned char*)c.smem, S, E, 256, c.tid);
}

__device__ __forceinline__ void phase_router(const Ctx& c, int l) {
  char* ws = c.ws; char* smem = c.smem; const int bid = c.bid, nblk = c.nblk;
  const int t = c.tid, lane = t & 63, w = t >> 6, l15 = lane & 15, lq = lane >> 4;
  bf16_t* Ah = (bf16_t*)smem;
  bf16_t* Al = Ah + 128 * 72;
  bf16_t* Wh = Al + 128 * 72;
  bf16_t* Wl = Wh + 48 * 72;
  float* rsl = (float*)(Wl + 48 * 72);
  float* lg = rsl + 128;
  const float* lnf = INP(I_LN_FFN) + l * 1024;
  const bf16_t* wrh = (const bf16_t*)(ws + OFF_WR) + (size_t)(l * 2) * 48 * 1024;
  const bf16_t* wrl = wrh + 48 * 1024;
  int* cnt = (int*)(ws + OFF_CTL) + CTL_CNT + l * 32;
  int* list = (int*)(ws + OFF_LIST);
  float* gate = (float*)(ws + OFF_GATE);
  for (int item = bid; item < NT / 128; item += nblk) {
    const int tok0 = item * 128;
    if (t < 128) {
      const float r = row_rs32((const float*)(ws + OFF_SSQB), tok0 + t);
      rsl[t] = r; ((float*)(ws + OFF_RS2))[tok0 + t] = r;
    }
    f32x4 acc[3];
#pragma unroll
    for (int i = 0; i < 3; ++i) acc[i] = zero4();
    const int lr = t >> 4, lc = (t & 15) * 4;
    const bf16_t* xres = (const bf16_t*)(ws + OFF_XCB);
    uint2 xv[4];
#pragma unroll
    for (int i = 0; i < 4; ++i) xv[i] = *(const uint2*)(xres + (long)(tok0 + lr + 32 * i) * 1024 + lc);
    __syncthreads();
    for (int kc = 0; kc < 16; ++kc) {
      const float4 gn = *(const float4*)(lnf + kc * 64 + lc);
#pragma unroll
      for (int i = 0; i < 4; ++i) {
        const float rs = rsl[lr + 32 * i];
        const float h0 = bflo(xv[i].x) * rs * gn.x, h1 = bfhi(xv[i].x) * rs * gn.y, h2 = bflo(xv[i].y) * rs * gn.z, h3 = bfhi(xv[i].y) * rs * gn.w;
        const bf16_t b0 = f2bf(h0), b1 = f2bf(h1), b2 = f2bf(h2), b3 = f2bf(h3);
        *(uint2*)(Ah + (lr + 32 * i) * 72 + lc) = make_uint2((unsigned)b0 | ((unsigned)b1 << 16), (unsigned)b2 | ((unsigned)b3 << 16));
        *(uint2*)(Al + (lr + 32 * i) * 72 + lc) = make_uint2(pack2(h0 - bf2f(b0), h1 - bf2f(b1)), pack2(h2 - bf2f(b2), h3 - bf2f(b3)));
      }
      if (t < 384) { const int r = t >> 3, cc = (t & 7) * 8; *(uint4*)(Wh + r * 72 + cc) = *(const uint4*)(wrh + r * 1024 + kc * 64 + cc); }
      else if (t < 384 + 128) { const int u = t - 384; for (int q = u; q < 384; q += 128) { const int r = q >> 3, cc = (q & 7) * 8; *(uint4*)(Wl + r * 72 + cc) = *(const uint4*)(wrl + r * 1024 + kc * 64 + cc); } }
      if (kc + 1 < 16) {
#pragma unroll
        for (int i = 0; i < 4; ++i) xv[i] = *(const uint2*)(xres + (long)(tok0 + lr + 32 * i) * 1024 + (kc + 1) * 64 + lc);
      }
      __syncthreads();
#pragma unroll
      for (int ks = 0; ks < 2; ++ks) {
        const bf16x8 ah = *(const bf16x8*)(Ah + (w * 16 + l15) * 72 + ks * 32 + lq * 8);
        const bf16x8 al = *(const bf16x8*)(Al + (w * 16 + l15) * 72 + ks * 32 + lq * 8);
#pragma unroll
        for (int nt = 0; nt < 3; ++nt) {
          const bf16x8 wh = *(const bf16x8*)(Wh + (nt * 16 + l15) * 72 + ks * 32 + lq * 8);
          const bf16x8 wl = *(const bf16x8*)(Wl + (nt * 16 + l15) * 72 + ks * 32 + lq * 8);
          acc[nt] = mfma16(ah, wh, acc[nt]);
          acc[nt] = mfma16(al, wh, acc[nt]);
          acc[nt] = mfma16(ah, wl, acc[nt]);
        }
      }
      __syncthreads();
    }
#pragma unroll
    for (int nt = 0; nt < 3; ++nt)
#pragma unroll
      for (int r = 0; r < 4; ++r) lg[(w * 16 + lq * 4 + r) * 49 + nt * 16 + l15] = acc[nt][r];
    __syncthreads();
    int* lcn = (int*)(lg + 128 * 49);
    if (t < 32) lcn[t] = 0;
    __syncthreads();
    int x0 = 0, x1 = 0, r0 = 0, r1 = 0; float g0 = 0.f, g1 = 0.f;
    if (t < 128) {
      const float* L = lg + t * 49;
      float gl[4];
#pragma unroll
      for (int i = 0; i < 4; ++i) gl[i] = L[i] + INP(I_RG_B)[l * 4 + i];
      int gi = 0; float gm = gl[0];
#pragma unroll
      for (int i = 1; i < 4; ++i) if (gl[i] > gm) { gm = gl[i]; gi = i; }
      float gsum = 0.f;
#pragma unroll
      for (int i = 0; i < 4; ++i) gsum += __expf(gl[i] - gm);
      const float gp = 1.f / gsum;
      float e0 = -3e38f, e1 = -3e38f; int i0 = 0, i1 = 0;
      for (int j = 0; j < 8; ++j) {
        const float v = L[4 + gi * 8 + j] + INP(I_RE_B)[l * 32 + gi * 8 + j];
        if (v > e0) { e1 = e0; i1 = i0; e0 = v; i0 = j; }
        else if (v > e1) { e1 = v; i1 = j; }
      }
      const float p1 = __expf(e1 - e0);
      g0 = gp / (1.f + p1); g1 = gp * p1 / (1.f + p1);
      x0 = gi * 8 + i0; x1 = gi * 8 + i1;
      r0 = atomicAdd(&lcn[x0], 1);
      r1 = atomicAdd(&lcn[x1], 1);
    }
    __syncthreads();
    if (t < 32 && c.f != 0.f) lcn[32 + t] = atomicAdd(&cnt[t], lcn[t]);
    __syncthreads();
    if (t < 128 && c.f != 0.f) {
      const int tok = tok0 + t;
      const int pos0 = lcn[32 + x0] + r0, pos1 = lcn[32 + x1] + r1;
      list[x0 * 65536 + pos0] = tok * 2;
      list[x1 * 65536 + pos1] = tok * 2 + 1;
      gate[tok * 2] = g0; gate[tok * 2 + 1] = g1;
      int* pinfo = (int*)(ws + OFF_PINFO);
      pinfo[tok * 2] = (x0 << 16) | pos0; pinfo[tok * 2 + 1] = (x1 << 16) | pos1;
    }
    __syncthreads();
  }
}

__device__ __forceinline__ int expert_prefix(const int* cnt, int* pre, int tid) {
  if (tid == 0) {
    int s = 0;
    for (int e = 0; e < 32; ++e) { pre[e] = s; s += (cnt[e] + 255) >> 8; }
    pre[32] = s;
  }
  __syncthreads();
  return pre[32];
}

template <bool GA_>
struct ExpertOrder {
  static constexpr bool GATHER = GA_;
  const char* A; const char* W; const int* list; const int* cnt; const int* pre; int lda_, ldb_, nN, total, G, c, which; size_t wstride;
  __device__ __forceinline__ bool next(int i, FUnit& u) const {
    const long L = (long)i * G + c; if (L >= (long)total * nN) return false;
    const int tile = (int)(L / nN); u.pn = (int)(L % nN); u.pm = tile;
    int e = 0;
    for (int j = 1; j < 32; ++j) if (pre[j] <= tile) e = j;
    e = __builtin_amdgcn_readfirstlane(e);
    u.e = e; u.pos0 = __builtin_amdgcn_readfirstlane((tile - pre[e]) * 256);
    u.nvalid = __builtin_amdgcn_readfirstlane(min(256, cnt[e] - u.pos0)); return true;
  }
  __device__ __forceinline__ unsigned lda() const { return (unsigned)lda_; }
  __device__ __forceinline__ unsigned ldb() const { return (unsigned)ldb_; }
  __device__ __forceinline__ const char* a_ptr(const FUnit& u) const { return GA_ ? A : A + (size_t)u.pm * 256 * lda_ * 2; }
  __device__ __forceinline__ const char* b_ptr(const FUnit& u) const { return W + (size_t)u.e * wstride + (size_t)u.pn * 256 * ldb_ * 2; }
  __device__ __forceinline__ void a_offs(const FUnit& u, int tid, unsigned (&va)[2][2]) const {
    int R0, C0, R1, C1; fg_stage_rc(tid * 16, R0, C0); fg_stage_rc(tid * 16 + 8192, R1, C1);
    const int* lp = list + u.e * 65536 + u.pos0;
#pragma unroll
    for (int h = 0; h < 2; ++h) {
      const int p0 = lp[min(128 * h + R0, u.nvalid - 1)], p1 = lp[min(128 * h + R1, u.nvalid - 1)];
      const int r0 = which == 0 ? (p0 >> 1) : p0, r1 = which == 0 ? (p1 >> 1) : p1;
      va[h][0] = (unsigned)(r0 * lda_ + C0) * 2u; va[h][1] = (unsigned)(r1 * lda_ + C1) * 2u;
    }
  }
};

struct EpiExpUp {
  char* ws; const int* list;
  __device__ __forceinline__ void operator()(const f32x4 (&acc)[2][2][4][2], const FUnit& u, int wr, int wc, int fr, int fq, int lane) const {
    const float* rs2 = (const float*)(ws + OFF_RS2);
    bf16_t* hb = (bf16_t*)(ws + OFF_HBUF);
#pragma unroll
    for (int ai = 0; ai < 2; ++ai)
#pragma unroll
      for (int m = 0; m < 4; ++m) {
        const int rl = ai * 128 + wr * 64 + m * 16 + fr;
        const int pair = list[u.e * 65536 + u.pos0 + min(rl, u.nvalid - 1)];
        const float rs = rs2[pair >> 1];
        if (rl < u.nvalid) {
#pragma unroll
          for (int bj = 0; bj < 2; ++bj) {
            const f32x4 g4 = acc[ai][bj][m][0] * rs, u4 = acc[ai][bj][m][1] * rs;
            const int col = u.pn * 128 + bj * 64 + wc * 16 + fq * 4;
            uint2 w2; w2.x = cvt_pk_bf16(silu_f(g4[0]) * u4[0], silu_f(g4[1]) * u4[1]); w2.y = cvt_pk_bf16(silu_f(g4[2]) * u4[2], silu_f(g4[3]) * u4[3]);
            *(uint2*)(hb + ((long)u.pm * 256 + rl) * 256 + col) = w2;
          }
        }
      }
  }
};
struct EpiExpDown {
  char* ws;
  __device__ __forceinline__ void operator()(const f32x4 (&acc)[2][2][4][2], const FUnit& u, int wr, int wc, int fr, int fq, int lane) const {
    bf16_t* yb = (bf16_t*)(ws + OFF_YBUF);
#pragma unroll
    for (int ai = 0; ai < 2; ++ai)
#pragma unroll
      for (int m = 0; m < 4; ++m) {
        const long row = (long)u.pm * 256 + ai * 128 + wr * 64 + m * 16 + fr;
#pragma unroll
        for (int bj = 0; bj < 2; ++bj) {
          const f32x4 v0 = acc[ai][bj][m][0], v1 = acc[ai][bj][m][1];
          const int col0 = u.pn * 256 + bj * 128 + wc * 32 + fq * 8;
          u32x4 w4; w4.x = cvt_pk_bf16(v0[0], v0[1]); w4.y = cvt_pk_bf16(v0[2], v0[3]); w4.z = cvt_pk_bf16(v1[0], v1[1]); w4.w = cvt_pk_bf16(v1[2], v1[3]);
          *(u32x4*)(yb + row * 1024 + col0) = w4;
        }
      }
  }
};

template <int WHICH>
__device__ __forceinline__ void phase_expert(const Ctx& c, int l) {
  char* ws = c.ws; char* smem = c.smem;
  int* pre = (int*)(smem + SMEM_MAIN + 16);
  const int* cnt = (const int*)(ws + OFF_CTL) + CTL_CNT + l * 32;
  const int* list = (const int*)(ws + OFF_LIST);
  const int ttiles = expert_prefix(cnt, pre, c.tid);
  if (WHICH == 0) {
    ExpertOrder<true> S;
    S.list = list; S.cnt = cnt; S.pre = pre; S.total = ttiles; S.G = c.nblk; S.c = c.bid; S.which = 0;
    S.A = ws + OFF_XCB; S.lda_ = 1024; S.W = ws + OFF_WGU_T + (size_t)l * 32 * 512 * 1024 * 2; S.ldb_ = 1024; S.nN = 2; S.wstride = (size_t)512 * 1024 * 2;
    EpiExpUp E{ws, list};
    fast_gemm((LAS3 unsigned char*)smem, S, E, 1024, c.tid);
  } else {
    ExpertOrder<false> S;
    S.list = list; S.cnt = cnt; S.pre = pre; S.total = ttiles; S.G = c.nblk; S.c = c.bid; S.which = 1;
    S.A = ws + OFF_HBUF; S.lda_ = 256; S.W = ws + OFF_WD_T + (size_t)l * 32 * 1024 * 256 * 2; S.ldb_ = 256; S.nN = 4; S.wstride = (size_t)1024 * 256 * 2;
    EpiExpDown E{ws};
    fast_gemm((LAS3 unsigned char*)smem, S, E, 256, c.tid);
  }
}

__device__ __forceinline__ void phase_combine(const Ctx& c, int l) {
  char* ws = c.ws; const int bid = c.bid, nblk = c.nblk;
  const int lane = c.tid & 63;
  const int gw = bid * NWAV + (c.tid >> 6), nw = nblk * NWAV;
  const bf16_t* yb = (const bf16_t*)(ws + OFF_YBUF);
  bf16_t* xcb = (bf16_t*)(ws + OFF_XCB);
  bf16_t* xnb = (bf16_t*)(ws + OFF_R4);
  const int* pinfo = (const int*)(ws + OFF_PINFO);
  const float* gate = (const float*)(ws + OFF_GATE);
  int* pre = (int*)(c.smem + SMEM_MAIN + 16);
  (void)expert_prefix((const int*)(ws + OFF_CTL) + CTL_CNT + l * 32, pre, c.tid);
  for (int row0 = gw * 2; row0 < NT; row0 += nw * 2) {
    uint2 xr[2][4], ya[2][4], yc[2][4]; float ga[2], gc[2];
#pragma unroll
    for (int q = 0; q < 2; ++q)
#pragma unroll
      for (int i = 0; i < 4; ++i) {
        const int cc = i * 256 + lane * 4; const long row = row0 + q;
        const int i0 = pinfo[row * 2], i1 = pinfo[row * 2 + 1];
        const long r0 = (long)pre[i0 >> 16] * 256 + (i0 & 0xffff), r1 = (long)pre[i1 >> 16] * 256 + (i1 & 0xffff);
        ga[q] = gate[row * 2]; gc[q] = gate[row * 2 + 1];
        xr[q][i] = *(const uint2*)(xcb + row * 1024 + cc);
        ya[q][i] = *(const uint2*)(yb + r0 * 1024 + cc); yc[q][i] = *(const uint2*)(yb + r1 * 1024 + cc);
      }
#pragma unroll
    for (int q = 0; q < 2; ++q) {
      const long row = row0 + q;
      float4 x[4];
      float ss = 0.f;
#pragma unroll
      for (int i = 0; i < 4; ++i) {
        const int cc = i * 256 + lane * 4;
        float4 v;
        const float g0 = ga[q] * c.f, g1 = gc[q] * c.f;
        v.x = bflo(xr[q][i].x) + (g0 * bflo(ya[q][i].x) + g1 * bflo(yc[q][i].x)); v.y = bfhi(xr[q][i].x) + (g0 * bfhi(ya[q][i].x) + g1 * bfhi(yc[q][i].x));
        v.z = bflo(xr[q][i].y) + (g0 * bflo(ya[q][i].y) + g1 * bflo(yc[q][i].y)); v.w = bfhi(xr[q][i].y) + (g0 * bfhi(ya[q][i].y) + g1 * bfhi(yc[q][i].y));
        if (l == 1) { if (c.f != 0.f) *(float4*)(c.p.out + row * 1024 + cc) = v; }
        else {
          const uint2 st2 = make_uint2(pack2(v.x, v.y), pack2(v.z, v.w));
          *(uint2*)(xcb + row * 1024 + cc) = st2;
          v = make_float4(bflo(st2.x), bfhi(st2.x), bflo(st2.y), bfhi(st2.y));
        }
        x[i] = v;
        ss += v.x * v.x + v.y * v.y + v.z * v.z + v.w * v.w;
      }
      if (l == 0) {
        ss = wave_sum(ss, lane);
        const float r = rsqrtf(ss * (1.f / 1024.f) + EPS);
#pragma unroll
        for (int i = 0; i < 4; ++i)
          *(uint2*)(xnb + row * 1024 + i * 256 + lane * 4) = make_uint2(pack2(x[i].x * r, x[i].y * r), pack2(x[i].z * r, x[i].w * r));
      }
    }
  }
}

__device__ __forceinline__ void phase_pool_dlt(const Ctx& c) {
  char* ws = c.ws; char* smem = c.smem; const int bid = c.bid, nblk = c.nblk;
  const bf16_t* xnb = (const bf16_t*)(ws + OFF_R4);
  bf16_t* dl = (bf16_t*)(ws + OFF_R1);
  const int t = c.tid;
  bf16_t* tl = (bf16_t*)smem;
  for (int item = bid; item < 1024 * 4; item += nblk) {
    const int g = item & 3, tt = item >> 2;
    const int tok0 = tt * 64, s0 = tok0 & 4095;
    const int wnd = 2 << g;
    const int halo = min(wnd - 1, s0);
    const int nrows = 64 + halo;
    for (int ch = t; ch < nrows * 32; ch += NTHR) {
      const int r = ch >> 5, cc = ch & 31;
      *(uint4*)(tl + r * 264 + cc * 8) = *(const uint4*)(xnb + (long)(tok0 - halo + r) * 1024 + g * 256 + cc * 8);
    }
    __syncthreads();
    {
      const int r = t >> 3, seg = (t & 7) * 32;
      const int n = min(s0 + r + 1, wnd);
      float a[32];
#pragma unroll
      for (int j = 0; j < 32; ++j) a[j] = 0.f;
      for (int k = 0; k < n; ++k) {
        const bf16_t* rp = tl + (halo + r - k) * 264 + seg;
#pragma unroll
        for (int q = 0; q < 4; ++q) {
          const uint4 u = *(const uint4*)(rp + q * 8);
          a[q * 8 + 0] += bflo(u.x); a[q * 8 + 1] += bfhi(u.x); a[q * 8 + 2] += bflo(u.y); a[q * 8 + 3] += bfhi(u.y);
          a[q * 8 + 4] += bflo(u.z); a[q * 8 + 5] += bfhi(u.z); a[q * 8 + 6] += bflo(u.w); a[q * 8 + 7] += bfhi(u.w);
        }
      }
      const float inv = 1.f / (float)n;
      const bf16_t* sp = tl + (halo + r) * 264 + seg;
      bf16_t* op = dl + (long)(tok0 + r) * 1024 + g * 256 + seg;
#pragma unroll
      for (int q = 0; q < 4; ++q) {
        const uint4 u = *(const uint4*)(sp + q * 8);
        const float sf[8] = {bflo(u.x), bfhi(u.x), bflo(u.y), bfhi(u.y), bflo(u.z), bfhi(u.z), bflo(u.w), bfhi(u.w)};
        float o[8];
#pragma unroll
        for (int j = 0; j < 8; ++j) o[j] = a[q * 8 + j] * inv - sf[j];
        *(uint4*)(op + q * 8) = make_uint4(pack2(o[0], o[1]), pack2(o[2], o[3]), pack2(o[4], o[5]), pack2(o[6], o[7]));
      }
    }
    __syncthreads();
  }
}

#define XB_TMO      128
#define XB_XCNT(j)  (256  + 64 * (j))
#define XB_XSUB(j)  (1280 + 64 * (j))
#define XB_XGEN(j)  (2304 + 64 * (j))
#define XB_TOP      3328
#define XB_TOPGEN   3392
#define XCD_BAR_WORDS 3456
#define XB_SPIN_CAP (1u << 22)
#define LAS __attribute__((address_space(3)))
__device__ __forceinline__ unsigned xb_ld(unsigned* p)              { return __hip_atomic_load(p, __ATOMIC_RELAXED, __HIP_MEMORY_SCOPE_AGENT); }
__device__ __forceinline__ unsigned xb_add(unsigned* p, unsigned v) { return __hip_atomic_fetch_add(p, v, __ATOMIC_RELAXED, __HIP_MEMORY_SCOPE_AGENT); }
__device__ __forceinline__ unsigned xb_xcc_id() { return (unsigned)__builtin_amdgcn_s_getreg((3 << 11) | 20) & 0xFu; }
#define XB_SPIN(cond, bar) do { unsigned _sp = 0; while (cond) { __builtin_amdgcn_s_sleep(1); \
    if ((++_sp & 255u) == 0u) { if (xb_ld(&(bar)[XB_TMO])) break; if (_sp > XB_SPIN_CAP) { atomicAdd(&(bar)[XB_TMO], 1u); break; } } } } while (0)
struct XcdBarrier { unsigned* bar; unsigned x; volatile LAS unsigned* st; };
__device__ __forceinline__ XcdBarrier xcd_barrier_post(unsigned* bar, volatile LAS unsigned* st) {
  XcdBarrier b; b.bar = bar; b.x = xb_xcc_id(); b.st = st;
  if (threadIdx.x == 0) (void)xb_add(&bar[XB_XCNT(b.x)], 1u);
  return b;
}
__device__ __forceinline__ void xcd_barrier_complete(unsigned* bar, unsigned x, unsigned& nloc, unsigned& nx) {
  const unsigned G = gridDim.x * gridDim.y * gridDim.z;
  unsigned sum, cnt, mine, sp = 0u;
  for (;;) {
    sum = 0u; cnt = 0u; mine = 0u;
#pragma unroll
    for (unsigned j = 0; j < 16; ++j) { const unsigned cc = xb_ld(&bar[XB_XCNT(j)]); sum += cc; cnt += (cc > 0u) ? 1u : 0u; mine = (j == x) ? cc : mine; }
    if (sum == G) break;
    __builtin_amdgcn_s_sleep(1);
    if ((++sp & 255u) == 0u) { if (xb_ld(&bar[XB_TMO])) break; if (sp > XB_SPIN_CAP) { atomicAdd(&bar[XB_TMO], 1u); break; } }
  }
  nloc = mine > 0u ? mine : 1u; nx = cnt > 0u ? cnt : 1u;
}
__device__ __forceinline__ void xcd_barrier(const XcdBarrier& b) {
  asm volatile("s_waitcnt vmcnt(0)" ::: "memory");
  __syncthreads();
  if (threadIdx.x == 0) {
    unsigned* bar = b.bar;
    __builtin_amdgcn_s_waitcnt(0);
    unsigned nloc = b.st[0], nx = b.st[1];
    if (nloc == 0u) { xcd_barrier_complete(bar, b.x, nloc, nx); b.st[0] = nloc; b.st[1] = nx; }
    const unsigned old = xb_add(&bar[XB_XSUB(b.x)], 1u);
    const unsigned gen = old / nloc;
    if (old + 1u == (gen + 1u) * nloc) {
      __builtin_amdgcn_fence(__ATOMIC_RELEASE, "agent");
      asm volatile("s_waitcnt vmcnt(0)" ::: "memory");
      const unsigned og = xb_add(&bar[XB_TOP], 1u);
      const unsigned tg = og / nx;
      if (og + 1u == (tg + 1u) * nx) xb_add(&bar[XB_TOPGEN], 1u);
      else XB_SPIN(xb_ld(&bar[XB_TOPGEN]) == tg, bar);
      __builtin_amdgcn_fence(__ATOMIC_ACQUIRE, "agent");
      xb_add(&bar[XB_XGEN(b.x)], 1u);
      asm volatile("s_waitcnt vmcnt(0)" ::: "memory");
    } else {
      XB_SPIN(xb_ld(&bar[XB_XGEN(b.x)]) == gen, bar);
      __builtin_amdgcn_fence(__ATOMIC_ACQUIRE, "agent");
      asm volatile("s_waitcnt vmcnt(0)" ::: "memory");
    }
  }
  __syncthreads();
}

constexpr int N_PHASES = 22;
#define RUN_PHASE(PH, CALL) do { \
    constexpr int nrep_ = ((PROBE_MASK >> (PH)) & 1u) ? 2 : 1; \
    _Pragma("unroll 1") for (int rep_ = 0; rep_ < nrep_; ++rep_) { \
      int tid = threadIdx.x; asm volatile("" : "+v"(tid)); \
      size_t wz = 0; asm volatile("" : "+s"(wz)); \
      char* ws = p.ws + wz; \
      int bid = blockIdx.x; asm volatile("" : "+s"(bid)); \
      int nblk = gridDim.x; asm volatile("" : "+s"(nblk)); \
      const Ctx c{p, ws, smem, tid, bid, nblk, (PROBE_MASK != 0u && rep_) ? 0.f : 1.f, rep_}; \
      CALL; \
      if ((PH) + 1 < N_PHASES || rep_ + 1 < nrep_) xcd_barrier(xb); \
    } } while (0)

__global__ void __launch_bounds__(NTHR, 2) fwd_megakernel(Params p) {
  extern __shared__ __attribute__((aligned(16))) char smem[];
  volatile LAS unsigned* xst = (volatile LAS unsigned*)(smem + SMEM_MAIN + 256);
  if (threadIdx.x < 4) xst[threadIdx.x] = 0u;
  __syncthreads();
  const XcdBarrier xb = xcd_barrier_post((unsigned*)(p.ws + OFF_BAR), xst);
  RUN_PHASE(0, phase_prep(c));
  RUN_PHASE(1, phase_gemm_in(c));
  RUN_PHASE(2, phase_up(c));
  RUN_PHASE(3, phase_mix(c));
  RUN_PHASE(4, phase_ynorm(c));
  RUN_PHASE(5, phase_gemm_out(c));
  RUN_PHASE(6, phase_xq(c, 0));
  RUN_PHASE(7, phase_xattn(c, 0));
  RUN_PHASE(8, phase_xo(c, 0));
  RUN_PHASE(9, phase_router(c, 0));
  RUN_PHASE(10, phase_expert<0>(c, 0));
  RUN_PHASE(11, phase_expert<1>(c, 0));
  RUN_PHASE(12, phase_combine(c, 0));
  RUN_PHASE(13, phase_pool_dlt(c));
  RUN_PHASE(14, phase_pool_gemm(c));
  RUN_PHASE(15, phase_xq(c, 1));
  RUN_PHASE(16, phase_xattn(c, 1));
  RUN_PHASE(17, phase_xo(c, 1));
  RUN_PHASE(18, phase_router(c, 1));
  RUN_PHASE(19, phase_expert<0>(c, 1));
  RUN_PHASE(20, phase_expert<1>(c, 1));
  RUN_PHASE(21, phase_combine(c, 1));
}

extern "C" void kernel_launch(void* const* d_in, const int* in_sizes, int n_in, void* d_out,
                              int out_size, void* d_ws, size_t ws_size, hipStream_t stream) {
  static int grid_blocks = 0;
  if (!grid_blocks) {
    int dev = 0, cus = 0, per_cu = 0;
    (void)hipGetDevice(&dev);
    (void)hipDeviceGetAttribute(&cus, hipDeviceAttributeMultiprocessorCount, dev);
    (void)hipFuncSetAttribute((const void*)fwd_megakernel, hipFuncAttributeMaxDynamicSharedMemorySize, SMEM_BYTES);
    (void)hipOccupancyMaxActiveBlocksPerMultiprocessor(&per_cu, fwd_megakernel, NTHR, SMEM_BYTES);
    if (per_cu > 1) per_cu = 1;
    if (per_cu < 1) per_cu = 1;
    grid_blocks = cus * per_cu;
    if (ws_size < WS_END) { fprintf(stderr, "workspace too small: %zu < %zu\n", ws_size, (size_t)WS_END); grid_blocks = -1; }
    if (n_in != N_IN) { fprintf(stderr, "unexpected n_in %d\n", n_in); grid_blocks = -1; }
  }
  if (grid_blocks < 0) return;
  Params p{};
  for (int i = 0; i < N_IN; ++i) p.in[i] = d_in[i];
  p.out = (float*)d_out;
  p.ws = (char*)d_ws;
  (void)hipMemsetAsync((char*)d_ws + OFF_BAR, 0, 16384, stream);
  void* args[] = {&p};
  hipError_t e = hipLaunchCooperativeKernel((void*)fwd_megakernel, dim3(grid_blocks), dim3(NTHR), args, SMEM_BYTES, stream);
  if (e != hipSuccess) fprintf(stderr, "cooperative launch failed: %s (grid %d)\n", hipGetErrorString(e), grid_blocks);
}
```

```cpp
#include <hip/hip_runtime.h>
#include <hip/hip_cooperative_groups.h>
#include <cstdio>
#include <cstdint>
namespace cg = cooperative_groups;

#ifndef MULTI_LAUNCH
#define MULTI_LAUNCH 0
#endif

typedef unsigned short bf16_t;
typedef short bf16x8 __attribute__((ext_vector_type(8)));
typedef float f32x4 __attribute__((ext_vector_type(4)));
typedef unsigned u32x4 __attribute__((ext_vector_type(4)));

constexpr int NT = 65536, DM = 1024, SEQ = 4096, NB = 16;
constexpr int NTHR = 512, NWAV = 8;
constexpr int PROJ_LD = 2048;
constexpr int C_QLAT = 0, C_KVLAT = 256, C_KROPE = 384, C_Z = 416, C_XBC = 928, C_DT = 1952;
constexpr float EPS = 1e-6f;
constexpr float LOG2E = 1.4426950408889634f;

enum { I_X = 0, I_MEM, I_POS, I_LN_MIX, I_W_IN, I_QLAT_NORM, I_W_UQ, I_KVLAT_NORM, I_W_UKV, I_Q_NORM, I_K_NORM,
       I_CONV_W, I_CONV_B, I_DT_BIAS, I_A_LOG, I_D_SKIP, I_SSD_NORM, I_W_OUT, I_POOL_W, I_POOL_B, I_POOL_SCALE,
       I_LN_XQ, I_LN_MEM, I_XQ_W, I_XKV_W, I_XQ_NORM, I_XK_NORM, I_XO_W, I_LN_FFN, I_RG_W, I_RG_B, I_RE_W, I_RE_B,
       I_EXP_G, I_EXP_U, I_EXP_D, N_IN };

constexpr size_t MiB = 1ull << 20;
constexpr size_t OFF_WIN_T = 0;
constexpr size_t OFF_WUQ_T = OFF_WIN_T + 2048ull * 1024 * 2;
constexpr size_t OFF_WUKV_T = OFF_WUQ_T + 1024ull * 256 * 2;
constexpr size_t OFF_WOUT_T = OFF_WUKV_T + 1024ull * 256 * 2;
constexpr size_t OFF_POOL_T = OFF_WOUT_T + 1024ull * 1024 * 2;
constexpr size_t OFF_XQ_T = OFF_POOL_T + 4ull * 256 * 256 * 2;
constexpr size_t OFF_XKV_T = OFF_XQ_T + 2ull * 256 * 1024 * 2;
constexpr size_t OFF_XO_T = OFF_XKV_T + 2ull * 512 * 1024 * 2;
constexpr size_t OFF_WGU_T = OFF_XO_T + 2ull * 1024 * 256 * 2;
constexpr size_t OFF_WD_T = OFF_WGU_T + 64ull * 512 * 1024 * 2;
constexpr size_t OFF_R1 = OFF_WD_T + 64ull * 1024 * 256 * 2;
constexpr size_t OFF_R2 = OFF_R1 + 128 * MiB;
constexpr size_t OFF_R3 = OFF_R2 + 256 * MiB;
constexpr size_t OFF_R4 = OFF_R3 + 256 * MiB;
constexpr size_t OFF_MISC = OFF_R4 + 128 * MiB;
constexpr size_t OFF_Q = OFF_R3, OFF_K = OFF_R3 + 96 * MiB, OFF_VT = OFF_R3 + 192 * MiB;
constexpr size_t OFF_XCB = OFF_R3, OFF_XQ = OFF_R3 + 128 * MiB, OFF_XO = OFF_R3 + 160 * MiB;
constexpr size_t OFF_RS0 = OFF_MISC;
constexpr size_t OFF_SSQ_Q = OFF_RS0 + NT * 4ull;
constexpr size_t OFF_SSQ_KV = OFF_SSQ_Q + NT * 32ull;
constexpr size_t OFF_DTRAW = OFF_SSQ_KV + NT * 16ull;
constexpr size_t OFF_DT = OFF_DTRAW + NT * 32ull;
constexpr size_t OFF_SSQA = OFF_DT + NT * 32ull;
constexpr size_t OFF_SSQB = OFF_SSQA + NT * 128ull;
constexpr size_t OFF_RS3 = OFF_SSQB + NT * 128ull;
constexpr size_t OFF_RS2 = OFF_RS3 + NT * 4ull;
constexpr size_t OFF_MEMB = OFF_RS2 + NT * 4ull;
constexpr size_t OFF_RSM = OFF_MEMB + 4096ull * 1024 * 2;
constexpr size_t OFF_MEMK = OFF_RSM + 4096 * 4ull;
constexpr size_t OFF_MEMVT = OFF_MEMK + 2ull * 4096 * 256 * 2;
constexpr size_t OFF_GATE = OFF_MEMVT + 2ull * 4096 * 256 * 2;
constexpr size_t OFF_PINFO = OFF_GATE + NT * 8ull;
constexpr size_t OFF_LIST = OFF_PINFO + NT * 8ull;
constexpr size_t OFF_CTL = OFF_LIST + 32ull * 65536 * 4;
constexpr size_t OFF_WR = OFF_CTL + 4096;
constexpr size_t OFF_BAR = OFF_WR + 2ull * 2 * 48 * 1024 * 2;
constexpr size_t OFF_HBUF = OFF_BAR + 16384;
constexpr size_t WS_END = OFF_HBUF + 544ull * 256 * 256 * 2;
constexpr size_t OFF_YBUF = OFF_R2 - 16 * MiB;

constexpr int CTL_CNT = 0;
constexpr int CTL_QCTR = 64;

constexpr int LDS_ST = 72;
constexpr int CS_LD = 132;
constexpr int SMEM_BYTES = 160 * 1024;
constexpr int SMEM_MAIN = SMEM_BYTES - 1024;

struct Params {
  const void* in[N_IN];
  float* out;
  char* ws;
  int phase_lo, phase_hi;
};

#ifndef PROBE_MASK
#define PROBE_MASK 0u
#endif
struct Ctx { const Params& p; char* ws; char* smem; int tid, bid, nblk; float f; int pass; };
__device__ __forceinline__ int opq(int i) { asm volatile("" : "+s"(i)); return i; }
#define INP(i) ((const float*)c.p.in[opq(i)])

__device__ __forceinline__ bf16_t f2bf(float f) {
  unsigned u = __float_as_uint(f);
  u += 0x7fffu + ((u >> 16) & 1u);
  return (bf16_t)(u >> 16);
}
__device__ __forceinline__ float bf2f(bf16_t h) { return __uint_as_float(((unsigned)h) << 16); }
__device__ __forceinline__ unsigned pack2(float lo, float hi) { return (unsigned)f2bf(lo) | ((unsigned)f2bf(hi) << 16); }
__device__ __forceinline__ float bflo(unsigned u) { return __uint_as_float(u << 16); }
__device__ __forceinline__ float bfhi(unsigned u) { return __uint_as_float(u & 0xffff0000u); }
__device__ __forceinline__ float silu_f(float x) { return x / (1.f + __expf(-x)); }
template <int M> __device__ __forceinline__ float sxor(float v) {
  static_assert(M >= 1 && M < 32, "swizzle xor mask");
  return __int_as_float(__builtin_amdgcn_ds_swizzle(__float_as_int(v), (M << 10) | 0x1f));
}
__device__ __forceinline__ float lane_get(float v, int src_lane) { return __int_as_float(__builtin_amdgcn_ds_bpermute(src_lane << 2, __float_as_int(v))); }
__device__ __forceinline__ float wave_sum(float v, int lane) {
  v += sxor<1>(v); v += sxor<2>(v); v += sxor<4>(v); v += sxor<8>(v); v += sxor<16>(v);
  v += lane_get(v, lane ^ 32);
  return v;
}
typedef short s16x4 __attribute__((ext_vector_type(4)));
__device__ __forceinline__ bf16x8 tr_frag(const bf16_t* M, int ld, int k0, int n0, int l15, int lq) {
  const bf16_t* p0 = M + (k0 + 8 * lq + (l15 >> 2)) * ld + n0 + 4 * (l15 & 3);
  const s16x4 a = __builtin_amdgcn_ds_read_tr16_b64_v4i16((__attribute__((address_space(3))) s16x4*)p0);
  const s16x4 b = __builtin_amdgcn_ds_read_tr16_b64_v4i16((__attribute__((address_space(3))) s16x4*)(p0 + 4 * ld));
  return (bf16x8){a[0], a[1], a[2], a[3], b[0], b[1], b[2], b[3]};
}
__device__ __forceinline__ unsigned cvt_pk_bf16(float lo, float hi) { unsigned r; asm volatile("v_cvt_pk_bf16_f32 %0, %1, %2" : "=v"(r) : "v"(lo), "v"(hi)); return r; }
__device__ __forceinline__ f32x4 zero4() { float z = 0.f; asm volatile("" : "+v"(z)); return (f32x4){z, z, z, z}; }
__device__ __forceinline__ f32x4 mfma16(bf16x8 a, bf16x8 b, f32x4 c) { return __builtin_amdgcn_mfma_f32_16x16x32_bf16(a, b, c, 0, 0, 0); }

__device__ __forceinline__ void gemm_core(const char* Ab, const unsigned (&ao)[2], const char* Bb, const unsigned (&bo)[2], int K, char* smem, int tid) {
  const int t = tid, lane = t & 63, w = t >> 6;
  const int wr = w >> 1, wc = w & 1;
  const int l15 = lane & 15, lq = lane >> 4;
  bf16_t* As = (bf16_t*)smem;
  bf16_t* Bs = As + 2 * 128 * LDS_ST;
  const int srow = t >> 3, scol = (t & 7) * 8;
  const int nk = K >> 6;
  u32x4 ra0[2], rb0[2], ra1[2], rb1[2];
#define G_LOAD(RA, RB, KT) { const unsigned kk_ = (unsigned)((KT) < nk ? (KT) : nk - 1) * 128u; \
    _Pragma("unroll") for (int i = 0; i < 2; ++i) { RA[i] = *(const u32x4*)(Ab + (size_t)(ao[i] + kk_)); RB[i] = *(const u32x4*)(Bb + (size_t)(bo[i] + kk_)); } }
#define G_STORE(RA, RB, ST) { bf16_t* An_ = As + (ST) * 128 * LDS_ST; bf16_t* Bn_ = Bs + (ST) * 128 * LDS_ST; \
    _Pragma("unroll") for (int i = 0; i < 2; ++i) { *(u32x4*)(An_ + (srow + 64 * i) * LDS_ST + scol) = RA[i]; *(u32x4*)(Bn_ + (srow + 64 * i) * LDS_ST + scol) = RB[i]; } }
#define G_COMPUTE(ST) { const bf16_t* Ac = As + (ST) * 128 * LDS_ST; const bf16_t* Bc = Bs + (ST) * 128 * LDS_ST; \
    _Pragma("unroll") for (int ks = 0; ks < 2; ++ks) { bf16x8 af[2], bfr[4]; \
      _Pragma("unroll") for (int mt = 0; mt < 2; ++mt) af[mt] = *(const bf16x8*)(Ac + (wr * 32 + mt * 16 + l15) * LDS_ST + ks * 32 + lq * 8); \
      _Pragma("unroll") for (int nt = 0; nt < 4; ++nt) bfr[nt] = *(const bf16x8*)(Bc + (wc * 64 + nt * 16 + l15) * LDS_ST + ks * 32 + lq * 8); \
      _Pragma("unroll") for (int mt = 0; mt < 2; ++mt) _Pragma("unroll") for (int nt = 0; nt < 4; ++nt) acc[mt][nt] = mfma16(af[mt], bfr[nt], acc[mt][nt]); } }
  G_LOAD(ra0, rb0, 0)
  G_LOAD(ra1, rb1, 1)
  G_STORE(ra0, rb0, 0)
  __syncthreads();
  f32x4 acc[2][4];
#pragma unroll
  for (int i = 0; i < 2; ++i)
#pragma unroll
    for (int j = 0; j < 4; ++j) acc[i][j] = zero4();
  for (int kt = 0; kt < nk; kt += 2) {
    G_LOAD(ra0, rb0, kt + 2)
    __builtin_amdgcn_sched_barrier(0);
    G_COMPUTE(0)
    G_STORE(ra1, rb1, 1)
    __syncthreads();
    G_LOAD(ra1, rb1, kt + 3)
    __builtin_amdgcn_sched_barrier(0);
    G_COMPUTE(1)
    G_STORE(ra0, rb0, 0)
    __syncthreads();
  }
#undef G_LOAD
#undef G_STORE
#undef G_COMPUTE
  float* Cs = (float*)smem;
#pragma unroll
  for (int mt = 0; mt < 2; ++mt)
#pragma unroll
    for (int nt = 0; nt < 4; ++nt)
#pragma unroll
      for (int r = 0; r < 4; ++r)
        Cs[(wr * 32 + mt * 16 + lq * 4 + r) * CS_LD + wc * 64 + nt * 16 + l15] = acc[mt][nt][r];
  __syncthreads();
}

__device__ __forceinline__ void gemm_dense(const bf16_t* A, long lda, const bf16_t* Bt, long ldb, int K, char* smem, int tid) {
  const int t = tid;
  const int srow = t >> 3, scol = (t & 7) * 8;
  unsigned ao[2], bo[2];
#pragma unroll
  for (int i = 0; i < 2; ++i) { ao[i] = (unsigned)(((srow + 64 * i) * lda + scol) * 2); bo[i] = (unsigned)(((srow + 64 * i) * ldb + scol) * 2); }
  gemm_core((const char*)A, ao, (const char*)Bt, bo, K, smem, tid);
}

template <int N>
__device__ __forceinline__ void store_bf16_row(bf16_t* dst, const float (&v)[N]) {
#pragma unroll
  for (int j = 0; j < N; j += 8) {
    uint4 u;
    u.x = pack2(v[j], v[j + 1]); u.y = pack2(v[j + 2], v[j + 3]); u.z = pack2(v[j + 4], v[j + 5]); u.w = pack2(v[j + 6], v[j + 7]);
    *(uint4*)(dst + j) = u;
  }
}


#define LAS3 __attribute__((address_space(3)))
constexpr int FG_HTB = 128 * 64 * 2;
__device__ __forceinline__ int fg_lds_byte(int r, int c) { const int st = (r >> 4) * 2 + (c >> 5), rr = r & 15, cc = c & 31, ob = rr * 64 + cc * 2; return st * 1024 + (ob ^ (((ob >> 9) & 1) << 5)); }
__device__ __forceinline__ void fg_stage_rc(int b, int& R, int& C) { const int st = b / 1024, sb = b % 1024, swz = sb ^ (((sb >> 9) & 1) << 5); R = (st >> 1) * 16 + swz / 64; C = (st & 1) * 32 + (swz % 64) / 2; }
__device__ __forceinline__ int fg_perm32(int rho) { const int n = rho >> 4, i = rho & 15; return 8 * (i >> 2) + 4 * n + (i & 3); }
struct FUnit { int pm, pn, e, pos0, nvalid; };

template <class Epi, class Sched>
__device__ __forceinline__ void fast_gemm(LAS3 unsigned char* lds, const Sched& S, const Epi& E, int K, int tid_) {
  const int tid = tid_, wid = __builtin_amdgcn_readfirstlane(tid >> 6), lane = tid & 63, wr = wid >> 2, wc = wid & 3, fr = lane & 15, fq = lane >> 4;
  const int nt = K / 64;
  int R0, C0, R1, C1; fg_stage_rc(tid * 16, R0, C0); fg_stage_rc(tid * 16 + 8192, R1, C1);
  const unsigned ldb = S.ldb();
  unsigned voffB[2];
  voffB[0] = (unsigned)(((R0 & ~31) + fg_perm32(R0 & 31)) * ldb + C0) * 2u;
  voffB[1] = (unsigned)(((R1 & ~31) + fg_perm32(R1 & 31)) * ldb + C1) * 2u;
  const size_t kstep = 128;
  const size_t hstepB = (size_t)128 * ldb * 2;
  const unsigned ldsw = (unsigned)wid * 1024u;
  const int aoff = fg_lds_byte(wr * 64 + fr, fq * 8), boff = fg_lds_byte(wc * 32 + fr, fq * 8);
#define FG_SA(b, h) (((b) * 2 + (h)) * FG_HTB)
#define FG_SB(b, h) ((4 + (b) * 2 + (h)) * FG_HTB)
#define FG_STAGE(bufoff, gbase, voff) do { _Pragma("unroll") for (int _i = 0; _i < 2; ++_i) \
    __builtin_amdgcn_global_load_lds((const unsigned*)((const char*)(gbase) + (voff)[_i]), (LAS3 unsigned*)(lds + (bufoff) + ldsw + _i * 8192), 16, 0, 0); } while (0)
#define FG_LDA(dst, b, h) do { _Pragma("unroll") for (int m = 0; m < 4; ++m) _Pragma("unroll") for (int k = 0; k < 2; ++k) dst[m][k] = *(const LAS3 bf16x8*)(lds + FG_SA(b, h) + aoff + m * 2048 + k * 1024); } while (0)
#define FG_LDB(dst, b, h) do { _Pragma("unroll") for (int n = 0; n < 2; ++n) _Pragma("unroll") for (int k = 0; k < 2; ++k) dst[n][k] = *(const LAS3 bf16x8*)(lds + FG_SB(b, h) + boff + n * 2048 + k * 1024); } while (0)
#define FG_MMA(ai, bj, At, Bt) do { __builtin_amdgcn_s_setprio(1); _Pragma("unroll") for (int m = 0; m < 4; ++m) _Pragma("unroll") for (int n = 0; n < 2; ++n) _Pragma("unroll") for (int k = 0; k < 2; ++k) \
    acc[ai][bj][m][n] = __builtin_amdgcn_mfma_f32_16x16x32_bf16(Bt[n][k], At[m][k], acc[ai][bj][m][n], 0, 0, 0); __builtin_amdgcn_s_setprio(0); } while (0)
#define FG_WAIT_V(n) asm volatile("s_waitcnt vmcnt(" #n ")" ::: "memory")
#define FG_WAIT_L(n) asm volatile("s_waitcnt lgkmcnt(" #n ")" ::: "memory")
#define FG_BAR __builtin_amdgcn_s_barrier()
#define FG_SCHED __builtin_amdgcn_sched_barrier(0)
  FUnit cur, nxt; int ui = 0;
  if (!S.next(0, cur)) return;
  f32x4 acc[2][2][4][2];
#pragma unroll
  for (int a = 0; a < 2; ++a)
#pragma unroll
    for (int b = 0; b < 2; ++b)
#pragma unroll
      for (int m = 0; m < 4; ++m)
#pragma unroll
        for (int n = 0; n < 2; ++n) acc[a][b][m][n] = zero4();
  bf16x8 At[4][2], B0[2][2], B1[2][2];
  constexpr bool GA = Sched::GATHER;
  const unsigned lda = S.lda();
  const size_t hstepA = (size_t)128 * lda * 2;
  unsigned voffA[2];
  voffA[0] = (unsigned)(R0 * lda + C0) * 2u; voffA[1] = (unsigned)(R1 * lda + C1) * 2u;
  unsigned vaC[2][2], vaN[2][2];
  const char* cA = S.a_ptr(cur);
  if (GA) S.a_offs(cur, tid, vaC);
  const char* cB = S.b_ptr(cur);
#define FG_STAGE_A(bufoff, UPTR, KOFF, H, VG) do { if (GA) FG_STAGE(bufoff, (UPTR) + (KOFF), (VG)[H]); else FG_STAGE(bufoff, (UPTR) + (KOFF) + (H) * hstepA, voffA); } while (0)
  FG_STAGE(FG_SB(0, 0), cB, voffB); FG_STAGE_A(FG_SA(0, 0), cA, 0, 0, vaC); FG_STAGE(FG_SB(0, 1), cB + hstepB, voffB); FG_STAGE_A(FG_SA(0, 1), cA, 0, 1, vaC);
  if (wr == 1) FG_BAR;
  FG_WAIT_V(4); FG_BAR;
  FG_STAGE(FG_SB(1, 0), cB + kstep, voffB); FG_STAGE_A(FG_SA(1, 0), cA, kstep, 0, vaC); FG_STAGE(FG_SB(1, 1), cB + hstepB + kstep, voffB);
  FG_WAIT_V(6); FG_BAR;
  for (;;) {
    const bool has_next = S.next(ui + 1, nxt);
    if (!has_next) nxt = cur;
    if (GA) S.a_offs(nxt, tid, vaN);
    const char* nA = has_next ? S.a_ptr(nxt) : cA;
    const char* nB = has_next ? S.b_ptr(nxt) : cB;
#pragma unroll 1
    for (int t = 0; t < nt; t += 2) {
      const bool last = (t == nt - 2);
      const size_t k1 = (size_t)(t + 1) * kstep;
      const char* a2 = last ? nA : cA + (size_t)(t + 2) * kstep;
      const char* b2 = last ? nB : cB + (size_t)(t + 2) * kstep;
      const char* b3 = b2 + kstep;
      FG_LDB(B0, 0, 0); FG_SCHED; FG_LDA(At, 0, 0); FG_STAGE_A(FG_SA(1, 1), cA, k1, 1, vaC);
      FG_WAIT_L(8); FG_BAR; FG_WAIT_L(0); FG_MMA(0, 0, At, B0); FG_BAR; FG_SCHED;
      if (GA && last) {
#pragma unroll
        for (int h = 0; h < 2; ++h)
#pragma unroll
          for (int i = 0; i < 2; ++i) vaC[h][i] = vaN[h][i];
      }
      FG_LDB(B1, 0, 1); FG_STAGE(FG_SB(0, 0), b2, voffB);
      FG_BAR; FG_WAIT_L(0); FG_MMA(0, 1, At, B1); FG_BAR;
      FG_LDA(At, 0, 1); FG_STAGE_A(FG_SA(0, 0), a2, 0, 0, vaC);
      FG_BAR; FG_WAIT_L(0); FG_MMA(1, 0, At, B0); FG_BAR; FG_SCHED;
      FG_STAGE(FG_SB(0, 1), b2 + hstepB, voffB);
      FG_WAIT_V(6); FG_BAR; FG_MMA(1, 1, At, B1); FG_BAR;
      FG_LDB(B0, 1, 0); FG_SCHED; FG_LDA(At, 1, 0); FG_STAGE_A(FG_SA(0, 1), a2, 0, 1, vaC);
      FG_WAIT_L(8); FG_BAR; FG_WAIT_L(0); FG_MMA(0, 0, At, B0); FG_BAR; FG_SCHED;
      FG_LDB(B1, 1, 1); FG_STAGE(FG_SB(1, 0), b3, voffB);
      FG_BAR; FG_WAIT_L(0); FG_MMA(0, 1, At, B1); FG_BAR;
      FG_LDA(At, 1, 1); FG_STAGE_A(FG_SA(1, 0), a2, kstep, 0, vaC);
      FG_BAR; FG_WAIT_L(0); FG_MMA(1, 0, At, B0); FG_BAR; FG_SCHED;
      FG_STAGE(FG_SB(1, 1), b3 + hstepB, voffB);
      FG_WAIT_V(6); FG_BAR; FG_MMA(1, 1, At, B1); FG_BAR;
    }
    {
      int fr2 = fr, fq2 = fq, ln2 = lane; asm volatile("" : "+v"(fr2), "+v"(fq2), "+v"(ln2));
      E(acc, cur, wr, wc, fr2, fq2, ln2);
    }
    if (!has_next) break;
#pragma unroll
    for (int a = 0; a < 2; ++a)
#pragma unroll
      for (int b = 0; b < 2; ++b)
#pragma unroll
        for (int m = 0; m < 4; ++m)
#pragma unroll
          for (int n = 0; n < 2; ++n) acc[a][b][m][n] = zero4();
    cur = nxt; cA = nA; cB = nB; ++ui;
  }
  FG_WAIT_V(0);
  if (wr == 0) FG_BAR;
  FG_BAR;
}

struct DenseOrder {
  const char* A; const char* Bt; int lda_, ldb_, nM, nN, nwg, G, c, a_col_bytes_per_pn;
  __device__ __forceinline__ void init(const void* A_, int ldaa, const void* Bt_, int ldbb, int M, int N, int G_, int c_, int acol) {
    A = (const char*)A_; Bt = (const char*)Bt_; lda_ = ldaa; ldb_ = ldbb; nM = M / 256; nN = N / 256; nwg = nM * nN; G = G_; c = c_; a_col_bytes_per_pn = acol; }
  __device__ __forceinline__ bool next(int i, FUnit& u) const {
    const long L = (long)i * G + c; if (L >= nwg) return false;
    int wgid = (int)L; { const int q = nwg / 8, r = nwg % 8, xcd = wgid % 8, off = wgid / 8; wgid = (xcd < r ? xcd * (q + 1) : r * (q + 1) + (xcd - r) * q) + off; }
    const int nig = 8 * nN, gid = wgid / nig, fm = gid * 8, gsz = (nM - fm) < 8 ? (nM - fm) : 8;
    u.pm = fm + ((wgid % nig) % gsz); u.pn = (wgid % nig) / gsz; u.e = 0; u.pos0 = 0; u.nvalid = 256; return true;
  }
  static constexpr bool GATHER = false;
  __device__ __forceinline__ unsigned lda() const { return (unsigned)lda_; }
  __device__ __forceinline__ unsigned ldb() const { return (unsigned)ldb_; }
  __device__ __forceinline__ const char* a_ptr(const FUnit& u) const { return A + (size_t)u.pm * 256 * lda_ * 2 + (size_t)u.pn * a_col_bytes_per_pn; }
  __device__ __forceinline__ void a_offs(const FUnit&, int, unsigned (&)[2][2]) const {}
  __device__ __forceinline__ const char* b_ptr(const FUnit& u) const { return Bt + (size_t)u.pn * 256 * ldb_ * 2; }
};

struct EpiProj {
  char* ws;
  __device__ __forceinline__ void operator()(const f32x4 (&acc)[2][2][4][2], const FUnit& u, int wr, int wc, int fr, int fq, int lane) const {
    const float* rs0 = (const float*)(ws + OFF_RS0);
    bf16_t* proj = (bf16_t*)(ws + OFF_R2);
    float scv[2][4];
#pragma unroll
    for (int ai = 0; ai < 2; ++ai)
#pragma unroll
      for (int m = 0; m < 4; ++m) scv[ai][m] = rs0[u.pm * 256 + ai * 128 + wr * 64 + m * 16 + fr];
#pragma unroll
    for (int ai = 0; ai < 2; ++ai)
#pragma unroll
      for (int m = 0; m < 4; ++m) {
        const int row = u.pm * 256 + ai * 128 + wr * 64 + m * 16 + fr;
        const float sc = scv[ai][m];
#pragma unroll
        for (int bj = 0; bj < 2; ++bj) {
          const int col0 = u.pn * 256 + bj * 128 + wc * 32 + fq * 8;
          const f32x4 v0 = acc[ai][bj][m][0] * sc, v1 = acc[ai][bj][m][1] * sc;
          u32x4 w4; w4.x = cvt_pk_bf16(v0[0], v0[1]); w4.y = cvt_pk_bf16(v0[2], v0[3]); w4.z = cvt_pk_bf16(v1[0], v1[1]); w4.w = cvt_pk_bf16(v1[2], v1[3]);
          *(u32x4*)(proj + (long)row * PROJ_LD + col0) = w4;
          if (u.pn == 7 && bj == 1 && wc == 1 && fq == 0) {
            float* d = (float*)(ws + OFF_DTRAW) + (long)row * 8;
            *(f32x4*)d = v0; *(f32x4*)(d + 4) = v1;
          }
          if (u.pn == 0 || (u.pn == 1 && bj == 0)) {
            float ss = v0[0] * v0[0] + v0[1] * v0[1] + v0[2] * v0[2] + v0[3] * v0[3] + v1[0] * v1[0] + v1[1] * v1[1] + v1[2] * v1[2] + v1[3] * v1[3];
            ss += sxor<16>(ss); ss += lane_get(ss, lane ^ 32);
            if (fq == 0) {
              if (u.pn == 0) ((float*)(ws + OFF_SSQ_Q))[row * 8 + bj * 4 + wc] = ss;
              else ((float*)(ws + OFF_SSQ_KV))[row * 4 + wc] = ss;
            }
          }
        }
      }
  }
};

template <int MODE>
struct EpiRes {
  char* ws; const float* xin; float* ssq; const float* pb; const float* psc; float f;
  __device__ __forceinline__ void operator()(const f32x4 (&acc)[2][2][4][2], const FUnit& u, int wr, int wc, int fr, int fq, int lane) const {
    bf16_t* xcb = (bf16_t*)(ws + OFF_XCB);
#pragma unroll
    for (int bj = 0; bj < 2; ++bj) {
      const int col0 = u.pn * 256 + bj * 128 + wc * 32 + fq * 8;
      f32x4 b0 = zero4(), b1 = b0, s0 = (f32x4){1.f, 1.f, 1.f, 1.f}, s1 = s0;
      if (MODE == 2) { b0 = *(const f32x4*)(pb + col0); b1 = *(const f32x4*)(pb + col0 + 4); s0 = *(const f32x4*)(psc + col0); s1 = *(const f32x4*)(psc + col0 + 4); }
      f32x4 base0[2][4], base1[2][4];
#pragma unroll
      for (int ai = 0; ai < 2; ++ai)
#pragma unroll
        for (int m = 0; m < 4; ++m) {
          const int row = u.pm * 256 + ai * 128 + wr * 64 + m * 16 + fr;
          if (MODE == 0) {
            const float* bp = xin + (long)row * 1024 + col0;
            base0[ai][m] = *(const f32x4*)bp; base1[ai][m] = *(const f32x4*)(bp + 4);
          } else {
            const u32x4 bu = *(const u32x4*)(xcb + (long)row * 1024 + col0);
            base0[ai][m] = (f32x4){bflo(bu.x), bfhi(bu.x), bflo(bu.y), bfhi(bu.y)};
            base1[ai][m] = (f32x4){bflo(bu.z), bfhi(bu.z), bflo(bu.w), bfhi(bu.w)};
          }
        }
#pragma unroll
      for (int ai = 0; ai < 2; ++ai)
#pragma unroll
        for (int m = 0; m < 4; ++m) {
          const int row = u.pm * 256 + ai * 128 + wr * 64 + m * 16 + fr;
          f32x4 a0 = acc[ai][bj][m][0], a1 = acc[ai][bj][m][1];
          if (MODE == 2) { a0 = (a0 + b0) * s0; a1 = (a1 + b1) * s1; }
          const float ff = (MODE == 0) ? 1.f : f;
          const f32x4 v0 = base0[ai][m] + a0 * ff, v1 = base1[ai][m] + a1 * ff;
          u32x4 w4; w4.x = cvt_pk_bf16(v0[0], v0[1]); w4.y = cvt_pk_bf16(v0[2], v0[3]); w4.z = cvt_pk_bf16(v1[0], v1[1]); w4.w = cvt_pk_bf16(v1[2], v1[3]);
          *(u32x4*)(xcb + (long)row * 1024 + col0) = w4;
          const float r0 = bflo(w4.x), r1 = bfhi(w4.x), r2 = bflo(w4.y), r3 = bfhi(w4.y), r4 = bflo(w4.z), r5 = bfhi(w4.z), r6 = bflo(w4.w), r7 = bfhi(w4.w);
          float ss = r0 * r0 + r1 * r1 + r2 * r2 + r3 * r3 + r4 * r4 + r5 * r5 + r6 * r6 + r7 * r7;
          ss += sxor<16>(ss); ss += lane_get(ss, lane ^ 32);
          if (fq == 0) ssq[row * 32 + (u.pn * 2 + bj) * 4 + wc] = ss;
        }
    }
  }
};

struct TJob { const float* src; int K, N; bf16_t* dst; int dst_ld, grp, grp_pad, goff; const float* gain; };
__device__ __forceinline__ void tstrip_load(const TJob& j, int tk, int tn, int t, float4 (&v)[8]) {
  const int k0 = tk * 64, n0 = tn * 256, c4 = (t & 63) * 4;
#pragma unroll
  for (int i = 0; i < 8; ++i) {
    const int r = (t >> 6) + 8 * i;
    float4 x = make_float4(0.f, 0.f, 0.f, 0.f);
    if (n0 + c4 < j.N) x = *(const float4*)(j.src + (long)(k0 + r) * j.N + n0 + c4);
    const float g = j.gain ? j.gain[k0 + r] : 1.f;
    v[i] = make_float4(x.x * g, x.y * g, x.z * g, x.w * g);
  }
}
__device__ __forceinline__ void tstrip_to_lds(int t, const float4 (&v)[8], float* tl) {
  const int c4 = (t & 63) * 4;
#pragma unroll
  for (int i = 0; i < 8; ++i) {
    const int r = (t >> 6) + 8 * i;
    tl[r * 257 + c4 + 0] = v[i].x; tl[r * 257 + c4 + 1] = v[i].y; tl[r * 257 + c4 + 2] = v[i].z; tl[r * 257 + c4 + 3] = v[i].w;
  }
}
__device__ __forceinline__ void tstrip_store(const TJob& j, int tk, int tn, int t, const float* tl) {
  const int k0 = tk * 64, n0 = tn * 256;
  const int n = n0 + (t >> 1);
  if (n < j.N) {
    const int drow = (n / j.grp) * j.grp_pad + j.goff + (n % j.grp);
    const int kk = (t & 1) * 32;
    bf16_t* d = j.dst + (long)drow * j.dst_ld + k0 + kk;
#pragma unroll
    for (int q = 0; q < 4; ++q) {
      unsigned u[4];
#pragma unroll
      for (int jj = 0; jj < 4; ++jj) u[jj] = pack2(tl[(kk + q * 8 + 2 * jj) * 257 + (t >> 1)], tl[(kk + q * 8 + 2 * jj + 1) * 257 + (t >> 1)]);
      *(uint4*)(d + q * 8) = make_uint4(u[0], u[1], u[2], u[3]);
    }
  }
}

constexpr int N_TJOBS = 5 + 4 + 6 + 192;
constexpr int N_TJOBS_PREP = 15;
__device__ __forceinline__ TJob get_tjob(int idx, const Ctx& c, char* ws) {
  constexpr int BIG = 1 << 30;
  TJob j;
  if (idx == 0) j = {INP(I_W_IN), 1024, 1960, (bf16_t*)(ws + OFF_WIN_T), 1024, BIG, 0, 0, INP(I_LN_MIX)};
  else if (idx == 1) j = {INP(I_W_UQ), 256, 768, (bf16_t*)(ws + OFF_WUQ_T), 256, 96, 128, 0, INP(I_QLAT_NORM)};
  else if (idx == 2) j = {INP(I_W_UKV), 128, 1024, (bf16_t*)(ws + OFF_WUKV_T), 256, BIG, 0, 0, INP(I_KVLAT_NORM)};
  else if (idx == 3) j = {INP(I_W_OUT), 512, 1024, (bf16_t*)(ws + OFF_WOUT_T), 1024, BIG, 0, 0, nullptr};
  else if (idx == 4) j = {INP(I_W_OUT) + 512 * 1024, 512, 1024, (bf16_t*)(ws + OFF_WOUT_T) + 512, 1024, BIG, 0, 0, INP(I_SSD_NORM)};
  else if (idx < 9) { const int g = idx - 5; j = {INP(I_POOL_W) + g * 65536, 256, 256, (bf16_t*)(ws + OFF_POOL_T) + g * 65536, 256, BIG, 0, 0, INP(I_LN_MIX) + 1024 + g * 256}; }
  else if (idx < 15) {
    const int l = (idx - 9) / 3, k = (idx - 9) % 3;
    if (k == 0) j = {INP(I_XQ_W) + l * 1024 * 256, 1024, 256, (bf16_t*)(ws + OFF_XQ_T) + l * 256 * 1024, 1024, BIG, 0, 0, INP(I_LN_XQ) + l * 1024};
    else if (k == 1) j = {INP(I_XKV_W) + l * 1024 * 512, 1024, 512, (bf16_t*)(ws + OFF_XKV_T) + l * 512 * 1024, 1024, BIG, 0, 0, INP(I_LN_MEM) + l * 1024};
    else j = {INP(I_XO_W) + l * 256 * 1024, 256, 1024, (bf16_t*)(ws + OFF_XO_T) + l * 1024 * 256, 256, BIG, 0, 0, nullptr};
  } else {
    const int le = (idx - 15) / 3, k = (idx - 15) % 3, l = le >> 5;
    const long wo = (long)le * 1024 * 256;
    if (k == 0) j = {INP(I_EXP_G) + wo, 1024, 256, (bf16_t*)(ws + OFF_WGU_T) + (long)le * 512 * 1024, 1024, 4, 8, 0, INP(I_LN_FFN) + l * 1024};
    else if (k == 1) j = {INP(I_EXP_U) + wo, 1024, 256, (bf16_t*)(ws + OFF_WGU_T) + (long)le * 512 * 1024, 1024, 4, 8, 4, INP(I_LN_FFN) + l * 1024};
    else j = {INP(I_EXP_D) + wo, 256, 1024, (bf16_t*)(ws + OFF_WD_T) + (long)le * 1024 * 256, 256, BIG, 0, 0, nullptr};
  }
  return j;
}

__device__ __forceinline__ void phase_prep(const Ctx& c) {
  char* ws = c.ws; char* smem = c.smem; const int bid = c.bid, nblk = c.nblk;
  float* tl = (float*)smem;
  {
    int ji = 0, base = 0, f = bid;
    TJob j = get_tjob(0, c, ws);
    int tilesN = (j.N + 255) / 256, ntiles = tilesN * (j.K / 64);
    float4 v[8];
    bool have = false; TJob jc = j; int tkc = 0, tnc = 0;
#define T_SEEK() { while (ji < N_TJOBS_PREP && f >= base + ntiles) { base += ntiles; ++ji; if (ji < N_TJOBS_PREP) { j = get_tjob(ji, c, ws); tilesN = (j.N + 255) / 256; ntiles = tilesN * (j.K / 64); } } }
    T_SEEK()
    if (ji < N_TJOBS_PREP) { jc = j; tkc = (f - base) / tilesN; tnc = (f - base) % tilesN; tstrip_load(jc, tkc, tnc, c.tid, v); have = true; }
    while (have) {
      tstrip_to_lds(c.tid, v, tl);
      __syncthreads();
      const TJob jd = jc; const int tkd = tkc, tnd = tnc;
      f += nblk;
      T_SEEK()
      have = ji < N_TJOBS_PREP;
      if (have) { jc = j; tkc = (f - base) / tilesN; tnc = (f - base) % tilesN; tstrip_load(jc, tkc, tnc, c.tid, v); }
      tstrip_store(jd, tkd, tnd, c.tid, tl);
      __syncthreads();
    }
#undef T_SEEK
  }
  {
    const int gt = bid * NTHR + c.tid, gn = nblk * NTHR;
    uint4 z = make_uint4(0, 0, 0, 0);
    bf16_t* w1 = (bf16_t*)(ws + OFF_WIN_T) + 1960l * 1024;
    for (int i = gt; i < 88 * 1024 / 8; i += gn) *(uint4*)(w1 + i * 8) = z;
    bf16_t* w2 = (bf16_t*)(ws + OFF_WUQ_T);
    for (int i = gt; i < 8 * 32 * 256 / 8; i += gn) {
      const int e = i * 8, h = e / (32 * 256), rem = e % (32 * 256);
      *(uint4*)(w2 + (long)(h * 128 + 96) * 256 + rem) = z;
    }
    bf16_t* w3 = (bf16_t*)(ws + OFF_WUKV_T);
    for (int i = gt; i < 1024 * 128 / 8; i += gn) *(uint4*)(w3 + (long)(i >> 4) * 256 + 128 + (i & 15) * 8) = z;
    if (gt < 128) ((int*)(ws + OFF_CTL))[gt] = 0;
    bf16_t* wr = (bf16_t*)(ws + OFF_WR);
    for (int i = gt; i < 2 * 48 * 1024; i += gn) {
      const int l = i / (48 * 1024), o = (i / 1024) % 48, k = i % 1024;
      float w = 0.f;
      if (o < 4) w = INP(I_RG_W)[(l * 1024 + k) * 4 + o];
      else if (o < 36) w = INP(I_RE_W)[(l * 1024 + k) * 32 + (o - 4)];
      const bf16_t hi = f2bf(w);
      wr[((l * 2 + 0) * 48 + o) * 1024 + k] = hi;
      wr[((l * 2 + 1) * 48 + o) * 1024 + k] = f2bf(w - bf2f(hi));
    }
  }
  {
    const int lane = c.tid & 63;
    const int gw = bid * NWAV + (c.tid >> 6), nw = nblk * NWAV;
    for (int row0 = gw * 2; row0 < NT + 4096; row0 += nw * 2) {
      float4 v[2][4];
#pragma unroll
      for (int q = 0; q < 2; ++q) {
        const int row = row0 + q; const bool ism = row >= NT; const int r = ism ? row - NT : row;
        const float* src = (ism ? INP(I_MEM) : INP(I_X)) + (long)r * 1024;
#pragma unroll
        for (int i = 0; i < 4; ++i) v[q][i] = *(const float4*)(src + i * 256 + lane * 4);
      }
#pragma unroll
      for (int q = 0; q < 2; ++q) {
        const int row = row0 + q; const bool ism = row >= NT; const int r = ism ? row - NT : row;
        bf16_t* dst = (bf16_t*)(ws + (ism ? OFF_MEMB : OFF_R1)) + (long)r * 1024;
        float ss = 0.f;
#pragma unroll
        for (int i = 0; i < 4; ++i) {
          const float4 x = v[q][i];
          ss += x.x * x.x + x.y * x.y + x.z * x.z + x.w * x.w;
          *(uint2*)(dst + i * 256 + lane * 4) = make_uint2(pack2(x.x, x.y), pack2(x.z, x.w));
        }
        ss = wave_sum(ss, lane);
        if (lane == 0) ((float*)(ws + (ism ? OFF_RSM : OFF_RS0)))[r] = rsqrtf(ss * (1.f / 1024.f) + EPS);
      }
    }
  }
}

__device__ __forceinline__ float cs_ssq(const float* crow, int n) {
  float ss = 0.f;
  for (int j = 0; j < n; j += 4) { const float4 c = *(const float4*)(crow + j); ss += c.x * c.x + c.y * c.y + c.z * c.z + c.w * c.w; }
  return ss;
}
__device__ __forceinline__ void cs_store_scaled(bf16_t* dst, const float* crow, int n, float sc, const float* g) {
  for (int j = 0; j < n; j += 8) {
    float4 a = *(const float4*)(crow + j), b = *(const float4*)(crow + j + 4);
    if (g) {
      const float4 ga = *(const float4*)(g + j), gb = *(const float4*)(g + j + 4);
      a.x *= ga.x; a.y *= ga.y; a.z *= ga.z; a.w *= ga.w; b.x *= gb.x; b.y *= gb.y; b.z *= gb.z; b.w *= gb.w;
    }
    *(uint4*)(dst + j) = make_uint4(pack2(a.x * sc, a.y * sc), pack2(a.z * sc, a.w * sc), pack2(b.x * sc, b.y * sc), pack2(b.z * sc, b.w * sc));
  }
}
__device__ __forceinline__ float row_rs32(const float* ssq, int row) {
  const float4* q = (const float4*)(ssq + (long)row * 32);
  float s = 0.f;
#pragma unroll
  for (int i = 0; i < 8; ++i) { const float4 v = q[i]; s += (v.x + v.y) + (v.z + v.w); }
  return rsqrtf(s * (1.f / 1024.f) + EPS);
}
__device__ __forceinline__ void rope_cs(float pos, int i, float& c, float& s) {
  const float ang = pos * exp2f(-(float)i * 0.8304820237218406f);
  float u = ang * 0.15915494309189535f;
  u -= rintf(u);
  c = __builtin_amdgcn_cosf(u);
  s = __builtin_amdgcn_sinf(u);
}


constexpr int XS_BASE = 128 * 1024, XS_PART = XS_BASE, XS_ROW = XS_BASE + 2 * 256 * 8 * 4;
__device__ __forceinline__ void xs_barrier() { asm volatile("s_waitcnt lgkmcnt(0)" ::: "memory"); __builtin_amdgcn_s_barrier(); asm volatile("" ::: "memory"); }
__device__ __forceinline__ void xs_put_parts(const f32x4 (&acc)[2][2][4][2], float* part, int wr, int wc, int fr, int fq, int lane) {
#pragma unroll
  for (int ai = 0; ai < 2; ++ai)
#pragma unroll
    for (int m = 0; m < 4; ++m)
#pragma unroll
      for (int bj = 0; bj < 2; ++bj) {
        const f32x4 a0 = acc[ai][bj][m][0], a1 = acc[ai][bj][m][1];
        float ss = a0[0] * a0[0] + a0[1] * a0[1] + a0[2] * a0[2] + a0[3] * a0[3] + a1[0] * a1[0] + a1[1] * a1[1] + a1[2] * a1[2] + a1[3] * a1[3];
        ss += sxor<16>(ss); ss += lane_get(ss, lane ^ 32);
        if (fq == 0) part[(ai * 128 + wr * 64 + m * 16 + fr) * 8 + bj * 4 + wc] = ss;
      }
}

struct EpiXq {
  char* ws; char* smem; const float* g; int tid; mutable int par;
  __device__ __forceinline__ void operator()(const f32x4 (&acc)[2][2][4][2], const FUnit& u, int wr, int wc, int fr, int fq, int lane) const {
    float* part = (float*)(smem + XS_PART) + par * 2048; float* rowsc = (float*)(smem + XS_ROW) + par * 512;
    if (tid < 256) rowsc[tid] = row_rs32((const float*)(ws + OFF_SSQA), u.pm * 256 + tid);
    xs_put_parts(acc, part, wr, wc, fr, fq, lane);
    xs_barrier();
    bf16_t* xq = (bf16_t*)(ws + OFF_XQ);
    const f32x4 g0 = *(const f32x4*)(g + (wc & 1) * 32 + fq * 8), g1 = *(const f32x4*)(g + (wc & 1) * 32 + fq * 8 + 4);
#pragma unroll
    for (int ai = 0; ai < 2; ++ai)
#pragma unroll
      for (int m = 0; m < 4; ++m) {
        const int rl = ai * 128 + wr * 64 + m * 16 + fr;
        const float rs = rowsc[rl];
#pragma unroll
        for (int bj = 0; bj < 2; ++bj) {
          const float ssh = (part[rl * 8 + bj * 4 + (wc & 2)] + part[rl * 8 + bj * 4 + (wc | 1)]) * rs * rs;
          const float sc = rsqrtf(ssh * (1.f / 64.f) + EPS) * rs * (0.125f * LOG2E);
          const f32x4 v0 = acc[ai][bj][m][0] * g0 * sc, v1 = acc[ai][bj][m][1] * g1 * sc;
          u32x4 w4; w4.x = cvt_pk_bf16(v0[0], v0[1]); w4.y = cvt_pk_bf16(v0[2], v0[3]); w4.z = cvt_pk_bf16(v1[0], v1[1]); w4.w = cvt_pk_bf16(v1[2], v1[3]);
          *(u32x4*)(xq + (long)(u.pm * 256 + rl) * 256 + bj * 128 + wc * 32 + fq * 8) = w4;
        }
      }
    par ^= 1;
  }
};

struct EpiQ {
  char* ws; char* smem; const float* g; const int* positions; int tid; mutable int par;
  __device__ __forceinline__ void operator()(const f32x4 (&acc)[2][2][4][2], const FUnit& u, int wr, int wc, int fr, int fq, int lane) const {
    float* part = (float*)(smem + XS_PART) + par * 2048; float* rowsc = (float*)(smem + XS_ROW) + par * 512;
    if (tid < 256) {
      const float* sq = (const float*)(ws + OFF_SSQ_Q) + (long)(u.pm * 256 + tid) * 8;
      rowsc[tid] = rsqrtf(((sq[0] + sq[1]) + (sq[2] + sq[3]) + (sq[4] + sq[5]) + (sq[6] + sq[7])) * (1.f / 256.f) + EPS);
    }
    xs_put_parts(acc, part, wr, wc, fr, fq, lane);
    xs_barrier();
    if (wc < 3) {
      bf16_t* qo = (bf16_t*)(ws + OFF_Q);
      const int c0 = wc * 32 + fq * 8;
      float posv[2][4];
#pragma unroll
      for (int ai = 0; ai < 2; ++ai)
#pragma unroll
        for (int m = 0; m < 4; ++m) posv[ai][m] = (wc == 2) ? (float)positions[u.pm * 256 + ai * 128 + wr * 64 + m * 16 + fr] : 0.f;
      const f32x4 g0 = *(const f32x4*)(g + c0), g1 = *(const f32x4*)(g + c0 + 4);
      const float qs = 0.10206207261596577f * LOG2E;
#pragma unroll
      for (int ai = 0; ai < 2; ++ai)
#pragma unroll
        for (int m = 0; m < 4; ++m) {
          const int rl = ai * 128 + wr * 64 + m * 16 + fr;
          const int row = u.pm * 256 + rl, b = row >> 12, sq_ = row & 4095;
          const float rq = rowsc[rl];
          float cs[8], sn[8];
          if (wc == 2) {
            const float pos = posv[ai][m];
#pragma unroll
            for (int j = 0; j < 8; ++j) rope_cs(pos, (fq & 1) * 8 + j, cs[j], sn[j]);
          }
#pragma unroll
          for (int bj = 0; bj < 2; ++bj) {
            const float ssh = (part[rl * 8 + bj * 4] + part[rl * 8 + bj * 4 + 1] + part[rl * 8 + bj * 4 + 2]) * rq * rq;
            const float sc = rsqrtf(ssh * (1.f / 96.f) + EPS) * rq * qs;
            f32x4 v0 = acc[ai][bj][m][0] * g0 * sc, v1 = acc[ai][bj][m][1] * g1 * sc;
            if (wc == 2) {
              float o[8];
#pragma unroll
              for (int j = 0; j < 8; ++j) {
                const float own = j < 4 ? v0[j] : v1[j - 4];
                const float oth = lane_get(own, lane ^ 32);
                o[j] = (fq < 2) ? (own * cs[j] - oth * sn[j]) : (own * cs[j] + oth * sn[j]);
              }
              v0 = (f32x4){o[0], o[1], o[2], o[3]}; v1 = (f32x4){o[4], o[5], o[6], o[7]};
            }
            u32x4 w4; w4.x = cvt_pk_bf16(v0[0], v0[1]); w4.y = cvt_pk_bf16(v0[2], v0[3]); w4.z = cvt_pk_bf16(v1[0], v1[1]); w4.w = cvt_pk_bf16(v1[2], v1[3]);
            *(u32x4*)(qo + ((long)(b * 8 + u.pn * 2 + bj) * 4096 + sq_) * 96 + c0) = w4;
          }
        }
    }
    par ^= 1;
  }
};

struct EpiKV {
  char* ws; char* smem; const float* g; const int* positions; int tid; mutable int par;
  __device__ __forceinline__ void operator()(const f32x4 (&acc)[2][2][4][2], const FUnit& u, int wr, int wc, int fr, int fq, int lane) const {
    float* part = (float*)(smem + XS_PART) + par * 2048; float* rowsc = (float*)(smem + XS_ROW) + par * 512;
    const bf16_t* proj = (const bf16_t*)(ws + OFF_R2);
    if (tid < 256) {
      const int row = u.pm * 256 + tid;
      const float* sk = (const float*)(ws + OFF_SSQ_KV) + (long)row * 4;
      rowsc[tid] = rsqrtf(((sk[0] + sk[1]) + (sk[2] + sk[3])) * (1.f / 128.f) + EPS);
      const bf16_t* kp = proj + (long)row * PROJ_LD + C_KROPE;
      float ss = 0.f;
#pragma unroll
      for (int j = 0; j < 32; j += 8) {
        const uint4 q4 = *(const uint4*)(kp + j);
        ss += bflo(q4.x) * bflo(q4.x) + bfhi(q4.x) * bfhi(q4.x) + bflo(q4.y) * bflo(q4.y) + bfhi(q4.y) * bfhi(q4.y)
            + bflo(q4.z) * bflo(q4.z) + bfhi(q4.z) * bfhi(q4.z) + bflo(q4.w) * bflo(q4.w) + bfhi(q4.w) * bfhi(q4.w);
      }
      rowsc[256 + tid] = ss;
    }
    xs_put_parts(acc, part, wr, wc, fr, fq, lane);
    xs_barrier();
    bf16_t* ko = (bf16_t*)(ws + OFF_K);
    bf16_t* vo = (bf16_t*)(ws + OFF_VT);
#pragma unroll
    for (int ai = 0; ai < 2; ++ai)
#pragma unroll
      for (int m = 0; m < 4; ++m) {
        const int rl = ai * 128 + wr * 64 + m * 16 + fr;
        const int row = u.pm * 256 + rl, b = row >> 12, sq_ = row & 4095;
        const float rkv = rowsc[rl], krs = rowsc[256 + rl];
        if (wc < 2) {
          const int c0 = wc * 32 + fq * 8;
          const f32x4 g0 = *(const f32x4*)(g + c0), g1 = *(const f32x4*)(g + c0 + 4);
#pragma unroll
          for (int bj = 0; bj < 2; ++bj) {
            const float ssh = (part[rl * 8 + bj * 4] + part[rl * 8 + bj * 4 + 1]) * rkv * rkv + krs;
            const float sc = rsqrtf(ssh * (1.f / 96.f) + EPS) * rkv;
            const f32x4 v0 = acc[ai][bj][m][0] * g0 * sc, v1 = acc[ai][bj][m][1] * g1 * sc;
            u32x4 w4; w4.x = cvt_pk_bf16(v0[0], v0[1]); w4.y = cvt_pk_bf16(v0[2], v0[3]); w4.z = cvt_pk_bf16(v1[0], v1[1]); w4.w = cvt_pk_bf16(v1[2], v1[3]);
            *(u32x4*)(ko + ((long)(b * 8 + u.pn * 2 + bj) * 4096 + sq_) * 96 + c0) = w4;
          }
        } else {
#pragma unroll
          for (int bj = 0; bj < 2; ++bj) {
            const f32x4 v0 = acc[ai][bj][m][0] * rkv, v1 = acc[ai][bj][m][1] * rkv;
            u32x4 w4; w4.x = cvt_pk_bf16(v0[0], v0[1]); w4.y = cvt_pk_bf16(v0[2], v0[3]); w4.z = cvt_pk_bf16(v1[0], v1[1]); w4.w = cvt_pk_bf16(v1[2], v1[3]);
            *(u32x4*)(vo + ((long)(b * 8 + u.pn * 2 + bj) * 4096 + sq_) * 64 + (wc - 2) * 32 + fq * 8) = w4;
          }
          const int hb = wc - 2;
          const float ssh = (part[rl * 8 + hb * 4] + part[rl * 8 + hb * 4 + 1]) * rkv * rkv + krs;
          const float r = rsqrtf(ssh * (1.f / 96.f) + EPS);
          const bf16_t* kp = proj + (long)row * PROJ_LD + C_KROPE;
          const int i0 = (fq & 1) * 8;
          const uint4 ua = *(const uint4*)(kp + i0), ub = *(const uint4*)(kp + 16 + i0);
          const float k1[8] = {bflo(ua.x), bfhi(ua.x), bflo(ua.y), bfhi(ua.y), bflo(ua.z), bfhi(ua.z), bflo(ua.w), bfhi(ua.w)};
          const float k2[8] = {bflo(ub.x), bfhi(ub.x), bflo(ub.y), bfhi(ub.y), bflo(ub.z), bfhi(ub.z), bflo(ub.w), bfhi(ub.w)};
          const float pos = (float)positions[row];
          float o[8];
#pragma unroll
          for (int j = 0; j < 8; ++j) {
            float cc, sn; rope_cs(pos, i0 + j, cc, sn);
            const float u1 = k1[j] * r * g[64 + i0 + j], u2 = k2[j] * r * g[80 + i0 + j];
            o[j] = (fq < 2) ? (u1 * cc - u2 * sn) : (u2 * cc + u1 * sn);
          }
          u32x4 w4; w4.x = cvt_pk_bf16(o[0], o[1]); w4.y = cvt_pk_bf16(o[2], o[3]); w4.z = cvt_pk_bf16(o[4], o[5]); w4.w = cvt_pk_bf16(o[6], o[7]);
          *(u32x4*)(ko + ((long)(b * 8 + u.pn * 2 + hb) * 4096 + sq_) * 96 + 64 + fq * 8) = w4;
        }
      }
    par ^= 1;
  }
};

__device__ __forceinline__ void phase_gemm_in(const Ctx& c) {
  char* ws = c.ws; char* smem = c.smem; const int bid = c.bid, nblk = c.nblk;
  {
    DenseOrder S; S.init(ws + OFF_R1, 1024, ws + OFF_WIN_T, 1024, NT, 2048, nblk, bid, 0);
    EpiProj E{ws};
    fast_gemm(( LAS3 unsigned char*)smem, S, E, 1024, c.tid);
  }
  __syncthreads();
  const int t = c.tid, er = t >> 1, eh = t & 1;
  const float* crow = (const float*)smem + er * CS_LD + eh * 64;
  for (int it = bid; it < 2 * 32 * 4; it += nblk) {
    const int l = it >> 7, mt = (it >> 2) & 31, nt = it & 3;
    gemm_dense((const bf16_t*)(ws + OFF_MEMB) + (long)mt * 128 * 1024, 1024,
               (const bf16_t*)(ws + OFF_XKV_T) + (long)l * 512 * 1024 + (long)nt * 128 * 1024, 1024, 1024, smem, c.tid);
    if (t < 256) {
      const int row = mt * 128 + er;
      const float sc = ((const float*)(ws + OFF_RSM))[row];
      if (nt < 2) {
        const int head = nt * 2 + eh;
        const float ss = cs_ssq(crow, 64) * sc * sc;
        const float r = rsqrtf(ss * (1.f / 64.f) + EPS) * sc;
        cs_store_scaled((bf16_t*)(ws + OFF_MEMK) + (long)l * 4096 * 256 + (long)row * 256 + head * 64, crow, 64, r, INP(I_XK_NORM) + l * 64);
      } else {
        const int head = (nt - 2) * 2 + eh;
        cs_store_scaled((bf16_t*)(ws + OFF_MEMVT) + (long)l * 4096 * 256 + (long)row * 256 + head * 64, crow, 64, sc, nullptr);
      }
    }
    __syncthreads();
  }
}

__device__ __forceinline__ void phase_up(const Ctx& c) {
  char* ws = c.ws; char* smem = c.smem; const int bid = c.bid, nblk = c.nblk; (void)smem; (void)bid; (void)nblk;
  const int t = c.tid;
  const bf16_t* proj = (const bf16_t*)(ws + OFF_R2);
  const int* positions = (const int*)c.p.in[opq(I_POS)];
  {
    DenseOrder S; S.init(ws + OFF_R2 + C_QLAT * 2, PROJ_LD, ws + OFF_WUQ_T, 256, NT, 1024, nblk, bid, 0);
    EpiQ E{ws, smem, INP(I_Q_NORM), positions, c.tid, 0};
    fast_gemm((LAS3 unsigned char*)smem, S, E, 256, c.tid);
  }
  {
    DenseOrder S; S.init(ws + OFF_R2 + C_KVLAT * 2, PROJ_LD, ws + OFF_WUKV_T, 256, NT, 1024, nblk, bid, 0);
    EpiKV E{ws, smem, INP(I_K_NORM), positions, c.tid, 0};
    fast_gemm((LAS3 unsigned char*)smem, S, E, 256, c.tid);
  }
  {
    const float* cw = INP(I_CONV_W);
    const float* cb = INP(I_CONV_B);
    bf16_t* xc = (bf16_t*)(ws + OFF_R4);
    const int ch = (t & 127) * 8, sub = t >> 7;
    float w0[8], w1[8], w2[8], w3[8], bs[8];
#pragma unroll
    for (int j = 0; j < 8; ++j) { w0[j] = cw[ch + j]; w1[j] = cw[1024 + ch + j]; w2[j] = cw[2048 + ch + j]; w3[j] = cw[3072 + ch + j]; bs[j] = cb[ch + j]; }
    for (int tb = bid; tb < NT / 256; tb += nblk) {
      const int tok0 = tb * 256 + sub * 64;
      const int s0 = tok0 & 4095;
      const bf16_t* src = proj + (long)tok0 * PROJ_LD + C_XBC + ch;
      float r0[8], r1[8], r2[8];
      {
        uint4 u0 = make_uint4(0, 0, 0, 0), u1 = u0, u2 = u0;
        if (s0 >= 3) u0 = *(const uint4*)(src - 3 * PROJ_LD);
        if (s0 >= 2) u1 = *(const uint4*)(src - 2 * PROJ_LD);
        if (s0 >= 1) u2 = *(const uint4*)(src - 1 * PROJ_LD);
        r0[0] = bflo(u0.x); r0[1] = bfhi(u0.x); r0[2] = bflo(u0.y); r0[3] = bfhi(u0.y); r0[4] = bflo(u0.z); r0[5] = bfhi(u0.z); r0[6] = bflo(u0.w); r0[7] = bfhi(u0.w);
        r1[0] = bflo(u1.x); r1[1] = bfhi(u1.x); r1[2] = bflo(u1.y); r1[3] = bfhi(u1.y); r1[4] = bflo(u1.z); r1[5] = bfhi(u1.z); r1[6] = bflo(u1.w); r1[7] = bfhi(u1.w);
        r2[0] = bflo(u2.x); r2[1] = bfhi(u2.x); r2[2] = bflo(u2.y); r2[3] = bfhi(u2.y); r2[4] = bflo(u2.z); r2[5] = bfhi(u2.z); r2[6] = bflo(u2.w); r2[7] = bfhi(u2.w);
      }
      for (int i0 = 0; i0 < 64; i0 += 8) {
        uint4 un[8];
#pragma unroll
        for (int q = 0; q < 8; ++q) un[q] = *(const uint4*)(src + (long)(i0 + q) * PROJ_LD);
#pragma unroll
        for (int q = 0; q < 8; ++q) {
          const float cur[8] = {bflo(un[q].x), bfhi(un[q].x), bflo(un[q].y), bfhi(un[q].y), bflo(un[q].z), bfhi(un[q].z), bflo(un[q].w), bfhi(un[q].w)};
          float a[8];
#pragma unroll
          for (int j = 0; j < 8; ++j) {
            a[j] = silu_f(bs[j] + w0[j] * r0[j] + w1[j] * r1[j] + w2[j] * r2[j] + w3[j] * cur[j]);
            r0[j] = r1[j]; r1[j] = r2[j]; r2[j] = cur[j];
          }
          *(uint4*)(xc + (long)(tok0 + i0 + q) * 1024 + ch) = make_uint4(pack2(a[0], a[1]), pack2(a[2], a[3]), pack2(a[4], a[5]), pack2(a[6], a[7]));
        }
      }
    }
    const long gt = (long)bid * NTHR + t, gn = (long)nblk * NTHR;
    const float* dtr = (const float*)(ws + OFF_DTRAW);
    float* dt = (float*)(ws + OFF_DT);
    for (long i = gt; i < (long)NT * 8; i += gn) {
      const float x = dtr[i] + INP(I_DT_BIAS)[i & 7];
      dt[i] = x > 20.f ? x : log1pf(__expf(x));
    }
  }
}

typedef float f32x16 __attribute__((ext_vector_type(16)));
__device__ __forceinline__ f32x16 mfma32(bf16x8 a, bf16x8 b, f32x16 c) { return __builtin_amdgcn_mfma_f32_32x32x16_bf16(a, b, c, 0, 0, 0); }
template <int DQK, bool CAUSAL>
__device__ __forceinline__ void attn_block(const bf16_t* Q, long ldq, const bf16_t* K, long ldk, const bf16_t* V, long ldv, int ntiles, int q0,
                           bf16_t* O, long ldo, char* smem, int tid) {
  constexpr int KLD = DQK + 8, VLD = 160, NK16 = DQK / 16, KCH = DQK / 8;
  constexpr int KBUF = 64 * KLD + 64 * VLD;
  constexpr int NKC = (64 * KCH + NTHR - 1) / NTHR;
  const int t = tid, lane = t & 63, w = t >> 6, l31 = lane & 31, hh = lane >> 5, l15 = lane & 15;
  bf16_t* KV = (bf16_t*)smem;
  bf16x8 qf[NK16];
#pragma unroll
  for (int ks = 0; ks < NK16; ++ks) qf[ks] = *(const bf16x8*)(Q + (long)(w * 32 + l31) * ldq + ks * 16 + hh * 8);
  f32x16 oacc[2];
#pragma unroll
  for (int dt = 0; dt < 2; ++dt)
#pragma unroll
    for (int i = 0; i < 16; ++i) oacc[dt][i] = 0.f;
  float mrow = -1e30f, lrow = 0.f;
  u32x4 kr[NKC], vr;
  const int vrow = t >> 3, vcc = t & 7;
#define A_LOAD(KT) { \
    _Pragma("unroll") for (int i = 0; i < NKC; ++i) { const int c_ = t + NTHR * i; if (c_ < 64 * KCH) kr[i] = *(const u32x4*)(K + (long)((KT) * 64 + c_ / KCH) * ldk + (c_ % KCH) * 8); } \
    vr = *(const u32x4*)(V + (long)((KT) * 64 + vrow) * ldv + vcc * 8); }
#define A_STORE(ST) { bf16_t* Kd_ = KV + (ST) * KBUF; bf16_t* Vd_ = Kd_ + 64 * KLD; \
    _Pragma("unroll") for (int i = 0; i < NKC; ++i) { const int c_ = t + NTHR * i; if (c_ < 64 * KCH) *(u32x4*)(Kd_ + (c_ / KCH) * KLD + (c_ % KCH) * 8) = kr[i]; } \
    *(u32x4*)(Vd_ + vrow * VLD + vcc * 8) = vr; }
  A_LOAD(0)
  A_STORE(0)
  if (ntiles > 1) A_LOAD(1)
  __syncthreads();
  const int qrow = q0 + w * 32 + l31;
  for (int kt = 0; kt < ntiles; ++kt) {
    const bf16_t* Ks = KV + (kt & 1) * KBUF;
    const bf16_t* Vs = Ks + 64 * KLD;
    f32x16 sacc[2];
#pragma unroll
    for (int T = 0; T < 2; ++T) {
#pragma unroll
      for (int i = 0; i < 16; ++i) sacc[T][i] = 0.f;
#pragma unroll
      for (int ks = 0; ks < NK16; ++ks) {
        const bf16x8 kf = *(const bf16x8*)(Ks + (T * 32 + l31) * KLD + ks * 16 + hh * 8);
        sacc[T] = mfma32(kf, qf[ks], sacc[T]);
      }
    }
    if (CAUSAL && (kt * 64 + 63 > q0 + w * 32)) {
#pragma unroll
      for (int T = 0; T < 2; ++T)
#pragma unroll
        for (int i = 0; i < 16; ++i) {
          const int key = kt * 64 + T * 32 + (i & 3) + 8 * (i >> 2) + 4 * hh;
          if (key > qrow) sacc[T][i] = -1e30f;
        }
    }
    float mx = sacc[0][0];
#pragma unroll
    for (int T = 0; T < 2; ++T)
#pragma unroll
      for (int i = 0; i < 16; ++i) mx = fmaxf(mx, sacc[T][i]);
    mx = fmaxf(mx, lane_get(mx, lane ^ 32));
    const float mn = fmaxf(mrow, mx);
    const float alpha = __builtin_amdgcn_exp2f(mrow - mn);
    mrow = mn;
    float ps = 0.f;
#pragma unroll
    for (int T = 0; T < 2; ++T)
#pragma unroll
      for (int i = 0; i < 16; ++i) { const float pv = __builtin_amdgcn_exp2f(sacc[T][i] - mn); sacc[T][i] = pv; ps += pv; }
    lrow = lrow * alpha + ps;
#pragma unroll
    for (int dt = 0; dt < 2; ++dt)
#pragma unroll
      for (int i = 0; i < 16; ++i) oacc[dt][i] *= alpha;
#pragma unroll
    for (int T = 0; T < 2; ++T)
#pragma unroll
      for (int s2 = 0; s2 < 2; ++s2) {
        union { unsigned u[4]; bf16x8 v; } pf;
#pragma unroll
        for (int j = 0; j < 4; ++j) pf.u[j] = cvt_pk_bf16(sacc[T][8 * s2 + 2 * j], sacc[T][8 * s2 + 2 * j + 1]);
        const int kb = T * 32 + 16 * s2 + 4 * hh + (l15 >> 2);
#pragma unroll
        for (int dt = 0; dt < 2; ++dt) {
          const bf16_t* vp = Vs + kb * VLD + dt * 32 + 16 * ((lane >> 4) & 1) + 4 * (l15 & 3);
          const s16x4 va = __builtin_amdgcn_ds_read_tr16_b64_v4i16((__attribute__((address_space(3))) s16x4*)vp);
          const s16x4 vb = __builtin_amdgcn_ds_read_tr16_b64_v4i16((__attribute__((address_space(3))) s16x4*)(vp + 8 * VLD));
          const bf16x8 vf = (bf16x8){va[0], va[1], va[2], va[3], vb[0], vb[1], vb[2], vb[3]};
          oacc[dt] = mfma32(vf, pf.v, oacc[dt]);
        }
      }
    if (kt + 1 < ntiles) {
      A_STORE((kt + 1) & 1)
      if (kt + 2 < ntiles) A_LOAD(kt + 2)
    }
    __syncthreads();
  }
#undef A_LOAD
#undef A_STORE
  lrow += lane_get(lrow, lane ^ 32);
  const float inv = 1.f / lrow;
  bf16_t* orow = O + (long)(w * 32 + l31) * ldo;
#pragma unroll
  for (int dt = 0; dt < 2; ++dt)
#pragma unroll
    for (int g4 = 0; g4 < 4; ++g4) {
      uint2 o2;
      o2.x = cvt_pk_bf16(oacc[dt][4 * g4] * inv, oacc[dt][4 * g4 + 1] * inv);
      o2.y = cvt_pk_bf16(oacc[dt][4 * g4 + 2] * inv, oacc[dt][4 * g4 + 3] * inv);
      *(uint2*)(orow + dt * 32 + 8 * g4 + 4 * hh) = o2;
    }
}

__device__ __forceinline__ void ssd_item(const Ctx& c, int b, int h) {
  char* ws = c.ws; char* smem = c.smem;
  const int t = c.tid, lane = t & 63, w = t >> 6, l15 = lane & 15, lq = lane >> 4;
  const int g = h >> 2;
  const int pw = w & 3, nq = (w >> 2) * 4;
  bf16_t* Cl = (bf16_t*)smem;
  bf16_t* Bl = Cl + 128 * 136;
  bf16_t* Ml = Bl + 128 * 136;
  bf16_t* Sl = Ml + 128 * 136;
  bf16_t* Xl = Sl + 64 * 136;
  float* fa = (float*)(Xl + 128 * 72);
  const bf16_t* xc = (const bf16_t*)(ws + OFF_R4);
  const bf16_t* proj = (const bf16_t*)(ws + OFF_R2);
  const float* dtp = (const float*)(ws + OFF_DT);
  bf16_t* AY = (bf16_t*)(ws + OFF_R1);
  const float a_h = -__expf(INP(I_A_LOG)[h]);
  const float dsk = INP(I_D_SKIP)[h];
  f32x4 st[4];
#pragma unroll
  for (int i = 0; i < 4; ++i) st[i] = zero4();
  u32x4 pc[4], pb[4], px[2]; float pd[2], pa0 = 0.f, pa1 = 0.f;
  u32x4 ox[2], oz[2];
#define S_LOAD(CK) { const long tn_ = (long)b * 4096 + (CK) * 128; \
    _Pragma("unroll") for (int i = 0; i < 4; ++i) { const int ch = t + NTHR * i, r = ch >> 4, cc = ch & 15; \
      pc[i] = *(const u32x4*)(xc + (tn_ + r) * 1024 + 768 + g * 128 + cc * 8); pb[i] = *(const u32x4*)(xc + (tn_ + r) * 1024 + 512 + g * 128 + cc * 8); } \
    _Pragma("unroll") for (int i = 0; i < 2; ++i) { const int ch = t + NTHR * i, r = ch >> 3, cc = ch & 7; \
      px[i] = *(const u32x4*)(xc + (tn_ + r) * 1024 + h * 64 + cc * 8); pd[i] = dtp[(tn_ + r) * 8 + h]; } \
    if (w == 0) { pa0 = dtp[(tn_ + 2 * lane) * 8 + h]; pa1 = dtp[(tn_ + 2 * lane + 1) * 8 + h]; } }
#define O_LOAD(CK) { const long tk_ = (long)b * 4096 + (CK) * 128 + w * 16 + (lane >> 2); const int sg_ = (lane & 3) * 16; \
    _Pragma("unroll") for (int j = 0; j < 2; ++j) { ox[j] = *(const u32x4*)(xc + tk_ * 1024 + h * 64 + sg_ + j * 8); oz[j] = *(const u32x4*)(proj + tk_ * PROJ_LD + C_Z + h * 64 + sg_ + j * 8); } }
  S_LOAD(0)
  O_LOAD(0)
  for (int ck = 0; ck < 32; ++ck) {
    const long t0 = (long)b * 4096 + ck * 128;
#pragma unroll
    for (int i = 0; i < 4; ++i) {
      const int ch = t + NTHR * i, r = ch >> 4, cc = ch & 15;
      *(u32x4*)(Cl + r * 136 + cc * 8) = pc[i];
      *(u32x4*)(Bl + r * 136 + cc * 8) = pb[i];
    }
#pragma unroll
    for (int i = 0; i < 2; ++i) {
      const int ch = t + NTHR * i, r = ch >> 3, cc = ch & 7;
      const u32x4 u = px[i]; const float d = pd[i];
      *(uint4*)(Xl + r * 72 + cc * 8) = make_uint4(pack2(bflo(u.x) * d, bfhi(u.x) * d), pack2(bflo(u.y) * d, bfhi(u.y) * d),
                                                   pack2(bflo(u.z) * d, bfhi(u.z) * d), pack2(bflo(u.w) * d, bfhi(u.w) * d));
    }
    if (w == 0) {
      const float a0 = pa0 * a_h, a1 = pa1 * a_h;
      const float pr = a0 + a1;
      float sc = pr;
#pragma unroll
      for (int o = 1; o < 64; o <<= 1) { const float n = lane_get(sc, (lane - o) & 63); if (lane >= o) sc += n; }
      const float alast = __int_as_float(__builtin_amdgcn_readlane(__float_as_int(sc), 63));
      const float c0 = sc - pr + a0, c1 = sc;
      fa[2 * lane] = c0; fa[2 * lane + 1] = c1;
      fa[128 + 2 * lane] = __expf(c0); fa[128 + 2 * lane + 1] = __expf(c1);
      fa[256 + 2 * lane] = __expf(alast - c0); fa[256 + 2 * lane + 1] = __expf(alast - c1);
    }
#pragma unroll
    for (int i = 0; i < 4; ++i)
#pragma unroll
      for (int r = 0; r < 4; ++r) Sl[(pw * 16 + lq * 4 + r) * 136 + (nq + i) * 16 + l15] = f2bf(st[i][r]);
    __syncthreads();
    if (ck + 1 < 32) S_LOAD(ck + 1)
    __builtin_amdgcn_sched_barrier(0);
    bf16x8 cf[4];
#pragma unroll
    for (int ks = 0; ks < 4; ++ks) cf[ks] = *(const bf16x8*)(Cl + (w * 16 + l15) * 136 + ks * 32 + lq * 8);
    f32x4 yacc[4];
#pragma unroll
    for (int pt = 0; pt < 4; ++pt) {
      yacc[pt] = zero4();
      if (ck > 0) {
#pragma unroll
        for (int ks = 0; ks < 4; ++ks) {
          const bf16x8 sf = *(const bf16x8*)(Sl + (pt * 16 + l15) * 136 + ks * 32 + lq * 8);
          yacc[pt] = mfma16(cf[ks], sf, yacc[pt]);
        }
#pragma unroll
        for (int r = 0; r < 4; ++r) yacc[pt][r] *= fa[128 + w * 16 + lq * 4 + r];
      }
    }
#pragma unroll
    for (int stl = 0; stl < 8; ++stl) {
      if (stl <= w) {
        f32x4 gacc = zero4();
#pragma unroll
        for (int ks = 0; ks < 4; ++ks) {
          const bf16x8 bfv = *(const bf16x8*)(Bl + (stl * 16 + l15) * 136 + ks * 32 + lq * 8);
          gacc = mfma16(cf[ks], bfv, gacc);
        }
#pragma unroll
        for (int r = 0; r < 4; ++r) {
          const int tt = w * 16 + lq * 4 + r, ss = stl * 16 + l15;
          float m = 0.f;
          if (ss <= tt) m = gacc[r] * __expf(fa[tt] - fa[ss]);
          Ml[tt * 136 + ss] = f2bf(m);
        }
      } else if (stl <= (w | 1)) {
#pragma unroll
        for (int r = 0; r < 4; ++r) Ml[(w * 16 + lq * 4 + r) * 136 + stl * 16 + l15] = 0;
      }
    }
    __builtin_amdgcn_fence(__ATOMIC_RELEASE, "wavefront");
    __builtin_amdgcn_wave_barrier();
    __builtin_amdgcn_fence(__ATOMIC_ACQUIRE, "wavefront");
#pragma unroll
    for (int ks = 0; ks < 4; ++ks) {
      if (ks * 32 <= w * 16 + 15) {
        const bf16x8 mf = *(const bf16x8*)(Ml + (w * 16 + l15) * 136 + ks * 32 + lq * 8);
#pragma unroll
        for (int pt = 0; pt < 4; ++pt) {
          const bf16x8 xf = tr_frag(Xl, 72, ks * 32, pt * 16, l15, lq);
          yacc[pt] = mfma16(mf, xf, yacc[pt]);
        }
      }
    }
    {
      __builtin_amdgcn_fence(__ATOMIC_RELEASE, "wavefront");
      __builtin_amdgcn_wave_barrier();
      float* Yf = (float*)(Ml + (w * 16) * 136);
#pragma unroll
      for (int pt = 0; pt < 4; ++pt)
#pragma unroll
        for (int r = 0; r < 4; ++r) Yf[(lq * 4 + r) * 68 + pt * 16 + l15] = yacc[pt][r];
      __builtin_amdgcn_fence(__ATOMIC_RELEASE, "wavefront");
      __builtin_amdgcn_wave_barrier();
      __builtin_amdgcn_fence(__ATOMIC_ACQUIRE, "wavefront");
      const int rr = lane >> 2, seg = (lane & 3) * 16;
      const long tok = t0 + w * 16 + rr;
      bf16_t* op = AY + tok * 1024 + 512 + h * 64 + seg;
#pragma unroll
      for (int j = 0; j < 2; ++j) {
        const u32x4 xu = ox[j], zu = oz[j];
        const float4 ya = *(const float4*)(Yf + rr * 68 + seg + j * 8), yb = *(const float4*)(Yf + rr * 68 + seg + j * 8 + 4);
        const float xf_[8] = {bflo(xu.x), bfhi(xu.x), bflo(xu.y), bfhi(xu.y), bflo(xu.z), bfhi(xu.z), bflo(xu.w), bfhi(xu.w)};
        const float zf_[8] = {bflo(zu.x), bfhi(zu.x), bflo(zu.y), bfhi(zu.y), bflo(zu.z), bfhi(zu.z), bflo(zu.w), bfhi(zu.w)};
        const float yf_[8] = {ya.x, ya.y, ya.z, ya.w, yb.x, yb.y, yb.z, yb.w};
        float o[8];
#pragma unroll
        for (int e = 0; e < 8; ++e) o[e] = (yf_[e] + xf_[e] * dsk) * silu_f(zf_[e]);
        *(uint4*)(op + j * 8) = make_uint4(pack2(o[0], o[1]), pack2(o[2], o[3]), pack2(o[4], o[5]), pack2(o[6], o[7]));
      }
      if (ck + 1 < 32) O_LOAD(ck + 1)
    }
    if (ck + 1 < 32) {
      const float dec = fa[128 + 127];
#pragma unroll
      for (int i = 0; i < 4; ++i)
#pragma unroll
        for (int r = 0; r < 4; ++r) st[i][r] *= dec;
#pragma unroll
      for (int ks = 0; ks < 4; ++ks) {
        const bf16x8 xr = tr_frag(Xl, 72, ks * 32, pw * 16, l15, lq);
        bf16x8 xf;
#pragma unroll
        for (int j = 0; j < 8; ++j) xf[j] = (short)f2bf(bf2f((bf16_t)xr[j]) * fa[256 + ks * 32 + lq * 8 + j]);
#pragma unroll
        for (int i = 0; i < 4; ++i) {
          const bf16x8 bfv = tr_frag(Bl, 136, ks * 32, (nq + i) * 16, l15, lq);
          st[i] = mfma16(xf, bfv, st[i]);
        }
      }
    }
    __syncthreads();
  }
#undef S_LOAD
#undef O_LOAD
}

__device__ __forceinline__ void wconv_item(const Ctx& c, int it) {
  float* tl = (float*)c.smem;
  float4 v[8];
  int f = it * 12;
  TJob jc = get_tjob(15 + (f >> 4), c, c.ws);
  int tilesN = (jc.N + 255) / 256;
  tstrip_load(jc, (f & 15) / tilesN, (f & 15) % tilesN, c.tid, v);
  for (int q = 0; q < 12; ++q) {
    tstrip_to_lds(c.tid, v, tl);
    __syncthreads();
    const TJob jd = jc; const int sd = f & 15, tnd = tilesN;
    ++f;
    if (q + 1 < 12) { jc = get_tjob(15 + (f >> 4), c, c.ws); tilesN = (jc.N + 255) / 256; tstrip_load(jc, (f & 15) / tilesN, (f & 15) % tilesN, c.tid, v); }
    tstrip_store(jd, sd / tnd, sd % tnd, c.tid, tl);
    __syncthreads();
  }
}

__device__ __forceinline__ void phase_mix(const Ctx& c0) {
  int* sitem = (int*)(c0.smem + SMEM_MAIN);
  int* qctr = (int*)(c0.ws + OFF_CTL) + CTL_QCTR + c0.pass;
  const int n_items = 128 + 2048 + 256;
  for (;;) {
    int tid = c0.tid; asm volatile("" : "+v"(tid));
    size_t wz = 0; asm volatile("" : "+s"(wz));
    char* ws = c0.ws + wz;
    const Ctx c{c0.p, ws, c0.smem, tid, c0.bid, c0.nblk, c0.f, c0.pass};
    char* smem = c.smem;
    if (tid == 0) *sitem = atomicAdd(qctr, 1);
    __syncthreads();
    const int item = *sitem;
    __syncthreads();
    if (item >= n_items) break;
    if (item < 128) {
      ssd_item(c, item >> 3, item & 7);
    } else {
      const int i2 = item - 128;
      if (i2 % 9 == 8) {
        wconv_item(c, i2 / 9);
      } else {
        const int it = i2 - i2 / 9;
        const int qb = 15 - (it >> 7), bh = it & 127;
        const bf16_t* Q = (const bf16_t*)(ws + OFF_Q) + ((long)bh * 4096 + qb * 256) * 96;
        const bf16_t* K = (const bf16_t*)(ws + OFF_K) + (long)bh * 4096 * 96;
        const bf16_t* Vv = (const bf16_t*)(ws + OFF_VT) + (long)bh * 4096 * 64;
        const int b = bh >> 3, h = bh & 7;
        bf16_t* O = (bf16_t*)(ws + OFF_R1) + ((long)b * 4096 + qb * 256) * 1024 + h * 64;
        attn_block<96, true>(Q, 96, K, 96, Vv, 64, 4 * qb + 4, qb * 256, O, 1024, smem, c.tid);
      }
    }
  }
}

__device__ __forceinline__ void phase_ynorm(const Ctx& c) {
  bf16_t* AY = (bf16_t*)(c.ws + OFF_R1);
  const int bid = c.bid, nblk = c.nblk;
  const int lane = c.tid & 63;
  const int gw = bid * NWAV + (c.tid >> 6), nw = nblk * NWAV;
  for (int row0 = gw * 4; row0 < NT; row0 += nw * 4) {
    uint4 u[4];
#pragma unroll
    for (int q = 0; q < 4; ++q) u[q] = *(const uint4*)(AY + (long)(row0 + q) * 1024 + 512 + lane * 8);
#pragma unroll
    for (int q = 0; q < 4; ++q) {
      float v[8] = {bflo(u[q].x), bfhi(u[q].x), bflo(u[q].y), bfhi(u[q].y), bflo(u[q].z), bfhi(u[q].z), bflo(u[q].w), bfhi(u[q].w)};
      float ss = 0.f;
#pragma unroll
      for (int j = 0; j < 8; ++j) ss += v[j] * v[j];
      ss = wave_sum(ss, lane);
      const float r = rsqrtf(ss * (1.f / 512.f) + EPS);
      *(uint4*)(AY + (long)(row0 + q) * 1024 + 512 + lane * 8) = make_uint4(pack2(v[0] * r, v[1] * r), pack2(v[2] * r, v[3] * r), pack2(v[4] * r, v[5] * r), pack2(v[6] * r, v[7] * r));
    }
  }
}

__device__ __forceinline__ void phase_gemm_out(const Ctx& c) {
  char* ws = c.ws;
  DenseOrder S; S.init(ws + OFF_R1, 1024, ws + OFF_WOUT_T, 1024, NT, 1024, c.nblk, c.bid, 0);
  EpiRes<0> E{ws, INP(I_X), (float*)(ws + OFF_SSQA), nullptr, nullptr, 1.f};
  fast_gemm((LAS3 unsigned char*)c.smem, S, E, 1024, c.tid);
}

__device__ __forceinline__ void phase_pool_gemm(const Ctx& c) {
  char* ws = c.ws;
  DenseOrder S; S.init(ws + OFF_R1, 1024, ws + OFF_POOL_T, 256, NT, 1024, c.nblk, c.bid, 512);
  EpiRes<2> E{ws, nullptr, (float*)(ws + OFF_SSQA), INP(I_POOL_B), INP(I_POOL_SCALE), c.f};
  fast_gemm((LAS3 unsigned char*)c.smem, S, E, 256, c.tid);
}

__device__ __forceinline__ void phase_xq(const Ctx& c, int l) {
  char* ws = c.ws;
  DenseOrder S; S.init(ws + OFF_XCB, 1024, ws + OFF_XQ_T + (size_t)l * 256 * 1024 * 2, 1024, NT, 256, c.nblk, c.bid, 0);
  EpiXq E{ws, c.smem, INP(I_XQ_NORM) + l * 64, c.tid, 0};
  fast_gemm((LAS3 unsigned char*)c.smem, S, E, 1024, c.tid);
}

__device__ __forceinline__ void phase_xattn(const Ctx& c, int l) {
  char* ws = c.ws; char* smem = c.smem; const int bid = c.bid, nblk = c.nblk; (void)smem; (void)bid; (void)nblk;
  for (int item = bid; item < 256 * 4; item += nblk) {
    const int mt = item >> 2, h = item & 3;
    const int b = mt >> 4;
    const bf16_t* Q = (const bf16_t*)(ws + OFF_XQ) + (long)mt * 256 * 256 + h * 64;
    const bf16_t* K = (const bf16_t*)(ws + OFF_MEMK) + (long)l * 4096 * 256 + (long)b * 256 * 256 + h * 64;
    const bf16_t* Vv = (const bf16_t*)(ws + OFF_MEMVT) + (long)l * 4096 * 256 + (long)b * 256 * 256 + h * 64;
    bf16_t* O = (bf16_t*)(ws + OFF_XO) + (long)mt * 256 * 256 + h * 64;
    attn_block<64, false>(Q, 256, K, 256, Vv, 256, 4, 0, O, 256, smem, c.tid);
  }
}

__device__ __forceinline__ void phase_xo(const Ctx& c, int l) {
  char* ws = c.ws;
  DenseOrder S; S.init(ws + OFF_XO, 256, ws + OFF_XO_T + (size_t)l * 1024 * 256 * 2, 256, NT, 1024, c.nblk, c.bid, 0);
  EpiRes<1> E{ws, nullptr, (float*)(ws + OFF_SSQB), nullptr, nullptr, c.f};
  fast_gemm((LAS3 unsigned char*)c.smem, S, E, 256, c.tid);
}

__device__ __forceinline__ void phase_router(const Ctx& c, int l) {
  char* ws = c.ws; char* smem = c.smem; const int bid = c.bid, nblk = c.nblk;
  const int t = c.tid, lane = t & 63, w = t >> 6, l15 = lane & 15, lq = lane >> 4;
  bf16_t* Ah = (bf16_t*)smem;
  bf16_t* Al = Ah + 128 * 72;
  bf16_t* Wh = Al + 128 * 72;
  bf16_t* Wl = Wh + 48 * 72;
  float* rsl = (float*)(Wl + 48 * 72);
  float* lg = rsl + 128;
  const float* lnf = INP(I_LN_FFN) + l * 1024;
  const bf16_t* wrh = (const bf16_t*)(ws + OFF_WR) + (size_t)(l * 2) * 48 * 1024;
  const bf16_t* wrl = wrh + 48 * 1024;
  int* cnt = (int*)(ws + OFF_CTL) + CTL_CNT + l * 32;
  int* list = (int*)(ws + OFF_LIST);
  float* gate = (float*)(ws + OFF_GATE);
  for (int item = bid; item < NT / 128; item += nblk) {
    const int tok0 = item * 128;
    if (t < 128) {
      const float r = row_rs32((const float*)(ws + OFF_SSQB), tok0 + t);
      rsl[t] = r; ((float*)(ws + OFF_RS2))[tok0 + t] = r;
    }
    f32x4 acc[3];
#pragma unroll
    for (int i = 0; i < 3; ++i) acc[i] = zero4();
    const int lr = t >> 4, lc = (t & 15) * 4;
    const bf16_t* xres = (const bf16_t*)(ws + OFF_XCB);
    uint2 xv[4];
#pragma unroll
    for (int i = 0; i < 4; ++i) xv[i] = *(const uint2*)(xres + (long)(tok0 + lr + 32 * i) * 1024 + lc);
    __syncthreads();
    for (int kc = 0; kc < 16; ++kc) {
      const float4 gn = *(const float4*)(lnf + kc * 64 + lc);
#pragma unroll
      for (int i = 0; i < 4; ++i) {
        const float rs = rsl[lr + 32 * i];
        const float h0 = bflo(xv[i].x) * rs * gn.x, h1 = bfhi(xv[i].x) * rs * gn.y, h2 = bflo(xv[i].y) * rs * gn.z, h3 = bfhi(xv[i].y) * rs * gn.w;
        const bf16_t b0 = f2bf(h0), b1 = f2bf(h1), b2 = f2bf(h2), b3 = f2bf(h3);
        *(uint2*)(Ah + (lr + 32 * i) * 72 + lc) = make_uint2((unsigned)b0 | ((unsigned)b1 << 16), (unsigned)b2 | ((unsigned)b3 << 16));
        *(uint2*)(Al + (lr + 32 * i) * 72 + lc) = make_uint2(pack2(h0 - bf2f(b0), h1 - bf2f(b1)), pack2(h2 - bf2f(b2), h3 - bf2f(b3)));
      }
      if (t < 384) { const int r = t >> 3, cc = (t & 7) * 8; *(uint4*)(Wh + r * 72 + cc) = *(const uint4*)(wrh + r * 1024 + kc * 64 + cc); }
      else if (t < 384 + 128) { const int u = t - 384; for (int q = u; q < 384; q += 128) { const int r = q >> 3, cc = (q & 7) * 8; *(uint4*)(Wl + r * 72 + cc) = *(const uint4*)(wrl + r * 1024 + kc * 64 + cc); } }
      if (kc + 1 < 16) {
#pragma unroll
        for (int i = 0; i < 4; ++i) xv[i] = *(const uint2*)(xres + (long)(tok0 + lr + 32 * i) * 1024 + (kc + 1) * 64 + lc);
      }
      __syncthreads();
#pragma unroll
      for (int ks = 0; ks < 2; ++ks) {
        const bf16x8 ah = *(const bf16x8*)(Ah + (w * 16 + l15) * 72 + ks * 32 + lq * 8);
        const bf16x8 al = *(const bf16x8*)(Al + (w * 16 + l15) * 72 + ks * 32 + lq * 8);
#pragma unroll
        for (int nt = 0; nt < 3; ++nt) {
          const bf16x8 wh = *(const bf16x8*)(Wh + (nt * 16 + l15) * 72 + ks * 32 + lq * 8);
          const bf16x8 wl = *(const bf16x8*)(Wl + (nt * 16 + l15) * 72 + ks * 32 + lq * 8);
          acc[nt] = mfma16(ah, wh, acc[nt]);
          acc[nt] = mfma16(al, wh, acc[nt]);
          acc[nt] = mfma16(ah, wl, acc[nt]);
        }
      }
      __syncthreads();
    }
#pragma unroll
    for (int nt = 0; nt < 3; ++nt)
#pragma unroll
      for (int r = 0; r < 4; ++r) lg[(w * 16 + lq * 4 + r) * 49 + nt * 16 + l15] = acc[nt][r];
    __syncthreads();
    int* lcn = (int*)(lg + 128 * 49);
    if (t < 32) lcn[t] = 0;
    __syncthreads();
    int x0 = 0, x1 = 0, r0 = 0, r1 = 0; float g0 = 0.f, g1 = 0.f;
    if (t < 128) {
      const float* L = lg + t * 49;
      float gl[4];
#pragma unroll
      for (int i = 0; i < 4; ++i) gl[i] = L[i] + INP(I_RG_B)[l * 4 + i];
      int gi = 0; float gm = gl[0];
#pragma unroll
      for (int i = 1; i < 4; ++i) if (gl[i] > gm) { gm = gl[i]; gi = i; }
      float gsum = 0.f;
#pragma unroll
      for (int i = 0; i < 4; ++i) gsum += __expf(gl[i] - gm);
      const float gp = 1.f / gsum;
      float e0 = -3e38f, e1 = -3e38f; int i0 = 0, i1 = 0;
      for (int j = 0; j < 8; ++j) {
        const float v = L[4 + gi * 8 + j] + INP(I_RE_B)[l * 32 + gi * 8 + j];
        if (v > e0) { e1 = e0; i1 = i0; e0 = v; i0 = j; }
        else if (v > e1) { e1 = v; i1 = j; }
      }
      const float p1 = __expf(e1 - e0);
      g0 = gp / (1.f + p1); g1 = gp * p1 / (1.f + p1);
      x0 = gi * 8 + i0; x1 = gi * 8 + i1;
      r0 = atomicAdd(&lcn[x0], 1);
      r1 = atomicAdd(&lcn[x1], 1);
    }
    __syncthreads();
    if (t < 32 && c.f != 0.f) lcn[32 + t] = atomicAdd(&cnt[t], lcn[t]);
    __syncthreads();
    if (t < 128 && c.f != 0.f) {
      const int tok = tok0 + t;
      const int pos0 = lcn[32 + x0] + r0, pos1 = lcn[32 + x1] + r1;
      list[x0 * 65536 + pos0] = tok * 2;
      list[x1 * 65536 + pos1] = tok * 2 + 1;
      gate[tok * 2] = g0; gate[tok * 2 + 1] = g1;
      int* pinfo = (int*)(ws + OFF_PINFO);
      pinfo[tok * 2] = (x0 << 16) | pos0; pinfo[tok * 2 + 1] = (x1 << 16) | pos1;
    }
    __syncthreads();
  }
}

__device__ __forceinline__ int expert_prefix(const int* cnt, int* pre, int tid) {
  if (tid == 0) {
    int s = 0;
    for (int e = 0; e < 32; ++e) { pre[e] = s; s += (cnt[e] + 255) >> 8; }
    pre[32] = s;
  }
  __syncthreads();
  return pre[32];
}

template <bool GA_>
struct ExpertOrder {
  static constexpr bool GATHER = GA_;
  const char* A; const char* W; const int* list; const int* cnt; const int* pre; int lda_, ldb_, nN, total, G, c, which; size_t wstride;
  __device__ __forceinline__ bool next(int i, FUnit& u) const {
    const long L = (long)i * G + c; if (L >= (long)total * nN) return false;
    const int tile = (int)(L / nN); u.pn = (int)(L % nN); u.pm = tile;
    int e = 0;
    for (int j = 1; j < 32; ++j) if (pre[j] <= tile) e = j;
    e = __builtin_amdgcn_readfirstlane(e);
    u.e = e; u.pos0 = __builtin_amdgcn_readfirstlane((tile - pre[e]) * 256);
    u.nvalid = __builtin_amdgcn_readfirstlane(min(256, cnt[e] - u.pos0)); return true;
  }
  __device__ __forceinline__ unsigned lda() const { return (unsigned)lda_; }
  __device__ __forceinline__ unsigned ldb() const { return (unsigned)ldb_; }
  __device__ __forceinline__ const char* a_ptr(const FUnit& u) const { return GA_ ? A : A + (size_t)u.pm * 256 * lda_ * 2; }
  __device__ __forceinline__ const char* b_ptr(const FUnit& u) const { return W + (size_t)u.e * wstride + (size_t)u.pn * 256 * ldb_ * 2; }
  __device__ __forceinline__ void a_offs(const FUnit& u, int tid, unsigned (&va)[2][2]) const {
    int R0, C0, R1, C1; fg_stage_rc(tid * 16, R0, C0); fg_stage_rc(tid * 16 + 8192, R1, C1);
    const int* lp = list + u.e * 65536 + u.pos0;
#pragma unroll
    for (int h = 0; h < 2; ++h) {
      const int p0 = lp[min(128 * h + R0, u.nvalid - 1)], p1 = lp[min(128 * h + R1, u.nvalid - 1)];
      const int r0 = which == 0 ? (p0 >> 1) : p0, r1 = which == 0 ? (p1 >> 1) : p1;
      va[h][0] = (unsigned)(r0 * lda_ + C0) * 2u; va[h][1] = (unsigned)(r1 * lda_ + C1) * 2u;
    }
  }
};

struct EpiExpUp {
  char* ws; const int* list;
  __device__ __forceinline__ void operator()(const f32x4 (&acc)[2][2][4][2], const FUnit& u, int wr, int wc, int fr, int fq, int lane) const {
    const float* rs2 = (const float*)(ws + OFF_RS2);
    bf16_t* hb = (bf16_t*)(ws + OFF_HBUF);
    int pairv[2][4]; float rsv[2][4];
#pragma unroll
    for (int ai = 0; ai < 2; ++ai)
#pragma unroll
      for (int m = 0; m < 4; ++m) pairv[ai][m] = list[u.e * 65536 + u.pos0 + min(ai * 128 + wr * 64 + m * 16 + fr, u.nvalid - 1)];
#pragma unroll
    for (int ai = 0; ai < 2; ++ai)
#pragma unroll
      for (int m = 0; m < 4; ++m) rsv[ai][m] = rs2[pairv[ai][m] >> 1];
#pragma unroll
    for (int ai = 0; ai < 2; ++ai)
#pragma unroll
      for (int m = 0; m < 4; ++m) {
        const int rl = ai * 128 + wr * 64 + m * 16 + fr;
        const float rs = rsv[ai][m];
        if (rl < u.nvalid) {
#pragma unroll
          for (int bj = 0; bj < 2; ++bj) {
            const f32x4 g4 = acc[ai][bj][m][0] * rs, u4 = acc[ai][bj][m][1] * rs;
            const int col = u.pn * 128 + bj * 64 + wc * 16 + fq * 4;
            uint2 w2; w2.x = cvt_pk_bf16(silu_f(g4[0]) * u4[0], silu_f(g4[1]) * u4[1]); w2.y = cvt_pk_bf16(silu_f(g4[2]) * u4[2], silu_f(g4[3]) * u4[3]);
            *(uint2*)(hb + ((long)u.pm * 256 + rl) * 256 + col) = w2;
          }
        }
      }
  }
};
struct EpiExpDown {
  char* ws;
  __device__ __forceinline__ void operator()(const f32x4 (&acc)[2][2][4][2], const FUnit& u, int wr, int wc, int fr, int fq, int lane) const {
    bf16_t* yb = (bf16_t*)(ws + OFF_YBUF);
#pragma unroll
    for (int ai = 0; ai < 2; ++ai)
#pragma unroll
      for (int m = 0; m < 4; ++m) {
        const long row = (long)u.pm * 256 + ai * 128 + wr * 64 + m * 16 + fr;
#pragma unroll
        for (int bj = 0; bj < 2; ++bj) {
          const f32x4 v0 = acc[ai][bj][m][0], v1 = acc[ai][bj][m][1];
          const int col0 = u.pn * 256 + bj * 128 + wc * 32 + fq * 8;
          u32x4 w4; w4.x = cvt_pk_bf16(v0[0], v0[1]); w4.y = cvt_pk_bf16(v0[2], v0[3]); w4.z = cvt_pk_bf16(v1[0], v1[1]); w4.w = cvt_pk_bf16(v1[2], v1[3]);
          *(u32x4*)(yb + row * 1024 + col0) = w4;
        }
      }
  }
};

template <int WHICH>
__device__ __forceinline__ void phase_expert(const Ctx& c, int l) {
  char* ws = c.ws; char* smem = c.smem;
  int* pre = (int*)(smem + SMEM_MAIN + 16);
  const int* cnt = (const int*)(ws + OFF_CTL) + CTL_CNT + l * 32;
  const int* list = (const int*)(ws + OFF_LIST);
  const int ttiles = expert_prefix(cnt, pre, c.tid);
  if (WHICH == 0) {
    ExpertOrder<true> S;
    S.list = list; S.cnt = cnt; S.pre = pre; S.total = ttiles; S.G = c.nblk; S.c = c.bid; S.which = 0;
    S.A = ws + OFF_XCB; S.lda_ = 1024; S.W = ws + OFF_WGU_T + (size_t)l * 32 * 512 * 1024 * 2; S.ldb_ = 1024; S.nN = 2; S.wstride = (size_t)512 * 1024 * 2;
    EpiExpUp E{ws, list};
    fast_gemm((LAS3 unsigned char*)smem, S, E, 1024, c.tid);
  } else {
    ExpertOrder<false> S;
    S.list = list; S.cnt = cnt; S.pre = pre; S.total = ttiles; S.G = c.nblk; S.c = c.bid; S.which = 1;
    S.A = ws + OFF_HBUF; S.lda_ = 256; S.W = ws + OFF_WD_T + (size_t)l * 32 * 1024 * 256 * 2; S.ldb_ = 256; S.nN = 4; S.wstride = (size_t)1024 * 256 * 2;
    EpiExpDown E{ws};
    fast_gemm((LAS3 unsigned char*)smem, S, E, 256, c.tid);
  }
}

__device__ __forceinline__ void phase_combine(const Ctx& c, int l) {
  char* ws = c.ws; const int bid = c.bid, nblk = c.nblk;
  const int lane = c.tid & 63;
  const int gw = bid * NWAV + (c.tid >> 6), nw = nblk * NWAV;
  const bf16_t* yb = (const bf16_t*)(ws + OFF_YBUF);
  bf16_t* xcb = (bf16_t*)(ws + OFF_XCB);
  bf16_t* xnb = (bf16_t*)(ws + OFF_R4);
  const int* pinfo = (const int*)(ws + OFF_PINFO);
  const float* gate = (const float*)(ws + OFF_GATE);
  int* pre = (int*)(c.smem + SMEM_MAIN + 16);
  (void)expert_prefix((const int*)(ws + OFF_CTL) + CTL_CNT + l * 32, pre, c.tid);
  for (int row0 = gw * 2; row0 < NT; row0 += nw * 2) {
    uint2 xr[2][4], ya[2][4], yc[2][4]; float ga[2], gc[2];
#pragma unroll
    for (int q = 0; q < 2; ++q)
#pragma unroll
      for (int i = 0; i < 4; ++i) {
        const int cc = i * 256 + lane * 4; const long row = row0 + q;
        const int i0 = pinfo[row * 2], i1 = pinfo[row * 2 + 1];
        const long r0 = (long)pre[i0 >> 16] * 256 + (i0 & 0xffff), r1 = (long)pre[i1 >> 16] * 256 + (i1 & 0xffff);
        ga[q] = gate[row * 2]; gc[q] = gate[row * 2 + 1];
        xr[q][i] = *(const uint2*)(xcb + row * 1024 + cc);
        ya[q][i] = *(const uint2*)(yb + r0 * 1024 + cc); yc[q][i] = *(const uint2*)(yb + r1 * 1024 + cc);
      }
#pragma unroll
    for (int q = 0; q < 2; ++q) {
      const long row = row0 + q;
      float4 x[4];
      float ss = 0.f;
#pragma unroll
      for (int i = 0; i < 4; ++i) {
        const int cc = i * 256 + lane * 4;
        float4 v;
        const float g0 = ga[q] * c.f, g1 = gc[q] * c.f;
        v.x = bflo(xr[q][i].x) + (g0 * bflo(ya[q][i].x) + g1 * bflo(yc[q][i].x)); v.y = bfhi(xr[q][i].x) + (g0 * bfhi(ya[q][i].x) + g1 * bfhi(yc[q][i].x));
        v.z = bflo(xr[q][i].y) + (g0 * bflo(ya[q][i].y) + g1 * bflo(yc[q][i].y)); v.w = bfhi(xr[q][i].y) + (g0 * bfhi(ya[q][i].y) + g1 * bfhi(yc[q][i].y));
        if (l == 1) { if (c.f != 0.f) *(float4*)(c.p.out + row * 1024 + cc) = v; }
        else {
          const uint2 st2 = make_uint2(pack2(v.x, v.y), pack2(v.z, v.w));
          *(uint2*)(xcb + row * 1024 + cc) = st2;
          v = make_float4(bflo(st2.x), bfhi(st2.x), bflo(st2.y), bfhi(st2.y));
        }
        x[i] = v;
        ss += v.x * v.x + v.y * v.y + v.z * v.z + v.w * v.w;
      }
      if (l == 0) {
        ss = wave_sum(ss, lane);
        const float r = rsqrtf(ss * (1.f / 1024.f) + EPS);
#pragma unroll
        for (int i = 0; i < 4; ++i)
          *(uint2*)(xnb + row * 1024 + i * 256 + lane * 4) = make_uint2(pack2(x[i].x * r, x[i].y * r), pack2(x[i].z * r, x[i].w * r));
      }
    }
  }
}

__device__ __forceinline__ void phase_pool_dlt(const Ctx& c) {
  char* ws = c.ws; const int bid = c.bid, nblk = c.nblk;
  const bf16_t* xnb = (const bf16_t*)(ws + OFF_R4);
  bf16_t* dl = (bf16_t*)(ws + OFF_R1);
  const int t = c.tid;
  const int ch = (t & 127) * 8, sub = t >> 7;
  const int wnd = 2 << (ch >> 8);
  for (int tb = bid; tb < NT / 256; tb += nblk) {
    const int tok0 = tb * 256 + sub * 64;
    const int s0 = tok0 & 4095;
    const bf16_t* src = xnb + (long)tok0 * 1024 + ch;
    float sum[8] = {0.f, 0.f, 0.f, 0.f, 0.f, 0.f, 0.f, 0.f};
    const int nh = min(wnd, s0);
    for (int k = 1; k <= nh; ++k) {
      const uint4 u = *(const uint4*)(src - (long)k * 1024);
      sum[0] += bflo(u.x); sum[1] += bfhi(u.x); sum[2] += bflo(u.y); sum[3] += bfhi(u.y); sum[4] += bflo(u.z); sum[5] += bfhi(u.z); sum[6] += bflo(u.w); sum[7] += bfhi(u.w);
    }
    for (int i0 = 0; i0 < 64; i0 += 4) {
      uint4 un[4], uo[4];
#pragma unroll
      for (int q = 0; q < 4; ++q) {
        un[q] = *(const uint4*)(src + (long)(i0 + q) * 1024);
        uo[q] = make_uint4(0, 0, 0, 0);
        if (s0 + i0 + q >= wnd) uo[q] = *(const uint4*)(src + (long)(i0 + q - wnd) * 1024);
      }
#pragma unroll
      for (int q = 0; q < 4; ++q) {
        const float xn_[8] = {bflo(un[q].x), bfhi(un[q].x), bflo(un[q].y), bfhi(un[q].y), bflo(un[q].z), bfhi(un[q].z), bflo(un[q].w), bfhi(un[q].w)};
        const float xo_[8] = {bflo(uo[q].x), bfhi(uo[q].x), bflo(uo[q].y), bfhi(uo[q].y), bflo(uo[q].z), bfhi(uo[q].z), bflo(uo[q].w), bfhi(uo[q].w)};
        const float inv = 1.f / (float)min(s0 + i0 + q + 1, wnd);
        float o[8];
#pragma unroll
        for (int j = 0; j < 8; ++j) { sum[j] += xn_[j] - xo_[j]; o[j] = sum[j] * inv - xn_[j]; }
        *(uint4*)(dl + (long)(tok0 + i0 + q) * 1024 + ch) = make_uint4(pack2(o[0], o[1]), pack2(o[2], o[3]), pack2(o[4], o[5]), pack2(o[6], o[7]));
      }
    }
  }
}

#define XB_TMO      128
#define XB_XCNT(j)  (256  + 64 * (j))
#define XB_XSUB(j)  (1280 + 64 * (j))
#define XB_XGEN(j)  (2304 + 64 * (j))
#define XB_TOP      3328
#define XB_TOPGEN   3392
#define XCD_BAR_WORDS 3456
#define XB_SPIN_CAP (1u << 22)
#define LAS __attribute__((address_space(3)))
__device__ __forceinline__ unsigned xb_ld(unsigned* p)              { return __hip_atomic_load(p, __ATOMIC_RELAXED, __HIP_MEMORY_SCOPE_AGENT); }
__device__ __forceinline__ unsigned xb_add(unsigned* p, unsigned v) { return __hip_atomic_fetch_add(p, v, __ATOMIC_RELAXED, __HIP_MEMORY_SCOPE_AGENT); }
__device__ __forceinline__ unsigned xb_xcc_id() { return (unsigned)__builtin_amdgcn_s_getreg((3 << 11) | 20) & 0xFu; }
#define XB_SPIN(cond, bar) do { unsigned _sp = 0; while (cond) { __builtin_amdgcn_s_sleep(1); \
    if ((++_sp & 255u) == 0u) { if (xb_ld(&(bar)[XB_TMO])) break; if (_sp > XB_SPIN_CAP) { atomicAdd(&(bar)[XB_TMO], 1u); break; } } } } while (0)
struct XcdBarrier { unsigned* bar; unsigned x; volatile LAS unsigned* st; };
__device__ __forceinline__ XcdBarrier xcd_barrier_post(unsigned* bar, volatile LAS unsigned* st) {
  XcdBarrier b; b.bar = bar; b.x = xb_xcc_id(); b.st = st;
  if (threadIdx.x == 0) (void)xb_add(&bar[XB_XCNT(b.x)], 1u);
  return b;
}
__device__ __forceinline__ void xcd_barrier_complete(unsigned* bar, unsigned x, unsigned& nloc, unsigned& nx) {
  const unsigned G = gridDim.x * gridDim.y * gridDim.z;
  unsigned sum, cnt, mine, sp = 0u;
  for (;;) {
    sum = 0u; cnt = 0u; mine = 0u;
#pragma unroll
    for (unsigned j = 0; j < 16; ++j) { const unsigned cc = xb_ld(&bar[XB_XCNT(j)]); sum += cc; cnt += (cc > 0u) ? 1u : 0u; mine = (j == x) ? cc : mine; }
    if (sum == G) break;
    __builtin_amdgcn_s_sleep(1);
    if ((++sp & 255u) == 0u) { if (xb_ld(&bar[XB_TMO])) break; if (sp > XB_SPIN_CAP) { atomicAdd(&bar[XB_TMO], 1u); break; } }
  }
  nloc = mine > 0u ? mine : 1u; nx = cnt > 0u ? cnt : 1u;
}
__device__ __forceinline__ void xcd_barrier(const XcdBarrier& b) {
  asm volatile("s_waitcnt vmcnt(0)" ::: "memory");
  __syncthreads();
  if (threadIdx.x == 0) {
    unsigned* bar = b.bar;
    __builtin_amdgcn_s_waitcnt(0);
    unsigned nloc = b.st[0], nx = b.st[1];
    if (nloc == 0u) { xcd_barrier_complete(bar, b.x, nloc, nx); b.st[0] = nloc; b.st[1] = nx; }
    const unsigned old = xb_add(&bar[XB_XSUB(b.x)], 1u);
    const unsigned gen = old / nloc;
    if (old + 1u == (gen + 1u) * nloc) {
      __builtin_amdgcn_fence(__ATOMIC_RELEASE, "agent");
      asm volatile("s_waitcnt vmcnt(0)" ::: "memory");
      const unsigned og = xb_add(&bar[XB_TOP], 1u);
      const unsigned tg = og / nx;
      if (og + 1u == (tg + 1u) * nx) xb_add(&bar[XB_TOPGEN], 1u);
      else XB_SPIN(xb_ld(&bar[XB_TOPGEN]) == tg, bar);
      __builtin_amdgcn_fence(__ATOMIC_ACQUIRE, "agent");
      xb_add(&bar[XB_XGEN(b.x)], 1u);
      asm volatile("s_waitcnt vmcnt(0)" ::: "memory");
    } else {
      XB_SPIN(xb_ld(&bar[XB_XGEN(b.x)]) == gen, bar);
      __builtin_amdgcn_fence(__ATOMIC_ACQUIRE, "agent");
      asm volatile("s_waitcnt vmcnt(0)" ::: "memory");
    }
  }
  __syncthreads();
}

constexpr int N_PHASES = 22;
#define RUN_PHASE(PH, CALL) do { \
    constexpr int nrep_ = ((PROBE_MASK >> (PH)) & 1u) ? 2 : 1; \
    _Pragma("unroll 1") for (int rep_ = 0; rep_ < nrep_; ++rep_) { \
      int tid = threadIdx.x; asm volatile("" : "+v"(tid)); \
      size_t wz = 0; asm volatile("" : "+s"(wz)); \
      char* ws = p.ws + wz; \
      int bid = blockIdx.x; asm volatile("" : "+s"(bid)); \
      int nblk = gridDim.x; asm volatile("" : "+s"(nblk)); \
      const Ctx c{p, ws, smem, tid, bid, nblk, (PROBE_MASK != 0u && rep_) ? 0.f : 1.f, rep_}; \
      CALL; \
      if ((PH) + 1 < N_PHASES || rep_ + 1 < nrep_) xcd_barrier(xb); \
    } } while (0)

__global__ void __launch_bounds__(NTHR, 2) fwd_megakernel(Params p) {
  extern __shared__ __attribute__((aligned(16))) char smem[];
  volatile LAS unsigned* xst = (volatile LAS unsigned*)(smem + SMEM_MAIN + 256);
  if (threadIdx.x < 4) xst[threadIdx.x] = 0u;
  __syncthreads();
  const XcdBarrier xb = xcd_barrier_post((unsigned*)(p.ws + OFF_BAR), xst);
  RUN_PHASE(0, phase_prep(c));
  RUN_PHASE(1, phase_gemm_in(c));
  RUN_PHASE(2, phase_up(c));
  RUN_PHASE(3, phase_mix(c));
  RUN_PHASE(4, phase_ynorm(c));
  RUN_PHASE(5, phase_gemm_out(c));
  RUN_PHASE(6, phase_xq(c, 0));
  RUN_PHASE(7, phase_xattn(c, 0));
  RUN_PHASE(8, phase_xo(c, 0));
  RUN_PHASE(9, phase_router(c, 0));
  RUN_PHASE(10, phase_expert<0>(c, 0));
  RUN_PHASE(11, phase_expert<1>(c, 0));
  RUN_PHASE(12, phase_combine(c, 0));
  RUN_PHASE(13, phase_pool_dlt(c));
  RUN_PHASE(14, phase_pool_gemm(c));
  RUN_PHASE(15, phase_xq(c, 1));
  RUN_PHASE(16, phase_xattn(c, 1));
  RUN_PHASE(17, phase_xo(c, 1));
  RUN_PHASE(18, phase_router(c, 1));
  RUN_PHASE(19, phase_expert<0>(c, 1));
  RUN_PHASE(20, phase_expert<1>(c, 1));
  RUN_PHASE(21, phase_combine(c, 1));
}

extern "C" void kernel_launch(void* const* d_in, const int* in_sizes, int n_in, void* d_out,
                              int out_size, void* d_ws, size_t ws_size, hipStream_t stream) {
  static int grid_blocks = 0;
  if (!grid_blocks) {
    int dev = 0, cus = 0, per_cu = 0;
    (void)hipGetDevice(&dev);
    (void)hipDeviceGetAttribute(&cus, hipDeviceAttributeMultiprocessorCount, dev);
    (void)hipFuncSetAttribute((const void*)fwd_megakernel, hipFuncAttributeMaxDynamicSharedMemorySize, SMEM_BYTES);
    (void)hipOccupancyMaxActiveBlocksPerMultiprocessor(&per_cu, fwd_megakernel, NTHR, SMEM_BYTES);
    if (per_cu > 1) per_cu = 1;
    if (per_cu < 1) per_cu = 1;
    grid_blocks = cus * per_cu;
    if (ws_size < WS_END) { fprintf(stderr, "workspace too small: %zu < %zu\n", ws_size, (size_t)WS_END); grid_blocks = -1; }
    if (n_in != N_IN) { fprintf(stderr, "unexpected n_in %d\n", n_in); grid_blocks = -1; }
  }
  if (grid_blocks < 0) return;
  Params p{};
  for (int i = 0; i < N_IN; ++i) p.in[i] = d_in[i];
  p.out = (float*)d_out;
  p.ws = (char*)d_ws;
  (void)hipMemsetAsync((char*)d_ws + OFF_BAR, 0, 16384, stream);
  void* args[] = {&p};
  hipError_t e = hipLaunchCooperativeKernel((void*)fwd_megakernel, dim3(grid_blocks), dim3(NTHR), args, SMEM_BYTES, stream);
  if (e != hipSuccess) fprintf(stderr, "cooperative launch failed: %s (grid %d)\n", hipGetErrorString(e), grid_blocks);
}
```

```cpp
#include <hip/hip_runtime.h>
#include <hip/hip_cooperative_groups.h>
#include <cstdio>
#include <cstdint>
namespace cg = cooperative_groups;

#ifndef MULTI_LAUNCH
#define MULTI_LAUNCH 0
#endif

typedef unsigned short bf16_t;
typedef short bf16x8 __attribute__((ext_vector_type(8)));
typedef float f32x4 __attribute__((ext_vector_type(4)));
typedef unsigned u32x4 __attribute__((ext_vector_type(4)));

constexpr int NT = 65536, DM = 1024, SEQ = 4096, NB = 16;
constexpr int NTHR = 512, NWAV = 8;
constexpr int PROJ_LD = 2048;
constexpr int C_QLAT = 0, C_KVLAT = 256, C_KROPE = 384, C_Z = 416, C_XBC = 928, C_DT = 1952;
constexpr float EPS = 1e-6f;
constexpr float LOG2E = 1.4426950408889634f;

enum { I_X = 0, I_MEM, I_POS, I_LN_MIX, I_W_IN, I_QLAT_NORM, I_W_UQ, I_KVLAT_NORM, I_W_UKV, I_Q_NORM, I_K_NORM,
       I_CONV_W, I_CONV_B, I_DT_BIAS, I_A_LOG, I_D_SKIP, I_SSD_NORM, I_W_OUT, I_POOL_W, I_POOL_B, I_POOL_SCALE,
       I_LN_XQ, I_LN_MEM, I_XQ_W, I_XKV_W, I_XQ_NORM, I_XK_NORM, I_XO_W, I_LN_FFN, I_RG_W, I_RG_B, I_RE_W, I_RE_B,
       I_EXP_G, I_EXP_U, I_EXP_D, N_IN };

constexpr size_t MiB = 1ull << 20;
constexpr size_t OFF_WIN_T = 0;
constexpr size_t OFF_WUQ_T = OFF_WIN_T + 2048ull * 1024 * 2;
constexpr size_t OFF_WUKV_T = OFF_WUQ_T + 1024ull * 256 * 2;
constexpr size_t OFF_WOUT_T = OFF_WUKV_T + 1024ull * 256 * 2;
constexpr size_t OFF_POOL_T = OFF_WOUT_T + 1024ull * 1024 * 2;
constexpr size_t OFF_XQ_T = OFF_POOL_T + 4ull * 256 * 256 * 2;
constexpr size_t OFF_XKV_T = OFF_XQ_T + 2ull * 256 * 1024 * 2;
constexpr size_t OFF_XO_T = OFF_XKV_T + 2ull * 512 * 1024 * 2;
constexpr size_t OFF_WGU_T = OFF_XO_T + 2ull * 1024 * 256 * 2;
constexpr size_t OFF_WD_T = OFF_WGU_T + 64ull * 512 * 1024 * 2;
constexpr size_t OFF_R1 = OFF_WD_T + 64ull * 1024 * 256 * 2;
constexpr size_t OFF_R2 = OFF_R1 + 128 * MiB;
constexpr size_t OFF_R3 = OFF_R2 + 256 * MiB;
constexpr size_t OFF_R4 = OFF_R3 + 256 * MiB;
constexpr size_t OFF_MISC = OFF_R4 + 128 * MiB;
constexpr size_t OFF_Q = OFF_R3, OFF_K = OFF_R3 + 96 * MiB, OFF_VT = OFF_R3 + 192 * MiB;
constexpr size_t OFF_XCB = OFF_R3, OFF_XQ = OFF_R3 + 128 * MiB, OFF_XO = OFF_R3 + 160 * MiB;
constexpr size_t OFF_RS0 = OFF_MISC;
constexpr size_t OFF_SSQ_Q = OFF_RS0 + NT * 4ull;
constexpr size_t OFF_SSQ_KV = OFF_SSQ_Q + NT * 32ull;
constexpr size_t OFF_DTRAW = OFF_SSQ_KV + NT * 16ull;
constexpr size_t OFF_DT = OFF_DTRAW + NT * 32ull;
constexpr size_t OFF_SSQA = OFF_DT + NT * 32ull;
constexpr size_t OFF_SSQB = OFF_SSQA + NT * 128ull;
constexpr size_t OFF_RS3 = OFF_SSQB + NT * 128ull;
constexpr size_t OFF_RS2 = OFF_RS3 + NT * 4ull;
constexpr size_t OFF_MEMB = OFF_RS2 + NT * 4ull;
constexpr size_t OFF_RSM = OFF_MEMB + 4096ull * 1024 * 2;
constexpr size_t OFF_MEMK = OFF_RSM + 4096 * 4ull;
constexpr size_t OFF_MEMVT = OFF_MEMK + 2ull * 4096 * 256 * 2;
constexpr size_t OFF_GATE = OFF_MEMVT + 2ull * 4096 * 256 * 2;
constexpr size_t OFF_PINFO = OFF_GATE + NT * 8ull;
constexpr size_t OFF_LIST = OFF_PINFO + NT * 8ull;
constexpr size_t OFF_CTL = OFF_LIST + 32ull * 65536 * 4;
constexpr size_t OFF_WR = OFF_CTL + 4096;
constexpr size_t OFF_BAR = OFF_WR + 2ull * 2 * 48 * 1024 * 2;
constexpr size_t OFF_HBUF = OFF_BAR + 16384;
constexpr size_t WS_END = OFF_HBUF + 544ull * 256 * 256 * 2;
constexpr size_t OFF_YBUF = OFF_R2 - 16 * MiB;

constexpr int CTL_CNT = 0;
constexpr int CTL_QCTR = 64;

constexpr int LDS_ST = 72;
constexpr int CS_LD = 132;
constexpr int SMEM_BYTES = 160 * 1024;
constexpr int SMEM_MAIN = SMEM_BYTES - 1024;

struct Params {
  const void* in[N_IN];
  float* out;
  char* ws;
  int phase_lo, phase_hi;
};

#ifndef PROBE_MASK
#define PROBE_MASK 0u
#endif
struct Ctx { const Params& p; char* ws; char* smem; int tid, bid, nblk; float f; int pass; };
__device__ __forceinline__ int opq(int i) { asm volatile("" : "+s"(i)); return i; }
#define INP(i) ((const float*)c.p.in[opq(i)])

__device__ __forceinline__ bf16_t f2bf(float f) {
  unsigned u = __float_as_uint(f);
  u += 0x7fffu + ((u >> 16) & 1u);
  return (bf16_t)(u >> 16);
}
__device__ __forceinline__ float bf2f(bf16_t h) { return __uint_as_float(((unsigned)h) << 16); }
__device__ __forceinline__ unsigned pack2(float lo, float hi) { return (unsigned)f2bf(lo) | ((unsigned)f2bf(hi) << 16); }
__device__ __forceinline__ float bflo(unsigned u) { return __uint_as_float(u << 16); }
__device__ __forceinline__ float bfhi(unsigned u) { return __uint_as_float(u & 0xffff0000u); }
__device__ __forceinline__ float silu_f(float x) { return x / (1.f + __expf(-x)); }
template <int M> __device__ __forceinline__ float sxor(float v) {
  static_assert(M >= 1 && M < 32, "swizzle xor mask");
  return __int_as_float(__builtin_amdgcn_ds_swizzle(__float_as_int(v), (M << 10) | 0x1f));
}
__device__ __forceinline__ float lane_get(float v, int src_lane) { return __int_as_float(__builtin_amdgcn_ds_bpermute(src_lane << 2, __float_as_int(v))); }
__device__ __forceinline__ float wave_sum(float v, int lane) {
  v += sxor<1>(v); v += sxor<2>(v); v += sxor<4>(v); v += sxor<8>(v); v += sxor<16>(v);
  v += lane_get(v, lane ^ 32);
  return v;
}
typedef short s16x4 __attribute__((ext_vector_type(4)));
__device__ __forceinline__ bf16x8 tr_frag(const bf16_t* M, int ld, int k0, int n0, int l15, int lq) {
  const bf16_t* p0 = M + (k0 + 8 * lq + (l15 >> 2)) * ld + n0 + 4 * (l15 & 3);
  const s16x4 a = __builtin_amdgcn_ds_read_tr16_b64_v4i16((__attribute__((address_space(3))) s16x4*)p0);
  const s16x4 b = __builtin_amdgcn_ds_read_tr16_b64_v4i16((__attribute__((address_space(3))) s16x4*)(p0 + 4 * ld));
  return (bf16x8){a[0], a[1], a[2], a[3], b[0], b[1], b[2], b[3]};
}
__device__ __forceinline__ unsigned cvt_pk_bf16(float lo, float hi) { unsigned r; asm volatile("v_cvt_pk_bf16_f32 %0, %1, %2" : "=v"(r) : "v"(lo), "v"(hi)); return r; }
__device__ __forceinline__ f32x4 zero4() { float z = 0.f; asm volatile("" : "+v"(z)); return (f32x4){z, z, z, z}; }
__device__ __forceinline__ f32x4 mfma16(bf16x8 a, bf16x8 b, f32x4 c) { return __builtin_amdgcn_mfma_f32_16x16x32_bf16(a, b, c, 0, 0, 0); }

__device__ __forceinline__ void gemm_core(const char* Ab, const unsigned (&ao)[2], const char* Bb, const unsigned (&bo)[2], int K, char* smem, int tid) {
  const int t = tid, lane = t & 63, w = t >> 6;
  const int wr = w >> 1, wc = w & 1;
  const int l15 = lane & 15, lq = lane >> 4;
  bf16_t* As = (bf16_t*)smem;
  bf16_t* Bs = As + 2 * 128 * LDS_ST;
  const int srow = t >> 3, scol = (t & 7) * 8;
  const int nk = K >> 6;
  u32x4 ra0[2], rb0[2], ra1[2], rb1[2];
#define G_LOAD(RA, RB, KT) { const unsigned kk_ = (unsigned)((KT) < nk ? (KT) : nk - 1) * 128u; \
    _Pragma("unroll") for (int i = 0; i < 2; ++i) { RA[i] = *(const u32x4*)(Ab + (size_t)(ao[i] + kk_)); RB[i] = *(const u32x4*)(Bb + (size_t)(bo[i] + kk_)); } }
#define G_STORE(RA, RB, ST) { bf16_t* An_ = As + (ST) * 128 * LDS_ST; bf16_t* Bn_ = Bs + (ST) * 128 * LDS_ST; \
    _Pragma("unroll") for (int i = 0; i < 2; ++i) { *(u32x4*)(An_ + (srow + 64 * i) * LDS_ST + scol) = RA[i]; *(u32x4*)(Bn_ + (srow + 64 * i) * LDS_ST + scol) = RB[i]; } }
#define G_COMPUTE(ST) { const bf16_t* Ac = As + (ST) * 128 * LDS_ST; const bf16_t* Bc = Bs + (ST) * 128 * LDS_ST; \
    _Pragma("unroll") for (int ks = 0; ks < 2; ++ks) { bf16x8 af[2], bfr[4]; \
      _Pragma("unroll") for (int mt = 0; mt < 2; ++mt) af[mt] = *(const bf16x8*)(Ac + (wr * 32 + mt * 16 + l15) * LDS_ST + ks * 32 + lq * 8); \
      _Pragma("unroll") for (int nt = 0; nt < 4; ++nt) bfr[nt] = *(const bf16x8*)(Bc + (wc * 64 + nt * 16 + l15) * LDS_ST + ks * 32 + lq * 8); \
      _Pragma("unroll") for (int mt = 0; mt < 2; ++mt) _Pragma("unroll") for (int nt = 0; nt < 4; ++nt) acc[mt][nt] = mfma16(af[mt], bfr[nt], acc[mt][nt]); } }
  G_LOAD(ra0, rb0, 0)
  G_LOAD(ra1, rb1, 1)
  G_STORE(ra0, rb0, 0)
  __syncthreads();
  f32x4 acc[2][4];
#pragma unroll
  for (int i = 0; i < 2; ++i)
#pragma unroll
    for (int j = 0; j < 4; ++j) acc[i][j] = zero4();
  for (int kt = 0; kt < nk; kt += 2) {
    G_LOAD(ra0, rb0, kt + 2)
    __builtin_amdgcn_sched_barrier(0);
    G_COMPUTE(0)
    G_STORE(ra1, rb1, 1)
    __syncthreads();
    G_LOAD(ra1, rb1, kt + 3)
    __builtin_amdgcn_sched_barrier(0);
    G_COMPUTE(1)
    G_STORE(ra0, rb0, 0)
    __syncthreads();
  }
#undef G_LOAD
#undef G_STORE
#undef G_COMPUTE
  float* Cs = (float*)smem;
#pragma unroll
  for (int mt = 0; mt < 2; ++mt)
#pragma unroll
    for (int nt = 0; nt < 4; ++nt)
#pragma unroll
      for (int r = 0; r < 4; ++r)
        Cs[(wr * 32 + mt * 16 + lq * 4 + r) * CS_LD + wc * 64 + nt * 16 + l15] = acc[mt][nt][r];
  __syncthreads();
}

__device__ __forceinline__ void gemm_dense(const bf16_t* A, long lda, const bf16_t* Bt, long ldb, int K, char* smem, int tid) {
  const int t = tid;
  const int srow = t >> 3, scol = (t & 7) * 8;
  unsigned ao[2], bo[2];
#pragma unroll
  for (int i = 0; i < 2; ++i) { ao[i] = (unsigned)(((srow + 64 * i) * lda + scol) * 2); bo[i] = (unsigned)(((srow + 64 * i) * ldb + scol) * 2); }
  gemm_core((const char*)A, ao, (const char*)Bt, bo, K, smem, tid);
}

template <int N>
__device__ __forceinline__ void store_bf16_row(bf16_t* dst, const float (&v)[N]) {
#pragma unroll
  for (int j = 0; j < N; j += 8) {
    uint4 u;
    u.x = pack2(v[j], v[j + 1]); u.y = pack2(v[j + 2], v[j + 3]); u.z = pack2(v[j + 4], v[j + 5]); u.w = pack2(v[j + 6], v[j + 7]);
    *(uint4*)(dst + j) = u;
  }
}


#define LAS3 __attribute__((address_space(3)))
constexpr int FG_HTB = 128 * 64 * 2;
__device__ __forceinline__ int fg_lds_byte(int r, int c) { const int st = (r >> 4) * 2 + (c >> 5), rr = r & 15, cc = c & 31, ob = rr * 64 + cc * 2; return st * 1024 + (ob ^ (((ob >> 9) & 1) << 5)); }
__device__ __forceinline__ void fg_stage_rc(int b, int& R, int& C) { const int st = b / 1024, sb = b % 1024, swz = sb ^ (((sb >> 9) & 1) << 5); R = (st >> 1) * 16 + swz / 64; C = (st & 1) * 32 + (swz % 64) / 2; }
__device__ __forceinline__ int fg_perm32(int rho) { const int n = rho >> 4, i = rho & 15; return 8 * (i >> 2) + 4 * n + (i & 3); }
struct FUnit { int pm, pn, e, pos0, nvalid; };

template <class Epi, class Sched>
__device__ __forceinline__ void fast_gemm(LAS3 unsigned char* lds, const Sched& S, const Epi& E, int K, int tid_) {
  const int tid = tid_, wid = __builtin_amdgcn_readfirstlane(tid >> 6), lane = tid & 63, wr = wid >> 2, wc = wid & 3, fr = lane & 15, fq = lane >> 4;
  const int nt = K / 64;
  int R0, C0, R1, C1; fg_stage_rc(tid * 16, R0, C0); fg_stage_rc(tid * 16 + 8192, R1, C1);
  const unsigned ldb = S.ldb();
  unsigned voffB[2];
  voffB[0] = (unsigned)(((R0 & ~31) + fg_perm32(R0 & 31)) * ldb + C0) * 2u;
  voffB[1] = (unsigned)(((R1 & ~31) + fg_perm32(R1 & 31)) * ldb + C1) * 2u;
  const size_t kstep = 128;
  const size_t hstepB = (size_t)128 * ldb * 2;
  const unsigned ldsw = (unsigned)wid * 1024u;
  const int aoff = fg_lds_byte(wr * 64 + fr, fq * 8), boff = fg_lds_byte(wc * 32 + fr, fq * 8);
#define FG_SA(b, h) (((b) * 2 + (h)) * FG_HTB)
#define FG_SB(b, h) ((4 + (b) * 2 + (h)) * FG_HTB)
#define FG_STAGE(bufoff, gbase, voff) do { _Pragma("unroll") for (int _i = 0; _i < 2; ++_i) \
    __builtin_amdgcn_global_load_lds((const unsigned*)((const char*)(gbase) + (voff)[_i]), (LAS3 unsigned*)(lds + (bufoff) + ldsw + _i * 8192), 16, 0, 0); } while (0)
#define FG_LDA(dst, b, h) do { _Pragma("unroll") for (int m = 0; m < 4; ++m) _Pragma("unroll") for (int k = 0; k < 2; ++k) dst[m][k] = *(const LAS3 bf16x8*)(lds + FG_SA(b, h) + aoff + m * 2048 + k * 1024); } while (0)
#define FG_LDB(dst, b, h) do { _Pragma("unroll") for (int n = 0; n < 2; ++n) _Pragma("unroll") for (int k = 0; k < 2; ++k) dst[n][k] = *(const LAS3 bf16x8*)(lds + FG_SB(b, h) + boff + n * 2048 + k * 1024); } while (0)
#define FG_MMA(ai, bj, At, Bt) do { __builtin_amdgcn_s_setprio(1); _Pragma("unroll") for (int m = 0; m < 4; ++m) _Pragma("unroll") for (int n = 0; n < 2; ++n) _Pragma("unroll") for (int k = 0; k < 2; ++k) \
    acc[ai][bj][m][n] = __builtin_amdgcn_mfma_f32_16x16x32_bf16(Bt[n][k], At[m][k], acc[ai][bj][m][n], 0, 0, 0); __builtin_amdgcn_s_setprio(0); } while (0)
#define FG_WAIT_V(n) asm volatile("s_waitcnt vmcnt(" #n ")" ::: "memory")
#define FG_WAIT_L(n) asm volatile("s_waitcnt lgkmcnt(" #n ")" ::: "memory")
#define FG_BAR __builtin_amdgcn_s_barrier()
#define FG_SCHED __builtin_amdgcn_sched_barrier(0)
  FUnit cur, nxt; int ui = 0;
  if (!S.next(0, cur)) return;
  f32x4 acc[2][2][4][2];
#pragma unroll
  for (int a = 0; a < 2; ++a)
#pragma unroll
    for (int b = 0; b < 2; ++b)
#pragma unroll
      for (int m = 0; m < 4; ++m)
#pragma unroll
        for (int n = 0; n < 2; ++n) acc[a][b][m][n] = zero4();
  bf16x8 At[4][2], B0[2][2], B1[2][2];
  constexpr bool GA = Sched::GATHER;
  const unsigned lda = S.lda();
  const size_t hstepA = (size_t)128 * lda * 2;
  unsigned voffA[2];
  voffA[0] = (unsigned)(R0 * lda + C0) * 2u; voffA[1] = (unsigned)(R1 * lda + C1) * 2u;
  unsigned vaC[2][2], vaN[2][2];
  const char* cA = S.a_ptr(cur);
  if (GA) S.a_offs(cur, tid, vaC);
  const char* cB = S.b_ptr(cur);
#define FG_STAGE_A(bufoff, UPTR, KOFF, H, VG) do { if (GA) FG_STAGE(bufoff, (UPTR) + (KOFF), (VG)[H]); else FG_STAGE(bufoff, (UPTR) + (KOFF) + (H) * hstepA, voffA); } while (0)
  FG_STAGE(FG_SB(0, 0), cB, voffB); FG_STAGE_A(FG_SA(0, 0), cA, 0, 0, vaC); FG_STAGE(FG_SB(0, 1), cB + hstepB, voffB); FG_STAGE_A(FG_SA(0, 1), cA, 0, 1, vaC);
  if (wr == 1) FG_BAR;
  FG_WAIT_V(4); FG_BAR;
  FG_STAGE(FG_SB(1, 0), cB + kstep, voffB); FG_STAGE_A(FG_SA(1, 0), cA, kstep, 0, vaC); FG_STAGE(FG_SB(1, 1), cB + hstepB + kstep, voffB);
  FG_WAIT_V(6); FG_BAR;
  for (;;) {
    const bool has_next = S.next(ui + 1, nxt);
    if (!has_next) nxt = cur;
    if (GA) S.a_offs(nxt, tid, vaN);
    const char* nA = has_next ? S.a_ptr(nxt) : cA;
    const char* nB = has_next ? S.b_ptr(nxt) : cB;
#pragma unroll 1
    for (int t = 0; t < nt; t += 2) {
      const bool last = (t == nt - 2);
      const size_t k1 = (size_t)(t + 1) * kstep;
      const char* a2 = last ? nA : cA + (size_t)(t + 2) * kstep;
      const char* b2 = last ? nB : cB + (size_t)(t + 2) * kstep;
      const char* b3 = b2 + kstep;
      FG_LDB(B0, 0, 0); FG_SCHED; FG_LDA(At, 0, 0); FG_STAGE_A(FG_SA(1, 1), cA, k1, 1, vaC);
      FG_WAIT_L(8); FG_BAR; FG_WAIT_L(0); FG_MMA(0, 0, At, B0); FG_BAR; FG_SCHED;
      if (GA && last) {
#pragma unroll
        for (int h = 0; h < 2; ++h)
#pragma unroll
          for (int i = 0; i < 2; ++i) vaC[h][i] = vaN[h][i];
      }
      FG_LDB(B1, 0, 1); FG_STAGE(FG_SB(0, 0), b2, voffB);
      FG_BAR; FG_WAIT_L(0); FG_MMA(0, 1, At, B1); FG_BAR;
      FG_LDA(At, 0, 1); FG_STAGE_A(FG_SA(0, 0), a2, 0, 0, vaC);
      FG_BAR; FG_WAIT_L(0); FG_MMA(1, 0, At, B0); FG_BAR; FG_SCHED;
      FG_STAGE(FG_SB(0, 1), b2 + hstepB, voffB);
      FG_WAIT_V(6); FG_BAR; FG_MMA(1, 1, At, B1); FG_BAR;
      FG_LDB(B0, 1, 0); FG_SCHED; FG_LDA(At, 1, 0); FG_STAGE_A(FG_SA(0, 1), a2, 0, 1, vaC);
      FG_WAIT_L(8); FG_BAR; FG_WAIT_L(0); FG_MMA(0, 0, At, B0); FG_BAR; FG_SCHED;
      FG_LDB(B1, 1, 1); FG_STAGE(FG_SB(1, 0), b3, voffB);
      FG_BAR; FG_WAIT_L(0); FG_MMA(0, 1, At, B1); FG_BAR;
      FG_LDA(At, 1, 1); FG_STAGE_A(FG_SA(1, 0), a2, kstep, 0, vaC);
      FG_BAR; FG_WAIT_L(0); FG_MMA(1, 0, At, B0); FG_BAR; FG_SCHED;
      FG_STAGE(FG_SB(1, 1), b3 + hstepB, voffB);
      FG_WAIT_V(6); FG_BAR; FG_MMA(1, 1, At, B1); FG_BAR;
    }
    {
      int fr2 = fr, fq2 = fq, ln2 = lane; asm volatile("" : "+v"(fr2), "+v"(fq2), "+v"(ln2));
      E(acc, cur, wr, wc, fr2, fq2, ln2);
    }
    if (!has_next) break;
#pragma unroll
    for (int a = 0; a < 2; ++a)
#pragma unroll
      for (int b = 0; b < 2; ++b)
#pragma unroll
        for (int m = 0; m < 4; ++m)
#pragma unroll
          for (int n = 0; n < 2; ++n) acc[a][b][m][n] = zero4();
    cur = nxt; cA = nA; cB = nB; ++ui;
  }
  FG_WAIT_V(0);
  if (wr == 0) FG_BAR;
  FG_BAR;
}

struct DenseOrder {
  const char* A; const char* Bt; int lda_, ldb_, nM, nN, nwg, G, c, a_col_bytes_per_pn;
  __device__ __forceinline__ void init(const void* A_, int ldaa, const void* Bt_, int ldbb, int M, int N, int G_, int c_, int acol) {
    A = (const char*)A_; Bt = (const char*)Bt_; lda_ = ldaa; ldb_ = ldbb; nM = M / 256; nN = N / 256; nwg = nM * nN; G = G_; c = c_; a_col_bytes_per_pn = acol; }
  __device__ __forceinline__ bool next(int i, FUnit& u) const {
    const long L = (long)i * G + c; if (L >= nwg) return false;
    int wgid = (int)L; { const int q = nwg / 8, r = nwg % 8, xcd = wgid % 8, off = wgid / 8; wgid = (xcd < r ? xcd * (q + 1) : r * (q + 1) + (xcd - r) * q) + off; }
    const int nig = 8 * nN, gid = wgid / nig, fm = gid * 8, gsz = (nM - fm) < 8 ? (nM - fm) : 8;
    u.pm = fm + ((wgid % nig) % gsz); u.pn = (wgid % nig) / gsz; u.e = 0; u.pos0 = 0; u.nvalid = 256; return true;
  }
  static constexpr bool GATHER = false;
  __device__ __forceinline__ unsigned lda() const { return (unsigned)lda_; }
  __device__ __forceinline__ unsigned ldb() const { return (unsigned)ldb_; }
  __device__ __forceinline__ const char* a_ptr(const FUnit& u) const { return A + (size_t)u.pm * 256 * lda_ * 2 + (size_t)u.pn * a_col_bytes_per_pn; }
  __device__ __forceinline__ void a_offs(const FUnit&, int, unsigned (&)[2][2]) const {}
  __device__ __forceinline__ const char* b_ptr(const FUnit& u) const { return Bt + (size_t)u.pn * 256 * ldb_ * 2; }
};

struct EpiProj {
  char* ws;
  __device__ __forceinline__ void operator()(const f32x4 (&acc)[2][2][4][2], const FUnit& u, int wr, int wc, int fr, int fq, int lane) const {
    const float* rs0 = (const float*)(ws + OFF_RS0);
    bf16_t* proj = (bf16_t*)(ws + OFF_R2);
    float scv[2][4];
#pragma unroll
    for (int ai = 0; ai < 2; ++ai)
#pragma unroll
      for (int m = 0; m < 4; ++m) scv[ai][m] = rs0[u.pm * 256 + ai * 128 + wr * 64 + m * 16 + fr];
#pragma unroll
    for (int ai = 0; ai < 2; ++ai)
#pragma unroll
      for (int m = 0; m < 4; ++m) {
        const int row = u.pm * 256 + ai * 128 + wr * 64 + m * 16 + fr;
        const float sc = scv[ai][m];
#pragma unroll
        for (int bj = 0; bj < 2; ++bj) {
          const int col0 = u.pn * 256 + bj * 128 + wc * 32 + fq * 8;
          const f32x4 v0 = acc[ai][bj][m][0] * sc, v1 = acc[ai][bj][m][1] * sc;
          u32x4 w4; w4.x = cvt_pk_bf16(v0[0], v0[1]); w4.y = cvt_pk_bf16(v0[2], v0[3]); w4.z = cvt_pk_bf16(v1[0], v1[1]); w4.w = cvt_pk_bf16(v1[2], v1[3]);
          *(u32x4*)(proj + (long)row * PROJ_LD + col0) = w4;
          if (u.pn == 7 && bj == 1 && wc == 1 && fq == 0) {
            float* d = (float*)(ws + OFF_DTRAW) + (long)row * 8;
            *(f32x4*)d = v0; *(f32x4*)(d + 4) = v1;
          }
          if (u.pn == 0 || (u.pn == 1 && bj == 0)) {
            float ss = v0[0] * v0[0] + v0[1] * v0[1] + v0[2] * v0[2] + v0[3] * v0[3] + v1[0] * v1[0] + v1[1] * v1[1] + v1[2] * v1[2] + v1[3] * v1[3];
            ss += sxor<16>(ss); ss += lane_get(ss, lane ^ 32);
            if (fq == 0) {
              if (u.pn == 0) ((float*)(ws + OFF_SSQ_Q))[row * 8 + bj * 4 + wc] = ss;
              else ((float*)(ws + OFF_SSQ_KV))[row * 4 + wc] = ss;
            }
          }
        }
      }
  }
};

template <int MODE>
struct EpiRes {
  char* ws; const float* xin; float* ssq; const float* pb; const float* psc; float f;
  __device__ __forceinline__ void operator()(const f32x4 (&acc)[2][2][4][2], const FUnit& u, int wr, int wc, int fr, int fq, int lane) const {
    bf16_t* xcb = (bf16_t*)(ws + OFF_XCB);
#pragma unroll
    for (int bj = 0; bj < 2; ++bj) {
      const int col0 = u.pn * 256 + bj * 128 + wc * 32 + fq * 8;
      f32x4 b0 = zero4(), b1 = b0, s0 = (f32x4){1.f, 1.f, 1.f, 1.f}, s1 = s0;
      if (MODE == 2) { b0 = *(const f32x4*)(pb + col0); b1 = *(const f32x4*)(pb + col0 + 4); s0 = *(const f32x4*)(psc + col0); s1 = *(const f32x4*)(psc + col0 + 4); }
      f32x4 base0[2][4], base1[2][4];
#pragma unroll
      for (int ai = 0; ai < 2; ++ai)
#pragma unroll
        for (int m = 0; m < 4; ++m) {
          const int row = u.pm * 256 + ai * 128 + wr * 64 + m * 16 + fr;
          if (MODE == 0) {
            const float* bp = xin + (long)row * 1024 + col0;
            base0[ai][m] = *(const f32x4*)bp; base1[ai][m] = *(const f32x4*)(bp + 4);
          } else {
            const u32x4 bu = *(const u32x4*)(xcb + (long)row * 1024 + col0);
            base0[ai][m] = (f32x4){bflo(bu.x), bfhi(bu.x), bflo(bu.y), bfhi(bu.y)};
            base1[ai][m] = (f32x4){bflo(bu.z), bfhi(bu.z), bflo(bu.w), bfhi(bu.w)};
          }
        }
#pragma unroll
      for (int ai = 0; ai < 2; ++ai)
#pragma unroll
        for (int m = 0; m < 4; ++m) {
          const int row = u.pm * 256 + ai * 128 + wr * 64 + m * 16 + fr;
          f32x4 a0 = acc[ai][bj][m][0], a1 = acc[ai][bj][m][1];
          if (MODE == 2) { a0 = (a0 + b0) * s0; a1 = (a1 + b1) * s1; }
          const float ff = (MODE == 0) ? 1.f : f;
          const f32x4 v0 = base0[ai][m] + a0 * ff, v1 = base1[ai][m] + a1 * ff;
          u32x4 w4; w4.x = cvt_pk_bf16(v0[0], v0[1]); w4.y = cvt_pk_bf16(v0[2], v0[3]); w4.z = cvt_pk_bf16(v1[0], v1[1]); w4.w = cvt_pk_bf16(v1[2], v1[3]);
          *(u32x4*)(xcb + (long)row * 1024 + col0) = w4;
          const float r0 = bflo(w4.x), r1 = bfhi(w4.x), r2 = bflo(w4.y), r3 = bfhi(w4.y), r4 = bflo(w4.z), r5 = bfhi(w4.z), r6 = bflo(w4.w), r7 = bfhi(w4.w);
          float ss = r0 * r0 + r1 * r1 + r2 * r2 + r3 * r3 + r4 * r4 + r5 * r5 + r6 * r6 + r7 * r7;
          ss += sxor<16>(ss); ss += lane_get(ss, lane ^ 32);
          if (fq == 0) ssq[row * 32 + (u.pn * 2 + bj) * 4 + wc] = ss;
        }
    }
  }
};

struct TJob { const float* src; int K, N; bf16_t* dst; int dst_ld, grp, grp_pad, goff; const float* gain; };
__device__ __forceinline__ void tstrip_load(const TJob& j, int tk, int tn, int t, float4 (&v)[8]) {
  const int k0 = tk * 64, n0 = tn * 256, c4 = (t & 63) * 4;
#pragma unroll
  for (int i = 0; i < 8; ++i) {
    const int r = (t >> 6) + 8 * i;
    float4 x = make_float4(0.f, 0.f, 0.f, 0.f);
    if (n0 + c4 < j.N) x = *(const float4*)(j.src + (long)(k0 + r) * j.N + n0 + c4);
    const float g = j.gain ? j.gain[k0 + r] : 1.f;
    v[i] = make_float4(x.x * g, x.y * g, x.z * g, x.w * g);
  }
}
__device__ __forceinline__ void tstrip_to_lds(int t, const float4 (&v)[8], float* tl) {
  const int c4 = (t & 63) * 4;
#pragma unroll
  for (int i = 0; i < 8; ++i) {
    const int r = (t >> 6) + 8 * i;
    tl[r * 257 + c4 + 0] = v[i].x; tl[r * 257 + c4 + 1] = v[i].y; tl[r * 257 + c4 + 2] = v[i].z; tl[r * 257 + c4 + 3] = v[i].w;
  }
}
__device__ __forceinline__ void tstrip_store(const TJob& j, int tk, int tn, int t, const float* tl) {
  const int k0 = tk * 64, n0 = tn * 256;
  const int n = n0 + (t >> 1);
  if (n < j.N) {
    const int drow = (n / j.grp) * j.grp_pad + j.goff + (n % j.grp);
    const int kk = (t & 1) * 32;
    bf16_t* d = j.dst + (long)drow * j.dst_ld + k0 + kk;
#pragma unroll
    for (int q = 0; q < 4; ++q) {
      unsigned u[4];
#pragma unroll
      for (int jj = 0; jj < 4; ++jj) u[jj] = pack2(tl[(kk + q * 8 + 2 * jj) * 257 + (t >> 1)], tl[(kk + q * 8 + 2 * jj + 1) * 257 + (t >> 1)]);
      *(uint4*)(d + q * 8) = make_uint4(u[0], u[1], u[2], u[3]);
    }
  }
}

constexpr int N_TJOBS = 5 + 4 + 6 + 192;
constexpr int N_TJOBS_PREP = 15;
__device__ __forceinline__ TJob get_tjob(int idx, const Ctx& c, char* ws) {
  constexpr int BIG = 1 << 30;
  TJob j;
  if (idx == 0) j = {INP(I_W_IN), 1024, 1960, (bf16_t*)(ws + OFF_WIN_T), 1024, BIG, 0, 0, INP(I_LN_MIX)};
  else if (idx == 1) j = {INP(I_W_UQ), 256, 768, (bf16_t*)(ws + OFF_WUQ_T), 256, 96, 128, 0, INP(I_QLAT_NORM)};
  else if (idx == 2) j = {INP(I_W_UKV), 128, 1024, (bf16_t*)(ws + OFF_WUKV_T), 256, BIG, 0, 0, INP(I_KVLAT_NORM)};
  else if (idx == 3) j = {INP(I_W_OUT), 512, 1024, (bf16_t*)(ws + OFF_WOUT_T), 1024, BIG, 0, 0, nullptr};
  else if (idx == 4) j = {INP(I_W_OUT) + 512 * 1024, 512, 1024, (bf16_t*)(ws + OFF_WOUT_T) + 512, 1024, BIG, 0, 0, INP(I_SSD_NORM)};
  else if (idx < 9) { const int g = idx - 5; j = {INP(I_POOL_W) + g * 65536, 256, 256, (bf16_t*)(ws + OFF_POOL_T) + g * 65536, 256, BIG, 0, 0, INP(I_LN_MIX) + 1024 + g * 256}; }
  else if (idx < 15) {
    const int l = (idx - 9) / 3, k = (idx - 9) % 3;
    if (k == 0) j = {INP(I_XQ_W) + l * 1024 * 256, 1024, 256, (bf16_t*)(ws + OFF_XQ_T) + l * 256 * 1024, 1024, BIG, 0, 0, INP(I_LN_XQ) + l * 1024};
    else if (k == 1) j = {INP(I_XKV_W) + l * 1024 * 512, 1024, 512, (bf16_t*)(ws + OFF_XKV_T) + l * 512 * 1024, 1024, BIG, 0, 0, INP(I_LN_MEM) + l * 1024};
    else j = {INP(I_XO_W) + l * 256 * 1024, 256, 1024, (bf16_t*)(ws + OFF_XO_T) + l * 1024 * 256, 256, BIG, 0, 0, nullptr};
  } else {
    const int le = (idx - 15) / 3, k = (idx - 15) % 3, l = le >> 5;
    const long wo = (long)le * 1024 * 256;
    if (k == 0) j = {INP(I_EXP_G) + wo, 1024, 256, (bf16_t*)(ws + OFF_WGU_T) + (long)le * 512 * 1024, 1024, 4, 8, 0, INP(I_LN_FFN) + l * 1024};
    else if (k == 1) j = {INP(I_EXP_U) + wo, 1024, 256, (bf16_t*)(ws + OFF_WGU_T) + (long)le * 512 * 1024, 1024, 4, 8, 4, INP(I_LN_FFN) + l * 1024};
    else j = {INP(I_EXP_D) + wo, 256, 1024, (bf16_t*)(ws + OFF_WD_T) + (long)le * 1024 * 256, 256, BIG, 0, 0, nullptr};
  }
  return j;
}

__device__ __forceinline__ void phase_prep(const Ctx& c) {
  char* ws = c.ws; char* smem = c.smem; const int bid = c.bid, nblk = c.nblk;
  float* tl = (float*)smem;
  {
    int ji = 0, base = 0, f = bid;
    TJob j = get_tjob(0, c, ws);
    int tilesN = (j.N + 255) / 256, ntiles = tilesN * (j.K / 64);
    float4 v[8];
    bool have = false; TJob jc = j; int tkc = 0, tnc = 0;
#define T_SEEK() { while (ji < N_TJOBS_PREP && f >= base + ntiles) { base += ntiles; ++ji; if (ji < N_TJOBS_PREP) { j = get_tjob(ji, c, ws); tilesN = (j.N + 255) / 256; ntiles = tilesN * (j.K / 64); } } }
    T_SEEK()
    if (ji < N_TJOBS_PREP) { jc = j; tkc = (f - base) / tilesN; tnc = (f - base) % tilesN; tstrip_load(jc, tkc, tnc, c.tid, v); have = true; }
    while (have) {
      tstrip_to_lds(c.tid, v, tl);
      __syncthreads();
      const TJob jd = jc; const int tkd = tkc, tnd = tnc;
      f += nblk;
      T_SEEK()
      have = ji < N_TJOBS_PREP;
      if (have) { jc = j; tkc = (f - base) / tilesN; tnc = (f - base) % tilesN; tstrip_load(jc, tkc, tnc, c.tid, v); }
      tstrip_store(jd, tkd, tnd, c.tid, tl);
      __syncthreads();
    }
#undef T_SEEK
  }
  {
    const int gt = bid * NTHR + c.tid, gn = nblk * NTHR;
    uint4 z = make_uint4(0, 0, 0, 0);
    bf16_t* w1 = (bf16_t*)(ws + OFF_WIN_T) + 1960l * 1024;
    for (int i = gt; i < 88 * 1024 / 8; i += gn) *(uint4*)(w1 + i * 8) = z;
    bf16_t* w2 = (bf16_t*)(ws + OFF_WUQ_T);
    for (int i = gt; i < 8 * 32 * 256 / 8; i += gn) {
      const int e = i * 8, h = e / (32 * 256), rem = e % (32 * 256);
      *(uint4*)(w2 + (long)(h * 128 + 96) * 256 + rem) = z;
    }
    bf16_t* w3 = (bf16_t*)(ws + OFF_WUKV_T);
    for (int i = gt; i < 1024 * 128 / 8; i += gn) *(uint4*)(w3 + (long)(i >> 4) * 256 + 128 + (i & 15) * 8) = z;
    if (gt < 128) ((int*)(ws + OFF_CTL))[gt] = 0;
    bf16_t* wr = (bf16_t*)(ws + OFF_WR);
    for (int i = gt; i < 2 * 48 * 1024; i += gn) {
      const int l = i / (48 * 1024), o = (i / 1024) % 48, k = i % 1024;
      float w = 0.f;
      if (o < 4) w = INP(I_RG_W)[(l * 1024 + k) * 4 + o];
      else if (o < 36) w = INP(I_RE_W)[(l * 1024 + k) * 32 + (o - 4)];
      w *= INP(I_LN_FFN)[l * 1024 + k];
      const bf16_t hi = f2bf(w);
      wr[((l * 2 + 0) * 48 + o) * 1024 + k] = hi;
      wr[((l * 2 + 1) * 48 + o) * 1024 + k] = f2bf(w - bf2f(hi));
    }
  }
  {
    const int lane = c.tid & 63;
    const int gw = bid * NWAV + (c.tid >> 6), nw = nblk * NWAV;
    for (int row0 = gw * 2; row0 < NT + 4096; row0 += nw * 2) {
      float4 v[2][4];
#pragma unroll
      for (int q = 0; q < 2; ++q) {
        const int row = row0 + q; const bool ism = row >= NT; const int r = ism ? row - NT : row;
        const float* src = (ism ? INP(I_MEM) : INP(I_X)) + (long)r * 1024;
#pragma unroll
        for (int i = 0; i < 4; ++i) v[q][i] = *(const float4*)(src + i * 256 + lane * 4);
      }
#pragma unroll
      for (int q = 0; q < 2; ++q) {
        const int row = row0 + q; const bool ism = row >= NT; const int r = ism ? row - NT : row;
        bf16_t* dst = (bf16_t*)(ws + (ism ? OFF_MEMB : OFF_R1)) + (long)r * 1024;
        float ss = 0.f;
#pragma unroll
        for (int i = 0; i < 4; ++i) {
          const float4 x = v[q][i];
          ss += x.x * x.x + x.y * x.y + x.z * x.z + x.w * x.w;
          *(uint2*)(dst + i * 256 + lane * 4) = make_uint2(pack2(x.x, x.y), pack2(x.z, x.w));
        }
        ss = wave_sum(ss, lane);
        if (lane == 0) ((float*)(ws + (ism ? OFF_RSM : OFF_RS0)))[r] = rsqrtf(ss * (1.f / 1024.f) + EPS);
      }
    }
  }
}

__device__ __forceinline__ float cs_ssq(const float* crow, int n) {
  float ss = 0.f;
  for (int j = 0; j < n; j += 4) { const float4 c = *(const float4*)(crow + j); ss += c.x * c.x + c.y * c.y + c.z * c.z + c.w * c.w; }
  return ss;
}
__device__ __forceinline__ void cs_store_scaled(bf16_t* dst, const float* crow, int n, float sc, const float* g) {
  for (int j = 0; j < n; j += 8) {
    float4 a = *(const float4*)(crow + j), b = *(const float4*)(crow + j + 4);
    if (g) {
      const float4 ga = *(const float4*)(g + j), gb = *(const float4*)(g + j + 4);
      a.x *= ga.x; a.y *= ga.y; a.z *= ga.z; a.w *= ga.w; b.x *= gb.x; b.y *= gb.y; b.z *= gb.z; b.w *= gb.w;
    }
    *(uint4*)(dst + j) = make_uint4(pack2(a.x * sc, a.y * sc), pack2(a.z * sc, a.w * sc), pack2(b.x * sc, b.y * sc), pack2(b.z * sc, b.w * sc));
  }
}
__device__ __forceinline__ float row_rs32(const float* ssq, int row) {
  const float4* q = (const float4*)(ssq + (long)row * 32);
  float s = 0.f;
#pragma unroll
  for (int i = 0; i < 8; ++i) { const float4 v = q[i]; s += (v.x + v.y) + (v.z + v.w); }
  return rsqrtf(s * (1.f / 1024.f) + EPS);
}
__device__ __forceinline__ void rope_cs(float pos, int i, float& c, float& s) {
  const float ang = pos * exp2f(-(float)i * 0.8304820237218406f);
  float u = ang * 0.15915494309189535f;
  u -= rintf(u);
  c = __builtin_amdgcn_cosf(u);
  s = __builtin_amdgcn_sinf(u);
}


constexpr int XS_BASE = 128 * 1024, XS_PART = XS_BASE, XS_ROW = XS_BASE + 2 * 256 * 8 * 4;
__device__ __forceinline__ void xs_barrier() { asm volatile("s_waitcnt lgkmcnt(0)" ::: "memory"); __builtin_amdgcn_s_barrier(); asm volatile("" ::: "memory"); }
__device__ __forceinline__ void xs_put_parts(const f32x4 (&acc)[2][2][4][2], float* part, int wr, int wc, int fr, int fq, int lane) {
#pragma unroll
  for (int ai = 0; ai < 2; ++ai)
#pragma unroll
    for (int m = 0; m < 4; ++m)
#pragma unroll
      for (int bj = 0; bj < 2; ++bj) {
        const f32x4 a0 = acc[ai][bj][m][0], a1 = acc[ai][bj][m][1];
        float ss = a0[0] * a0[0] + a0[1] * a0[1] + a0[2] * a0[2] + a0[3] * a0[3] + a1[0] * a1[0] + a1[1] * a1[1] + a1[2] * a1[2] + a1[3] * a1[3];
        ss += sxor<16>(ss); ss += lane_get(ss, lane ^ 32);
        if (fq == 0) part[(ai * 128 + wr * 64 + m * 16 + fr) * 8 + bj * 4 + wc] = ss;
      }
}

struct EpiXq {
  char* ws; char* smem; const float* g; int tid; mutable int par;
  __device__ __forceinline__ void operator()(const f32x4 (&acc)[2][2][4][2], const FUnit& u, int wr, int wc, int fr, int fq, int lane) const {
    float* part = (float*)(smem + XS_PART) + par * 2048; float* rowsc = (float*)(smem + XS_ROW) + par * 512;
    if (tid < 256) rowsc[tid] = row_rs32((const float*)(ws + OFF_SSQA), u.pm * 256 + tid);
    xs_put_parts(acc, part, wr, wc, fr, fq, lane);
    xs_barrier();
    bf16_t* xq = (bf16_t*)(ws + OFF_XQ);
    const f32x4 g0 = *(const f32x4*)(g + (wc & 1) * 32 + fq * 8), g1 = *(const f32x4*)(g + (wc & 1) * 32 + fq * 8 + 4);
#pragma unroll
    for (int ai = 0; ai < 2; ++ai)
#pragma unroll
      for (int m = 0; m < 4; ++m) {
        const int rl = ai * 128 + wr * 64 + m * 16 + fr;
        const float rs = rowsc[rl];
#pragma unroll
        for (int bj = 0; bj < 2; ++bj) {
          const float ssh = (part[rl * 8 + bj * 4 + (wc & 2)] + part[rl * 8 + bj * 4 + (wc | 1)]) * rs * rs;
          const float sc = rsqrtf(ssh * (1.f / 64.f) + EPS) * rs * (0.125f * LOG2E);
          const f32x4 v0 = acc[ai][bj][m][0] * g0 * sc, v1 = acc[ai][bj][m][1] * g1 * sc;
          u32x4 w4; w4.x = cvt_pk_bf16(v0[0], v0[1]); w4.y = cvt_pk_bf16(v0[2], v0[3]); w4.z = cvt_pk_bf16(v1[0], v1[1]); w4.w = cvt_pk_bf16(v1[2], v1[3]);
          *(u32x4*)(xq + (long)(u.pm * 256 + rl) * 256 + bj * 128 + wc * 32 + fq * 8) = w4;
        }
      }
    par ^= 1;
  }
};

struct EpiQ {
  char* ws; char* smem; const float* g; const int* positions; int tid; mutable int par;
  __device__ __forceinline__ void operator()(const f32x4 (&acc)[2][2][4][2], const FUnit& u, int wr, int wc, int fr, int fq, int lane) const {
    float* part = (float*)(smem + XS_PART) + par * 2048; float* rowsc = (float*)(smem + XS_ROW) + par * 512;
    if (tid < 256) {
      const float* sq = (const float*)(ws + OFF_SSQ_Q) + (long)(u.pm * 256 + tid) * 8;
      rowsc[tid] = rsqrtf(((sq[0] + sq[1]) + (sq[2] + sq[3]) + (sq[4] + sq[5]) + (sq[6] + sq[7])) * (1.f / 256.f) + EPS);
    }
    xs_put_parts(acc, part, wr, wc, fr, fq, lane);
    xs_barrier();
    if (wc < 3) {
      bf16_t* qo = (bf16_t*)(ws + OFF_Q);
      const int c0 = wc * 32 + fq * 8;
      float posv[2][4];
#pragma unroll
      for (int ai = 0; ai < 2; ++ai)
#pragma unroll
        for (int m = 0; m < 4; ++m) posv[ai][m] = (wc == 2) ? (float)positions[u.pm * 256 + ai * 128 + wr * 64 + m * 16 + fr] : 0.f;
      const f32x4 g0 = *(const f32x4*)(g + c0), g1 = *(const f32x4*)(g + c0 + 4);
      const float qs = 0.10206207261596577f * LOG2E;
#pragma unroll
      for (int ai = 0; ai < 2; ++ai)
#pragma unroll
        for (int m = 0; m < 4; ++m) {
          const int rl = ai * 128 + wr * 64 + m * 16 + fr;
          const int row = u.pm * 256 + rl, b = row >> 12, sq_ = row & 4095;
          const float rq = rowsc[rl];
          float cs[8], sn[8];
          if (wc == 2) {
            const float pos = posv[ai][m];
#pragma unroll
            for (int j = 0; j < 8; ++j) rope_cs(pos, (fq & 1) * 8 + j, cs[j], sn[j]);
          }
#pragma unroll
          for (int bj = 0; bj < 2; ++bj) {
            const float ssh = (part[rl * 8 + bj * 4] + part[rl * 8 + bj * 4 + 1] + part[rl * 8 + bj * 4 + 2]) * rq * rq;
            const float sc = rsqrtf(ssh * (1.f / 96.f) + EPS) * rq * qs;
            f32x4 v0 = acc[ai][bj][m][0] * g0 * sc, v1 = acc[ai][bj][m][1] * g1 * sc;
            if (wc == 2) {
              float o[8];
#pragma unroll
              for (int j = 0; j < 8; ++j) {
                const float own = j < 4 ? v0[j] : v1[j - 4];
                const float oth = lane_get(own, lane ^ 32);
                o[j] = (fq < 2) ? (own * cs[j] - oth * sn[j]) : (own * cs[j] + oth * sn[j]);
              }
              v0 = (f32x4){o[0], o[1], o[2], o[3]}; v1 = (f32x4){o[4], o[5], o[6], o[7]};
            }
            u32x4 w4; w4.x = cvt_pk_bf16(v0[0], v0[1]); w4.y = cvt_pk_bf16(v0[2], v0[3]); w4.z = cvt_pk_bf16(v1[0], v1[1]); w4.w = cvt_pk_bf16(v1[2], v1[3]);
            *(u32x4*)(qo + ((long)(b * 8 + u.pn * 2 + bj) * 4096 + sq_) * 96 + c0) = w4;
          }
        }
    }
    par ^= 1;
  }
};

struct EpiKV {
  char* ws; char* smem; const float* g; const int* positions; int tid; mutable int par;
  __device__ __forceinline__ void operator()(const f32x4 (&acc)[2][2][4][2], const FUnit& u, int wr, int wc, int fr, int fq, int lane) const {
    float* part = (float*)(smem + XS_PART) + par * 2048; float* rowsc = (float*)(smem + XS_ROW) + par * 512;
    const bf16_t* proj = (const bf16_t*)(ws + OFF_R2);
    if (tid < 256) {
      const int row = u.pm * 256 + tid;
      const float* sk = (const float*)(ws + OFF_SSQ_KV) + (long)row * 4;
      rowsc[tid] = rsqrtf(((sk[0] + sk[1]) + (sk[2] + sk[3])) * (1.f / 128.f) + EPS);
      const bf16_t* kp = proj + (long)row * PROJ_LD + C_KROPE;
      float ss = 0.f;
#pragma unroll
      for (int j = 0; j < 32; j += 8) {
        const uint4 q4 = *(const uint4*)(kp + j);
        ss += bflo(q4.x) * bflo(q4.x) + bfhi(q4.x) * bfhi(q4.x) + bflo(q4.y) * bflo(q4.y) + bfhi(q4.y) * bfhi(q4.y)
            + bflo(q4.z) * bflo(q4.z) + bfhi(q4.z) * bfhi(q4.z) + bflo(q4.w) * bflo(q4.w) + bfhi(q4.w) * bfhi(q4.w);
      }
      rowsc[256 + tid] = ss;
    }
    xs_put_parts(acc, part, wr, wc, fr, fq, lane);
    xs_barrier();
    bf16_t* ko = (bf16_t*)(ws + OFF_K);
    bf16_t* vo = (bf16_t*)(ws + OFF_VT);
#pragma unroll
    for (int ai = 0; ai < 2; ++ai)
#pragma unroll
      for (int m = 0; m < 4; ++m) {
        const int rl = ai * 128 + wr * 64 + m * 16 + fr;
        const int row = u.pm * 256 + rl, b = row >> 12, sq_ = row & 4095;
        const float rkv = rowsc[rl], krs = rowsc[256 + rl];
        if (wc < 2) {
          const int c0 = wc * 32 + fq * 8;
          const f32x4 g0 = *(const f32x4*)(g + c0), g1 = *(const f32x4*)(g + c0 + 4);
#pragma unroll
          for (int bj = 0; bj < 2; ++bj) {
            const float ssh = (part[rl * 8 + bj * 4] + part[rl * 8 + bj * 4 + 1]) * rkv * rkv + krs;
            const float sc = rsqrtf(ssh * (1.f / 96.f) + EPS) * rkv;
            const f32x4 v0 = acc[ai][bj][m][0] * g0 * sc, v1 = acc[ai][bj][m][1] * g1 * sc;
            u32x4 w4; w4.x = cvt_pk_bf16(v0[0], v0[1]); w4.y = cvt_pk_bf16(v0[2], v0[3]); w4.z = cvt_pk_bf16(v1[0], v1[1]); w4.w = cvt_pk_bf16(v1[2], v1[3]);
            *(u32x4*)(ko + ((long)(b * 8 + u.pn * 2 + bj) * 4096 + sq_) * 96 + c0) = w4;
          }
        } else {
#pragma unroll
          for (int bj = 0; bj < 2; ++bj) {
            const f32x4 v0 = acc[ai][bj][m][0] * rkv, v1 = acc[ai][bj][m][1] * rkv;
            u32x4 w4; w4.x = cvt_pk_bf16(v0[0], v0[1]); w4.y = cvt_pk_bf16(v0[2], v0[3]); w4.z = cvt_pk_bf16(v1[0], v1[1]); w4.w = cvt_pk_bf16(v1[2], v1[3]);
            *(u32x4*)(vo + ((long)(b * 8 + u.pn * 2 + bj) * 4096 + sq_) * 64 + (wc - 2) * 32 + fq * 8) = w4;
          }
          const int hb = wc - 2;
          const float ssh = (part[rl * 8 + hb * 4] + part[rl * 8 + hb * 4 + 1]) * rkv * rkv + krs;
          const float r = rsqrtf(ssh * (1.f / 96.f) + EPS);
          const bf16_t* kp = proj + (long)row * PROJ_LD + C_KROPE;
          const int i0 = (fq & 1) * 8;
          const uint4 ua = *(const uint4*)(kp + i0), ub = *(const uint4*)(kp + 16 + i0);
          const float k1[8] = {bflo(ua.x), bfhi(ua.x), bflo(ua.y), bfhi(ua.y), bflo(ua.z), bfhi(ua.z), bflo(ua.w), bfhi(ua.w)};
          const float k2[8] = {bflo(ub.x), bfhi(ub.x), bflo(ub.y), bfhi(ub.y), bflo(ub.z), bfhi(ub.z), bflo(ub.w), bfhi(ub.w)};
          const float pos = (float)positions[row];
          float o[8];
#pragma unroll
          for (int j = 0; j < 8; ++j) {
            float cc, sn; rope_cs(pos, i0 + j, cc, sn);
            const float u1 = k1[j] * r * g[64 + i0 + j], u2 = k2[j] * r * g[80 + i0 + j];
            o[j] = (fq < 2) ? (u1 * cc - u2 * sn) : (u2 * cc + u1 * sn);
          }
          u32x4 w4; w4.x = cvt_pk_bf16(o[0], o[1]); w4.y = cvt_pk_bf16(o[2], o[3]); w4.z = cvt_pk_bf16(o[4], o[5]); w4.w = cvt_pk_bf16(o[6], o[7]);
          *(u32x4*)(ko + ((long)(b * 8 + u.pn * 2 + hb) * 4096 + sq_) * 96 + 64 + fq * 8) = w4;
        }
      }
    par ^= 1;
  }
};

__device__ __forceinline__ void phase_gemm_in(const Ctx& c) {
  char* ws = c.ws; char* smem = c.smem; const int bid = c.bid, nblk = c.nblk;
  {
    DenseOrder S; S.init(ws + OFF_R1, 1024, ws + OFF_WIN_T, 1024, NT, 2048, nblk, bid, 0);
    EpiProj E{ws};
    fast_gemm(( LAS3 unsigned char*)smem, S, E, 1024, c.tid);
  }
  __syncthreads();
  const int t = c.tid, er = t >> 1, eh = t & 1;
  const float* crow = (const float*)smem + er * CS_LD + eh * 64;
  for (int it = bid; it < 2 * 32 * 4; it += nblk) {
    const int l = it >> 7, mt = (it >> 2) & 31, nt = it & 3;
    gemm_dense((const bf16_t*)(ws + OFF_MEMB) + (long)mt * 128 * 1024, 1024,
               (const bf16_t*)(ws + OFF_XKV_T) + (long)l * 512 * 1024 + (long)nt * 128 * 1024, 1024, 1024, smem, c.tid);
    if (t < 256) {
      const int row = mt * 128 + er;
      const float sc = ((const float*)(ws + OFF_RSM))[row];
      if (nt < 2) {
        const int head = nt * 2 + eh;
        const float ss = cs_ssq(crow, 64) * sc * sc;
        const float r = rsqrtf(ss * (1.f / 64.f) + EPS) * sc;
        cs_store_scaled((bf16_t*)(ws + OFF_MEMK) + (long)l * 4096 * 256 + (long)row * 256 + head * 64, crow, 64, r, INP(I_XK_NORM) + l * 64);
      } else {
        const int head = (nt - 2) * 2 + eh;
        cs_store_scaled((bf16_t*)(ws + OFF_MEMVT) + (long)l * 4096 * 256 + (long)row * 256 + head * 64, crow, 64, sc, nullptr);
      }
    }
    __syncthreads();
  }
}

__device__ __forceinline__ void phase_up(const Ctx& c0) {
  const int odd = c0.bid & 1;
#pragma unroll 1
  for (int st = 0; st < 3; ++st) {
    const int step = odd ? (st + 2) % 3 : st;
    int tidl = c0.tid; asm volatile("" : "+v"(tidl));
    size_t wzl = 0; asm volatile("" : "+s"(wzl));
    const Ctx c{c0.p, c0.ws + wzl, c0.smem, tidl, c0.bid, c0.nblk, c0.f, c0.pass};
    char* ws = c.ws; char* smem = c.smem; const int bid = c.bid, nblk = c.nblk; (void)smem; (void)bid; (void)nblk;
    const int t = c.tid;
    const bf16_t* proj = (const bf16_t*)(ws + OFF_R2);
    const int* positions = (const int*)c.p.in[opq(I_POS)];
    if (step == 0) {
      DenseOrder S; S.init(ws + OFF_R2 + C_QLAT * 2, PROJ_LD, ws + OFF_WUQ_T, 256, NT, 1024, nblk, bid, 0);
      EpiQ E{ws, smem, INP(I_Q_NORM), positions, c.tid, 0};
      fast_gemm((LAS3 unsigned char*)smem, S, E, 256, c.tid);
    } else if (step == 1) {
      DenseOrder S; S.init(ws + OFF_R2 + C_KVLAT * 2, PROJ_LD, ws + OFF_WUKV_T, 256, NT, 1024, nblk, bid, 0);
      EpiKV E{ws, smem, INP(I_K_NORM), positions, c.tid, 0};
      fast_gemm((LAS3 unsigned char*)smem, S, E, 256, c.tid);
    } else {
  {
    const float* cw = INP(I_CONV_W);
    const float* cb = INP(I_CONV_B);
    bf16_t* xc = (bf16_t*)(ws + OFF_R4);
    const int ch = (t & 127) * 8, sub = t >> 7;
    float w0[8], w1[8], w2[8], w3[8], bs[8];
#pragma unroll
    for (int j = 0; j < 8; ++j) { w0[j] = cw[ch + j]; w1[j] = cw[1024 + ch + j]; w2[j] = cw[2048 + ch + j]; w3[j] = cw[3072 + ch + j]; bs[j] = cb[ch + j]; }
    for (int tb = bid; tb < NT / 256; tb += nblk) {
      const int tok0 = tb * 256 + sub * 64;
      const int s0 = tok0 & 4095;
      const bf16_t* src = proj + (long)tok0 * PROJ_LD + C_XBC + ch;
      float r0[8], r1[8], r2[8];
      {
        uint4 u0 = make_uint4(0, 0, 0, 0), u1 = u0, u2 = u0;
        if (s0 >= 3) u0 = *(const uint4*)(src - 3 * PROJ_LD);
        if (s0 >= 2) u1 = *(const uint4*)(src - 2 * PROJ_LD);
        if (s0 >= 1) u2 = *(const uint4*)(src - 1 * PROJ_LD);
        r0[0] = bflo(u0.x); r0[1] = bfhi(u0.x); r0[2] = bflo(u0.y); r0[3] = bfhi(u0.y); r0[4] = bflo(u0.z); r0[5] = bfhi(u0.z); r0[6] = bflo(u0.w); r0[7] = bfhi(u0.w);
        r1[0] = bflo(u1.x); r1[1] = bfhi(u1.x); r1[2] = bflo(u1.y); r1[3] = bfhi(u1.y); r1[4] = bflo(u1.z); r1[5] = bfhi(u1.z); r1[6] = bflo(u1.w); r1[7] = bfhi(u1.w);
        r2[0] = bflo(u2.x); r2[1] = bfhi(u2.x); r2[2] = bflo(u2.y); r2[3] = bfhi(u2.y); r2[4] = bflo(u2.z); r2[5] = bfhi(u2.z); r2[6] = bflo(u2.w); r2[7] = bfhi(u2.w);
      }
      for (int i0 = 0; i0 < 64; i0 += 8) {
        uint4 un[8];
#pragma unroll
        for (int q = 0; q < 8; ++q) un[q] = *(const uint4*)(src + (long)(i0 + q) * PROJ_LD);
#pragma unroll
        for (int q = 0; q < 8; ++q) {
          const float cur[8] = {bflo(un[q].x), bfhi(un[q].x), bflo(un[q].y), bfhi(un[q].y), bflo(un[q].z), bfhi(un[q].z), bflo(un[q].w), bfhi(un[q].w)};
          float a[8];
#pragma unroll
          for (int j = 0; j < 8; ++j) {
            a[j] = silu_f(bs[j] + w0[j] * r0[j] + w1[j] * r1[j] + w2[j] * r2[j] + w3[j] * cur[j]);
            r0[j] = r1[j]; r1[j] = r2[j]; r2[j] = cur[j];
          }
          *(uint4*)(xc + (long)(tok0 + i0 + q) * 1024 + ch) = make_uint4(pack2(a[0], a[1]), pack2(a[2], a[3]), pack2(a[4], a[5]), pack2(a[6], a[7]));
        }
      }
    }
    const long gt = (long)bid * NTHR + t, gn = (long)nblk * NTHR;
    const float* dtr = (const float*)(ws + OFF_DTRAW);
    float* dt = (float*)(ws + OFF_DT);
    for (long i = gt; i < (long)NT * 8; i += gn) {
      const float x = dtr[i] + INP(I_DT_BIAS)[i & 7];
      dt[i] = x > 20.f ? x : log1pf(__expf(x));
    }
  }
    }
    __syncthreads();
  }
}

typedef float f32x16 __attribute__((ext_vector_type(16)));
__device__ __forceinline__ f32x16 mfma32(bf16x8 a, bf16x8 b, f32x16 c) { return __builtin_amdgcn_mfma_f32_32x32x16_bf16(a, b, c, 0, 0, 0); }
template <int DQK, bool CAUSAL>
__device__ __forceinline__ void attn_block(const bf16_t* Q, long ldq, const bf16_t* K, long ldk, const bf16_t* V, long ldv, int ntiles, int q0,
                           bf16_t* O, long ldo, char* smem, int tid) {
  constexpr int KLD = DQK + 8, VLD = 160, NK16 = DQK / 16, KCH = DQK / 8;
  constexpr int KBUF = 64 * KLD + 64 * VLD;
  constexpr int NKC = (64 * KCH + NTHR - 1) / NTHR;
  const int t = tid, lane = t & 63, w = t >> 6, l31 = lane & 31, hh = lane >> 5, l15 = lane & 15;
  bf16_t* KV = (bf16_t*)smem;
  bf16x8 qf[NK16];
#pragma unroll
  for (int ks = 0; ks < NK16; ++ks) qf[ks] = *(const bf16x8*)(Q + (long)(w * 32 + l31) * ldq + ks * 16 + hh * 8);
  f32x16 oacc[2];
#pragma unroll
  for (int dt = 0; dt < 2; ++dt)
#pragma unroll
    for (int i = 0; i < 16; ++i) oacc[dt][i] = 0.f;
  float mrow = -1e30f, lrow = 0.f;
  u32x4 kr[NKC], vr;
  const int vrow = t >> 3, vcc = t & 7;
#define A_LOAD(KT) { \
    _Pragma("unroll") for (int i = 0; i < NKC; ++i) { const int c_ = t + NTHR * i; if (c_ < 64 * KCH) kr[i] = *(const u32x4*)(K + (long)((KT) * 64 + c_ / KCH) * ldk + (c_ % KCH) * 8); } \
    vr = *(const u32x4*)(V + (long)((KT) * 64 + vrow) * ldv + vcc * 8); }
#define A_STORE(ST) { bf16_t* Kd_ = KV + (ST) * KBUF; bf16_t* Vd_ = Kd_ + 64 * KLD; \
    _Pragma("unroll") for (int i = 0; i < NKC; ++i) { const int c_ = t + NTHR * i; if (c_ < 64 * KCH) *(u32x4*)(Kd_ + (c_ / KCH) * KLD + (c_ % KCH) * 8) = kr[i]; } \
    *(u32x4*)(Vd_ + vrow * VLD + vcc * 8) = vr; }
  A_LOAD(0)
  A_STORE(0)
  if (ntiles > 1) A_LOAD(1)
  __syncthreads();
  const int qrow = q0 + w * 32 + l31;
  for (int kt = 0; kt < ntiles; ++kt) {
    const bf16_t* Ks = KV + (kt & 1) * KBUF;
    const bf16_t* Vs = Ks + 64 * KLD;
    f32x16 sacc[2];
    {
      bf16x8 kfr[2][NK16];
#pragma unroll
      for (int T = 0; T < 2; ++T)
#pragma unroll
        for (int ks = 0; ks < NK16; ++ks) kfr[T][ks] = *(const bf16x8*)(Ks + (T * 32 + l31) * KLD + ks * 16 + hh * 8);
      __builtin_amdgcn_sched_barrier(0);
#pragma unroll
      for (int T = 0; T < 2; ++T) {
        const f32x16 zc = {0.f, 0.f, 0.f, 0.f, 0.f, 0.f, 0.f, 0.f, 0.f, 0.f, 0.f, 0.f, 0.f, 0.f, 0.f, 0.f};
        sacc[T] = mfma32(kfr[T][0], qf[0], zc);
#pragma unroll
        for (int ks = 1; ks < NK16; ++ks) sacc[T] = mfma32(kfr[T][ks], qf[ks], sacc[T]);
      }
    }
    s16x4 vfr[2][2][2][2];
#pragma unroll
    for (int T = 0; T < 2; ++T)
#pragma unroll
      for (int s2 = 0; s2 < 2; ++s2)
#pragma unroll
        for (int dt = 0; dt < 2; ++dt) {
          const bf16_t* vp = Vs + (T * 32 + 16 * s2 + 4 * hh + (l15 >> 2)) * VLD + dt * 32 + 16 * ((lane >> 4) & 1) + 4 * (l15 & 3);
          vfr[T][s2][dt][0] = __builtin_amdgcn_ds_read_tr16_b64_v4i16((__attribute__((address_space(3))) s16x4*)vp);
          vfr[T][s2][dt][1] = __builtin_amdgcn_ds_read_tr16_b64_v4i16((__attribute__((address_space(3))) s16x4*)(vp + 8 * VLD));
        }
    __builtin_amdgcn_sched_barrier(0);
    if (CAUSAL && (kt * 64 + 63 > q0 + w * 32)) {
#pragma unroll
      for (int T = 0; T < 2; ++T)
#pragma unroll
        for (int i = 0; i < 16; ++i) {
          const int key = kt * 64 + T * 32 + (i & 3) + 8 * (i >> 2) + 4 * hh;
          if (key > qrow) sacc[T][i] = -1e30f;
        }
    }
    float mx = sacc[0][0];
#pragma unroll
    for (int T = 0; T < 2; ++T)
#pragma unroll
      for (int i = 0; i < 16; ++i) mx = fmaxf(mx, sacc[T][i]);
    mx = fmaxf(mx, lane_get(mx, lane ^ 32));
    if (!__all(mx - mrow <= 8.f)) {
      const float mn = fmaxf(mrow, mx);
      const float alpha = __builtin_amdgcn_exp2f(mrow - mn);
      mrow = mn;
      lrow *= alpha;
#pragma unroll
      for (int dt = 0; dt < 2; ++dt)
#pragma unroll
        for (int i = 0; i < 16; ++i) oacc[dt][i] *= alpha;
    }
    float ps = 0.f;
#pragma unroll
    for (int T = 0; T < 2; ++T)
#pragma unroll
      for (int i = 0; i < 16; ++i) { const float pv = __builtin_amdgcn_exp2f(sacc[T][i] - mrow); sacc[T][i] = pv; ps += pv; }
    lrow += ps;
    {
#pragma unroll
      for (int T = 0; T < 2; ++T)
#pragma unroll
        for (int s2 = 0; s2 < 2; ++s2) {
          union { unsigned u[4]; bf16x8 v; } pf;
#pragma unroll
          for (int j = 0; j < 4; ++j) pf.u[j] = cvt_pk_bf16(sacc[T][8 * s2 + 2 * j], sacc[T][8 * s2 + 2 * j + 1]);
#pragma unroll
          for (int dt = 0; dt < 2; ++dt) {
            const s16x4 va = vfr[T][s2][dt][0], vb = vfr[T][s2][dt][1];
            const bf16x8 vf = (bf16x8){va[0], va[1], va[2], va[3], vb[0], vb[1], vb[2], vb[3]};
            oacc[dt] = mfma32(vf, pf.v, oacc[dt]);
          }
        }
    }
    if (kt + 1 < ntiles) {
      A_STORE((kt + 1) & 1)
      if (kt + 2 < ntiles) A_LOAD(kt + 2)
    }
    __syncthreads();
  }
#undef A_LOAD
#undef A_STORE
  lrow += lane_get(lrow, lane ^ 32);
  const float inv = 1.f / lrow;
  bf16_t* orow = O + (long)(w * 32 + l31) * ldo;
#pragma unroll
  for (int dt = 0; dt < 2; ++dt)
#pragma unroll
    for (int g4 = 0; g4 < 4; ++g4) {
      uint2 o2;
      o2.x = cvt_pk_bf16(oacc[dt][4 * g4] * inv, oacc[dt][4 * g4 + 1] * inv);
      o2.y = cvt_pk_bf16(oacc[dt][4 * g4 + 2] * inv, oacc[dt][4 * g4 + 3] * inv);
      *(uint2*)(orow + dt * 32 + 8 * g4 + 4 * hh) = o2;
    }
}

__device__ __forceinline__ void ssd_item(const Ctx& c, int b, int h) {
  char* ws = c.ws; char* smem = c.smem;
  const int t = c.tid, lane = t & 63, w = t >> 6, l15 = lane & 15, lq = lane >> 4;
  const int g = h >> 2;
  const int pw = w & 3, nq = (w >> 2) * 4;
  bf16_t* Cl = (bf16_t*)smem;
  bf16_t* Bl = Cl + 128 * 136;
  bf16_t* Ml = Bl + 128 * 136;
  bf16_t* Sl = Ml + 128 * 136;
  bf16_t* Xl = Sl + 64 * 136;
  float* fa = (float*)(Xl + 128 * 72);
  const bf16_t* xc = (const bf16_t*)(ws + OFF_R4);
  const bf16_t* proj = (const bf16_t*)(ws + OFF_R2);
  const float* dtp = (const float*)(ws + OFF_DT);
  bf16_t* AY = (bf16_t*)(ws + OFF_R1);
  const float a_h = -__expf(INP(I_A_LOG)[h]);
  const float dsk = INP(I_D_SKIP)[h];
  f32x4 st[4];
#pragma unroll
  for (int i = 0; i < 4; ++i) st[i] = zero4();
  u32x4 pc[4], pb[4], px[2]; float pd[2], pa0 = 0.f, pa1 = 0.f;
  u32x4 ox[2], oz[2];
#define S_LOAD(CK) { const long tn_ = (long)b * 4096 + (CK) * 128; \
    _Pragma("unroll") for (int i = 0; i < 4; ++i) { const int ch = t + NTHR * i, r = ch >> 4, cc = ch & 15; \
      pc[i] = *(const u32x4*)(xc + (tn_ + r) * 1024 + 768 + g * 128 + cc * 8); pb[i] = *(const u32x4*)(xc + (tn_ + r) * 1024 + 512 + g * 128 + cc * 8); } \
    _Pragma("unroll") for (int i = 0; i < 2; ++i) { const int ch = t + NTHR * i, r = ch >> 3, cc = ch & 7; \
      px[i] = *(const u32x4*)(xc + (tn_ + r) * 1024 + h * 64 + cc * 8); pd[i] = dtp[(tn_ + r) * 8 + h]; } \
    if (w == 0) { pa0 = dtp[(tn_ + 2 * lane) * 8 + h]; pa1 = dtp[(tn_ + 2 * lane + 1) * 8 + h]; } }
#define O_LOAD(CK) { const long tk_ = (long)b * 4096 + (CK) * 128 + w * 16 + (lane >> 2); const int sg_ = (lane & 3) * 16; \
    _Pragma("unroll") for (int j = 0; j < 2; ++j) { ox[j] = *(const u32x4*)(xc + tk_ * 1024 + h * 64 + sg_ + j * 8); oz[j] = *(const u32x4*)(proj + tk_ * PROJ_LD + C_Z + h * 64 + sg_ + j * 8); } }
  S_LOAD(0)
  O_LOAD(0)
  for (int ck = 0; ck < 32; ++ck) {
    const long t0 = (long)b * 4096 + ck * 128;
#pragma unroll
    for (int i = 0; i < 4; ++i) {
      const int ch = t + NTHR * i, r = ch >> 4, cc = ch & 15;
      *(u32x4*)(Cl + r * 136 + cc * 8) = pc[i];
      *(u32x4*)(Bl + r * 136 + cc * 8) = pb[i];
    }
#pragma unroll
    for (int i = 0; i < 2; ++i) {
      const int ch = t + NTHR * i, r = ch >> 3, cc = ch & 7;
      const u32x4 u = px[i]; const float d = pd[i];
      *(uint4*)(Xl + r * 72 + cc * 8) = make_uint4(pack2(bflo(u.x) * d, bfhi(u.x) * d), pack2(bflo(u.y) * d, bfhi(u.y) * d),
                                                   pack2(bflo(u.z) * d, bfhi(u.z) * d), pack2(bflo(u.w) * d, bfhi(u.w) * d));
    }
    if (w == 0) {
      const float a0 = pa0 * a_h, a1 = pa1 * a_h;
      const float pr = a0 + a1;
      float sc = pr;
#pragma unroll
      for (int o = 1; o < 64; o <<= 1) { const float n = lane_get(sc, (lane - o) & 63); if (lane >= o) sc += n; }
      const float alast = __int_as_float(__builtin_amdgcn_readlane(__float_as_int(sc), 63));
      const float c0 = sc - pr + a0, c1 = sc;
      fa[2 * lane] = c0; fa[2 * lane + 1] = c1;
      fa[128 + 2 * lane] = __expf(c0); fa[128 + 2 * lane + 1] = __expf(c1);
      fa[256 + 2 * lane] = __expf(alast - c0); fa[256 + 2 * lane + 1] = __expf(alast - c1);
    }
#pragma unroll
    for (int i = 0; i < 4; ++i)
#pragma unroll
      for (int r = 0; r < 4; ++r) Sl[(pw * 16 + lq * 4 + r) * 136 + (nq + i) * 16 + l15] = f2bf(st[i][r]);
    __syncthreads();
    if (ck + 1 < 32) S_LOAD(ck + 1)
    __builtin_amdgcn_sched_barrier(0);
    bf16x8 cf[4];
#pragma unroll
    for (int ks = 0; ks < 4; ++ks) cf[ks] = *(const bf16x8*)(Cl + (w * 16 + l15) * 136 + ks * 32 + lq * 8);
    f32x4 yacc[4];
#pragma unroll
    for (int pt = 0; pt < 4; ++pt) {
      yacc[pt] = zero4();
      if (ck > 0) {
#pragma unroll
        for (int ks = 0; ks < 4; ++ks) {
          const bf16x8 sf = *(const bf16x8*)(Sl + (pt * 16 + l15) * 136 + ks * 32 + lq * 8);
          yacc[pt] = mfma16(cf[ks], sf, yacc[pt]);
        }
#pragma unroll
        for (int r = 0; r < 4; ++r) yacc[pt][r] *= fa[128 + w * 16 + lq * 4 + r];
      }
    }
#pragma unroll
    for (int stl = 0; stl < 8; ++stl) {
      if (stl <= w) {
        f32x4 gacc = zero4();
#pragma unroll
        for (int ks = 0; ks < 4; ++ks) {
          const bf16x8 bfv = *(const bf16x8*)(Bl + (stl * 16 + l15) * 136 + ks * 32 + lq * 8);
          gacc = mfma16(cf[ks], bfv, gacc);
        }
#pragma unroll
        for (int r = 0; r < 4; ++r) {
          const int tt = w * 16 + lq * 4 + r, ss = stl * 16 + l15;
          float m = 0.f;
          if (ss <= tt) m = gacc[r] * __expf(fa[tt] - fa[ss]);
          Ml[tt * 136 + ss] = f2bf(m);
        }
      } else if (stl <= (w | 1)) {
#pragma unroll
        for (int r = 0; r < 4; ++r) Ml[(w * 16 + lq * 4 + r) * 136 + stl * 16 + l15] = 0;
      }
    }
    __builtin_amdgcn_fence(__ATOMIC_RELEASE, "wavefront");
    __builtin_amdgcn_wave_barrier();
    __builtin_amdgcn_fence(__ATOMIC_ACQUIRE, "wavefront");
#pragma unroll
    for (int ks = 0; ks < 4; ++ks) {
      if (ks * 32 <= w * 16 + 15) {
        const bf16x8 mf = *(const bf16x8*)(Ml + (w * 16 + l15) * 136 + ks * 32 + lq * 8);
#pragma unroll
        for (int pt = 0; pt < 4; ++pt) {
          const bf16x8 xf = tr_frag(Xl, 72, ks * 32, pt * 16, l15, lq);
          yacc[pt] = mfma16(mf, xf, yacc[pt]);
        }
      }
    }
    {
      __builtin_amdgcn_fence(__ATOMIC_RELEASE, "wavefront");
      __builtin_amdgcn_wave_barrier();
      float* Yf = (float*)(Ml + (w * 16) * 136);
#pragma unroll
      for (int pt = 0; pt < 4; ++pt)
#pragma unroll
        for (int r = 0; r < 4; ++r) Yf[(lq * 4 + r) * 68 + pt * 16 + l15] = yacc[pt][r];
      __builtin_amdgcn_fence(__ATOMIC_RELEASE, "wavefront");
      __builtin_amdgcn_wave_barrier();
      __builtin_amdgcn_fence(__ATOMIC_ACQUIRE, "wavefront");
      const int rr = lane >> 2, seg = (lane & 3) * 16;
      const long tok = t0 + w * 16 + rr;
      bf16_t* op = AY + tok * 1024 + 512 + h * 64 + seg;
#pragma unroll
      for (int j = 0; j < 2; ++j) {
        const u32x4 xu = ox[j], zu = oz[j];
        const float4 ya = *(const float4*)(Yf + rr * 68 + seg + j * 8), yb = *(const float4*)(Yf + rr * 68 + seg + j * 8 + 4);
        const float xf_[8] = {bflo(xu.x), bfhi(xu.x), bflo(xu.y), bfhi(xu.y), bflo(xu.z), bfhi(xu.z), bflo(xu.w), bfhi(xu.w)};
        const float zf_[8] = {bflo(zu.x), bfhi(zu.x), bflo(zu.y), bfhi(zu.y), bflo(zu.z), bfhi(zu.z), bflo(zu.w), bfhi(zu.w)};
        const float yf_[8] = {ya.x, ya.y, ya.z, ya.w, yb.x, yb.y, yb.z, yb.w};
        float o[8];
#pragma unroll
        for (int e = 0; e < 8; ++e) o[e] = (yf_[e] + xf_[e] * dsk) * silu_f(zf_[e]);
        *(uint4*)(op + j * 8) = make_uint4(pack2(o[0], o[1]), pack2(o[2], o[3]), pack2(o[4], o[5]), pack2(o[6], o[7]));
      }
      if (ck + 1 < 32) O_LOAD(ck + 1)
    }
    if (ck + 1 < 32) {
      const float dec = fa[128 + 127];
#pragma unroll
      for (int i = 0; i < 4; ++i)
#pragma unroll
        for (int r = 0; r < 4; ++r) st[i][r] *= dec;
#pragma unroll
      for (int ks = 0; ks < 4; ++ks) {
        const bf16x8 xr = tr_frag(Xl, 72, ks * 32, pw * 16, l15, lq);
        bf16x8 xf;
#pragma unroll
        for (int j = 0; j < 8; ++j) xf[j] = (short)f2bf(bf2f((bf16_t)xr[j]) * fa[256 + ks * 32 + lq * 8 + j]);
#pragma unroll
        for (int i = 0; i < 4; ++i) {
          const bf16x8 bfv = tr_frag(Bl, 136, ks * 32, (nq + i) * 16, l15, lq);
          st[i] = mfma16(xf, bfv, st[i]);
        }
      }
    }
    __syncthreads();
  }
#undef S_LOAD
#undef O_LOAD
}

__device__ __forceinline__ void wconv_item(const Ctx& c, int it) {
  float* tl = (float*)c.smem;
  float4 v[8];
  int f = it * 12;
  TJob jc = get_tjob(15 + (f >> 4), c, c.ws);
  int tilesN = (jc.N + 255) / 256;
  tstrip_load(jc, (f & 15) / tilesN, (f & 15) % tilesN, c.tid, v);
  for (int q = 0; q < 12; ++q) {
    tstrip_to_lds(c.tid, v, tl);
    __syncthreads();
    const TJob jd = jc; const int sd = f & 15, tnd = tilesN;
    ++f;
    if (q + 1 < 12) { jc = get_tjob(15 + (f >> 4), c, c.ws); tilesN = (jc.N + 255) / 256; tstrip_load(jc, (f & 15) / tilesN, (f & 15) % tilesN, c.tid, v); }
    tstrip_store(jd, sd / tnd, sd % tnd, c.tid, tl);
    __syncthreads();
  }
}

__device__ __forceinline__ void phase_mix(const Ctx& c0) {
  int* sitem = (int*)(c0.smem + SMEM_MAIN);
  int* qctr = (int*)(c0.ws + OFF_CTL) + CTL_QCTR + c0.pass;
  const int n_items = 128 + 2048 + 256;
  for (;;) {
    int tid = c0.tid; asm volatile("" : "+v"(tid));
    size_t wz = 0; asm volatile("" : "+s"(wz));
    char* ws = c0.ws + wz;
    const Ctx c{c0.p, ws, c0.smem, tid, c0.bid, c0.nblk, c0.f, c0.pass};
    char* smem = c.smem;
    if (tid == 0) *sitem = atomicAdd(qctr, 1);
    __syncthreads();
    const int item = *sitem;
    __syncthreads();
    if (item >= n_items) break;
    if (item < 128) {
      ssd_item(c, item >> 3, item & 7);
    } else {
      const int i2 = item - 128;
      if (i2 % 9 == 8) {
        wconv_item(c, i2 / 9);
      } else {
        const int it = i2 - i2 / 9;
        const int qb = 15 - (it >> 7), bh = it & 127;
        const bf16_t* Q = (const bf16_t*)(ws + OFF_Q) + ((long)bh * 4096 + qb * 256) * 96;
        const bf16_t* K = (const bf16_t*)(ws + OFF_K) + (long)bh * 4096 * 96;
        const bf16_t* Vv = (const bf16_t*)(ws + OFF_VT) + (long)bh * 4096 * 64;
        const int b = bh >> 3, h = bh & 7;
        bf16_t* O = (bf16_t*)(ws + OFF_R1) + ((long)b * 4096 + qb * 256) * 1024 + h * 64;
        attn_block<96, true>(Q, 96, K, 96, Vv, 64, 4 * qb + 4, qb * 256, O, 1024, smem, c.tid);
      }
    }
  }
}

__device__ __forceinline__ void phase_ynorm(const Ctx& c) {
  bf16_t* AY = (bf16_t*)(c.ws + OFF_R1);
  const int bid = c.bid, nblk = c.nblk;
  const int lane = c.tid & 63;
  const int gw = bid * NWAV + (c.tid >> 6), nw = nblk * NWAV;
  for (int row0 = gw * 4; row0 < NT; row0 += nw * 4) {
    uint4 u[4];
#pragma unroll
    for (int q = 0; q < 4; ++q) u[q] = *(const uint4*)(AY + (long)(row0 + q) * 1024 + 512 + lane * 8);
#pragma unroll
    for (int q = 0; q < 4; ++q) {
      float v[8] = {bflo(u[q].x), bfhi(u[q].x), bflo(u[q].y), bfhi(u[q].y), bflo(u[q].z), bfhi(u[q].z), bflo(u[q].w), bfhi(u[q].w)};
      float ss = 0.f;
#pragma unroll
      for (int j = 0; j < 8; ++j) ss += v[j] * v[j];
      ss = wave_sum(ss, lane);
      const float r = rsqrtf(ss * (1.f / 512.f) + EPS);
      *(uint4*)(AY + (long)(row0 + q) * 1024 + 512 + lane * 8) = make_uint4(pack2(v[0] * r, v[1] * r), pack2(v[2] * r, v[3] * r), pack2(v[4] * r, v[5] * r), pack2(v[6] * r, v[7] * r));
    }
  }
}

__device__ __forceinline__ void phase_gemm_out(const Ctx& c) {
  char* ws = c.ws;
  DenseOrder S; S.init(ws + OFF_R1, 1024, ws + OFF_WOUT_T, 1024, NT, 1024, c.nblk, c.bid, 0);
  EpiRes<0> E{ws, INP(I_X), (float*)(ws + OFF_SSQA), nullptr, nullptr, 1.f};
  fast_gemm((LAS3 unsigned char*)c.smem, S, E, 1024, c.tid);
}

__device__ __forceinline__ void phase_pool_gemm(const Ctx& c) {
  char* ws = c.ws;
  DenseOrder S; S.init(ws + OFF_R1, 1024, ws + OFF_POOL_T, 256, NT, 1024, c.nblk, c.bid, 512);
  EpiRes<2> E{ws, nullptr, (float*)(ws + OFF_SSQA), INP(I_POOL_B), INP(I_POOL_SCALE), c.f};
  fast_gemm((LAS3 unsigned char*)c.smem, S, E, 256, c.tid);
}

__device__ __forceinline__ void phase_xq(const Ctx& c, int l) {
  char* ws = c.ws;
  DenseOrder S; S.init(ws + OFF_XCB, 1024, ws + OFF_XQ_T + (size_t)l * 256 * 1024 * 2, 1024, NT, 256, c.nblk, c.bid, 0);
  EpiXq E{ws, c.smem, INP(I_XQ_NORM) + l * 64, c.tid, 0};
  fast_gemm((LAS3 unsigned char*)c.smem, S, E, 1024, c.tid);
}

__device__ __forceinline__ void phase_xattn(const Ctx& c, int l) {
  char* ws = c.ws; char* smem = c.smem; const int bid = c.bid, nblk = c.nblk; (void)smem; (void)bid; (void)nblk;
  for (int item = bid; item < 256 * 4; item += nblk) {
    const int mt = item >> 2, h = item & 3;
    const int b = mt >> 4;
    const bf16_t* Q = (const bf16_t*)(ws + OFF_XQ) + (long)mt * 256 * 256 + h * 64;
    const bf16_t* K = (const bf16_t*)(ws + OFF_MEMK) + (long)l * 4096 * 256 + (long)b * 256 * 256 + h * 64;
    const bf16_t* Vv = (const bf16_t*)(ws + OFF_MEMVT) + (long)l * 4096 * 256 + (long)b * 256 * 256 + h * 64;
    bf16_t* O = (bf16_t*)(ws + OFF_XO) + (long)mt * 256 * 256 + h * 64;
    attn_block<64, false>(Q, 256, K, 256, Vv, 256, 4, 0, O, 256, smem, c.tid);
  }
}

__device__ __forceinline__ void phase_xo(const Ctx& c, int l) {
  char* ws = c.ws;
  DenseOrder S; S.init(ws + OFF_XO, 256, ws + OFF_XO_T + (size_t)l * 1024 * 256 * 2, 256, NT, 1024, c.nblk, c.bid, 0);
  EpiRes<1> E{ws, nullptr, (float*)(ws + OFF_SSQB), nullptr, nullptr, c.f};
  fast_gemm((LAS3 unsigned char*)c.smem, S, E, 256, c.tid);
}

__device__ __forceinline__ void phase_router(const Ctx& c, int l) {
  char* ws = c.ws; char* smem = c.smem; const int bid = c.bid, nblk = c.nblk;
  const int t = c.tid, lane = t & 63, w = t >> 6, l15 = lane & 15, lq = lane >> 4;
  bf16_t* Ax = (bf16_t*)smem;
  bf16_t* Wh = Ax + 2 * 256 * 72;
  float* lg = (float*)(Wh + 2 * 96 * 72);
  int* lcn = (int*)(lg + 256 * 49);
  const bf16_t* wr = (const bf16_t*)(ws + OFF_WR) + (size_t)(l * 2) * 48 * 1024;
  int* cnt = (int*)(ws + OFF_CTL) + CTL_CNT + l * 32;
  int* list = (int*)(ws + OFF_LIST);
  float* gate = (float*)(ws + OFF_GATE);
  const bf16_t* xres = (const bf16_t*)(ws + OFF_XCB);
  for (int item = bid; item < NT / 256; item += nblk) {
    const int tok0 = item * 256;
    float rs_own = 0.f;
    if (t < 256) { rs_own = row_rs32((const float*)(ws + OFF_SSQB), tok0 + t); ((float*)(ws + OFF_RS2))[tok0 + t] = rs_own; }
    if (t < 32) lcn[t] = 0;
    f32x4 acc[2][3];
#pragma unroll
    for (int mt = 0; mt < 2; ++mt)
#pragma unroll
      for (int i = 0; i < 3; ++i) acc[mt][i] = zero4();
    u32x4 xa[4], xw[2];
#define R_LOAD(KC) { \
      _Pragma("unroll") for (int i = 0; i < 4; ++i) { const int ch = t + NTHR * i; xa[i] = *(const u32x4*)(xres + (long)(tok0 + (ch >> 3)) * 1024 + (KC) * 64 + (ch & 7) * 8); } \
      _Pragma("unroll") for (int i = 0; i < 2; ++i) { const int ch = t + NTHR * i; if (ch < 768) xw[i] = *(const u32x4*)(wr + (long)(ch >> 3) * 1024 + (KC) * 64 + (ch & 7) * 8); } }
#define R_STORE(ST) { bf16_t* Ad_ = Ax + (ST) * 256 * 72; bf16_t* Wd_ = Wh + (ST) * 96 * 72; \
      _Pragma("unroll") for (int i = 0; i < 4; ++i) { const int ch = t + NTHR * i; *(u32x4*)(Ad_ + (ch >> 3) * 72 + (ch & 7) * 8) = xa[i]; } \
      _Pragma("unroll") for (int i = 0; i < 2; ++i) { const int ch = t + NTHR * i; if (ch < 768) *(u32x4*)(Wd_ + (ch >> 3) * 72 + (ch & 7) * 8) = xw[i]; } }
    R_LOAD(0)
    R_STORE(0)
    R_LOAD(1)
    __syncthreads();
    for (int kc = 0; kc < 16; ++kc) {
      const bf16_t* Ac = Ax + (kc & 1) * 256 * 72; const bf16_t* Wc = Wh + (kc & 1) * 96 * 72;
#pragma unroll
      for (int ks = 0; ks < 2; ++ks) {
        bf16x8 af[2];
#pragma unroll
        for (int mt = 0; mt < 2; ++mt) af[mt] = *(const bf16x8*)(Ac + (w * 32 + mt * 16 + l15) * 72 + ks * 32 + lq * 8);
#pragma unroll
        for (int nt = 0; nt < 3; ++nt) {
          const bf16x8 wh = *(const bf16x8*)(Wc + (nt * 16 + l15) * 72 + ks * 32 + lq * 8);
          const bf16x8 wl = *(const bf16x8*)(Wc + (48 + nt * 16 + l15) * 72 + ks * 32 + lq * 8);
#pragma unroll
          for (int mt = 0; mt < 2; ++mt) { acc[mt][nt] = mfma16(af[mt], wh, acc[mt][nt]); acc[mt][nt] = mfma16(af[mt], wl, acc[mt][nt]); }
        }
      }
      if (kc + 1 < 16) {
        R_STORE((kc + 1) & 1)
        if (kc + 2 < 16) R_LOAD(kc + 2)
      }
      __syncthreads();
    }
#undef R_LOAD
#undef R_STORE
#pragma unroll
    for (int mt = 0; mt < 2; ++mt)
#pragma unroll
      for (int nt = 0; nt < 3; ++nt)
#pragma unroll
        for (int r = 0; r < 4; ++r) lg[(w * 32 + mt * 16 + lq * 4 + r) * 49 + nt * 16 + l15] = acc[mt][nt][r];
    __syncthreads();
    int x0 = 0, x1 = 0, r0 = 0, r1 = 0; float g0 = 0.f, g1 = 0.f;
    if (t < 256) {
      const float* L = lg + t * 49;
      float gl[4];
#pragma unroll
      for (int i = 0; i < 4; ++i) gl[i] = L[i] * rs_own + INP(I_RG_B)[l * 4 + i];
      int gi = 0; float gm = gl[0];
#pragma unroll
      for (int i = 1; i < 4; ++i) if (gl[i] > gm) { gm = gl[i]; gi = i; }
      float gsum = 0.f;
#pragma unroll
      for (int i = 0; i < 4; ++i) gsum += __expf(gl[i] - gm);
      const float gp = 1.f / gsum;
      float e0 = -3e38f, e1 = -3e38f; int i0 = 0, i1 = 0;
      for (int j = 0; j < 8; ++j) {
        const float v = L[4 + gi * 8 + j] * rs_own + INP(I_RE_B)[l * 32 + gi * 8 + j];
        if (v > e0) { e1 = e0; i1 = i0; e0 = v; i0 = j; }
        else if (v > e1) { e1 = v; i1 = j; }
      }
      const float p1 = __expf(e1 - e0);
      g0 = gp / (1.f + p1); g1 = gp * p1 / (1.f + p1);
      x0 = gi * 8 + i0; x1 = gi * 8 + i1;
      r0 = atomicAdd(&lcn[x0], 1);
      r1 = atomicAdd(&lcn[x1], 1);
    }
    __syncthreads();
    if (t < 32 && c.f != 0.f) lcn[32 + t] = atomicAdd(&cnt[t], lcn[t]);
    __syncthreads();
    if (t < 256 && c.f != 0.f) {
      const int tok = tok0 + t;
      const int pos0 = lcn[32 + x0] + r0, pos1 = lcn[32 + x1] + r1;
      list[x0 * 65536 + pos0] = tok * 2;
      list[x1 * 65536 + pos1] = tok * 2 + 1;
      gate[tok * 2] = g0; gate[tok * 2 + 1] = g1;
      int* pinfo = (int*)(ws + OFF_PINFO);
      pinfo[tok * 2] = (x0 << 16) | pos0; pinfo[tok * 2 + 1] = (x1 << 16) | pos1;
    }
    __syncthreads();
  }
}

__device__ __forceinline__ int expert_prefix(const int* cnt, int* pre, int tid) {
  if (tid == 0) {
    int s = 0;
    for (int e = 0; e < 32; ++e) { pre[e] = s; s += (cnt[e] + 255) >> 8; }
    pre[32] = s;
  }
  __syncthreads();
  return pre[32];
}

template <bool GA_>
struct ExpertOrder {
  static constexpr bool GATHER = GA_;
  const char* A; const char* W; const int* list; const int* cnt; const int* pre; int lda_, ldb_, nN, total, G, c, which; size_t wstride;
  __device__ __forceinline__ bool next(int i, FUnit& u) const {
    const long L = (long)i * G + c; if (L >= (long)total * nN) return false;
    const int tile = (int)(L / nN); u.pn = (int)(L % nN); u.pm = tile;
    int e = 0;
    for (int j = 1; j < 32; ++j) if (pre[j] <= tile) e = j;
    e = __builtin_amdgcn_readfirstlane(e);
    u.e = e; u.pos0 = __builtin_amdgcn_readfirstlane((tile - pre[e]) * 256);
    u.nvalid = __builtin_amdgcn_readfirstlane(min(256, cnt[e] - u.pos0)); return true;
  }
  __device__ __forceinline__ unsigned lda() const { return (unsigned)lda_; }
  __device__ __forceinline__ unsigned ldb() const { return (unsigned)ldb_; }
  __device__ __forceinline__ const char* a_ptr(const FUnit& u) const { return GA_ ? A : A + (size_t)u.pm * 256 * lda_ * 2; }
  __device__ __forceinline__ const char* b_ptr(const FUnit& u) const { return W + (size_t)u.e * wstride + (size_t)u.pn * 256 * ldb_ * 2; }
  __device__ __forceinline__ void a_offs(const FUnit& u, int tid, unsigned (&va)[2][2]) const {
    int R0, C0, R1, C1; fg_stage_rc(tid * 16, R0, C0); fg_stage_rc(tid * 16 + 8192, R1, C1);
    const int* lp = list + u.e * 65536 + u.pos0;
#pragma unroll
    for (int h = 0; h < 2; ++h) {
      const int p0 = lp[min(128 * h + R0, u.nvalid - 1)], p1 = lp[min(128 * h + R1, u.nvalid - 1)];
      const int r0 = which == 0 ? (p0 >> 1) : p0, r1 = which == 0 ? (p1 >> 1) : p1;
      va[h][0] = (unsigned)(r0 * lda_ + C0) * 2u; va[h][1] = (unsigned)(r1 * lda_ + C1) * 2u;
    }
  }
};

struct EpiExpUp {
  char* ws; const int* list;
  __device__ __forceinline__ void operator()(const f32x4 (&acc)[2][2][4][2], const FUnit& u, int wr, int wc, int fr, int fq, int lane) const {
    const float* rs2 = (const float*)(ws + OFF_RS2);
    bf16_t* hb = (bf16_t*)(ws + OFF_HBUF);
    int pairv[2][4]; float rsv[2][4];
#pragma unroll
    for (int ai = 0; ai < 2; ++ai)
#pragma unroll
      for (int m = 0; m < 4; ++m) pairv[ai][m] = list[u.e * 65536 + u.pos0 + min(ai * 128 + wr * 64 + m * 16 + fr, u.nvalid - 1)];
#pragma unroll
    for (int ai = 0; ai < 2; ++ai)
#pragma unroll
      for (int m = 0; m < 4; ++m) rsv[ai][m] = rs2[pairv[ai][m] >> 1];
#pragma unroll
    for (int ai = 0; ai < 2; ++ai)
#pragma unroll
      for (int m = 0; m < 4; ++m) {
        const int rl = ai * 128 + wr * 64 + m * 16 + fr;
        const float rs = rsv[ai][m];
        if (rl < u.nvalid) {
#pragma unroll
          for (int bj = 0; bj < 2; ++bj) {
            const f32x4 g4 = acc[ai][bj][m][0] * rs, u4 = acc[ai][bj][m][1] * rs;
            const int col = u.pn * 128 + bj * 64 + wc * 16 + fq * 4;
            uint2 w2; w2.x = cvt_pk_bf16(silu_f(g4[0]) * u4[0], silu_f(g4[1]) * u4[1]); w2.y = cvt_pk_bf16(silu_f(g4[2]) * u4[2], silu_f(g4[3]) * u4[3]);
            *(uint2*)(hb + ((long)u.pm * 256 + rl) * 256 + col) = w2;
          }
        }
      }
  }
};
struct EpiExpDown {
  char* ws;
  __device__ __forceinline__ void operator()(const f32x4 (&acc)[2][2][4][2], const FUnit& u, int wr, int wc, int fr, int fq, int lane) const {
    bf16_t* yb = (bf16_t*)(ws + OFF_YBUF);
#pragma unroll
    for (int ai = 0; ai < 2; ++ai)
#pragma unroll
      for (int m = 0; m < 4; ++m) {
        const long row = (long)u.pm * 256 + ai * 128 + wr * 64 + m * 16 + fr;
#pragma unroll
        for (int bj = 0; bj < 2; ++bj) {
          const f32x4 v0 = acc[ai][bj][m][0], v1 = acc[ai][bj][m][1];
          const int col0 = u.pn * 256 + bj * 128 + wc * 32 + fq * 8;
          u32x4 w4; w4.x = cvt_pk_bf16(v0[0], v0[1]); w4.y = cvt_pk_bf16(v0[2], v0[3]); w4.z = cvt_pk_bf16(v1[0], v1[1]); w4.w = cvt_pk_bf16(v1[2], v1[3]);
          *(u32x4*)(yb + row * 1024 + col0) = w4;
        }
      }
  }
};

template <int WHICH>
__device__ __forceinline__ void phase_expert(const Ctx& c, int l) {
  char* ws = c.ws; char* smem = c.smem;
  int* pre = (int*)(smem + SMEM_MAIN + 16);
  const int* cnt = (const int*)(ws + OFF_CTL) + CTL_CNT + l * 32;
  const int* list = (const int*)(ws + OFF_LIST);
  const int ttiles = expert_prefix(cnt, pre, c.tid);
  if (WHICH == 0) {
    ExpertOrder<true> S;
    S.list = list; S.cnt = cnt; S.pre = pre; S.total = ttiles; S.G = c.nblk; S.c = c.bid; S.which = 0;
    S.A = ws + OFF_XCB; S.lda_ = 1024; S.W = ws + OFF_WGU_T + (size_t)l * 32 * 512 * 1024 * 2; S.ldb_ = 1024; S.nN = 2; S.wstride = (size_t)512 * 1024 * 2;
    EpiExpUp E{ws, list};
    fast_gemm((LAS3 unsigned char*)smem, S, E, 1024, c.tid);
  } else {
    ExpertOrder<false> S;
    S.list = list; S.cnt = cnt; S.pre = pre; S.total = ttiles; S.G = c.nblk; S.c = c.bid; S.which = 1;
    S.A = ws + OFF_HBUF; S.lda_ = 256; S.W = ws + OFF_WD_T + (size_t)l * 32 * 1024 * 256 * 2; S.ldb_ = 256; S.nN = 4; S.wstride = (size_t)1024 * 256 * 2;
    EpiExpDown E{ws};
    fast_gemm((LAS3 unsigned char*)smem, S, E, 256, c.tid);
  }
}

__device__ __forceinline__ void phase_combine(const Ctx& c, int l) {
  char* ws = c.ws; const int bid = c.bid, nblk = c.nblk;
  const int lane = c.tid & 63;
  const int gw = bid * NWAV + (c.tid >> 6), nw = nblk * NWAV;
  const bf16_t* yb = (const bf16_t*)(ws + OFF_YBUF);
  bf16_t* xcb = (bf16_t*)(ws + OFF_XCB);
  bf16_t* xnb = (bf16_t*)(ws + OFF_R4);
  const int* pinfo = (const int*)(ws + OFF_PINFO);
  const float* gate = (const float*)(ws + OFF_GATE);
  int* pre = (int*)(c.smem + SMEM_MAIN + 16);
  (void)expert_prefix((const int*)(ws + OFF_CTL) + CTL_CNT + l * 32, pre, c.tid);
  for (int row0 = gw * 2; row0 < NT; row0 += nw * 2) {
    uint2 xr[2][4], ya[2][4], yc[2][4]; float ga[2], gc[2];
#pragma unroll
    for (int q = 0; q < 2; ++q)
#pragma unroll
      for (int i = 0; i < 4; ++i) {
        const int cc = i * 256 + lane * 4; const long row = row0 + q;
        const int i0 = pinfo[row * 2], i1 = pinfo[row * 2 + 1];
        const long r0 = (long)pre[i0 >> 16] * 256 + (i0 & 0xffff), r1 = (long)pre[i1 >> 16] * 256 + (i1 & 0xffff);
        ga[q] = gate[row * 2]; gc[q] = gate[row * 2 + 1];
        xr[q][i] = *(const uint2*)(xcb + row * 1024 + cc);
        ya[q][i] = *(const uint2*)(yb + r0 * 1024 + cc); yc[q][i] = *(const uint2*)(yb + r1 * 1024 + cc);
      }
#pragma unroll
    for (int q = 0; q < 2; ++q) {
      const long row = row0 + q;
      float4 x[4];
      float ss = 0.f;
#pragma unroll
      for (int i = 0; i < 4; ++i) {
        const int cc = i * 256 + lane * 4;
        float4 v;
        const float g0 = ga[q] * c.f, g1 = gc[q] * c.f;
        v.x = bflo(xr[q][i].x) + (g0 * bflo(ya[q][i].x) + g1 * bflo(yc[q][i].x)); v.y = bfhi(xr[q][i].x) + (g0 * bfhi(ya[q][i].x) + g1 * bfhi(yc[q][i].x));
        v.z = bflo(xr[q][i].y) + (g0 * bflo(ya[q][i].y) + g1 * bflo(yc[q][i].y)); v.w = bfhi(xr[q][i].y) + (g0 * bfhi(ya[q][i].y) + g1 * bfhi(yc[q][i].y));
        if (l == 1) { if (c.f != 0.f) *(float4*)(c.p.out + row * 1024 + cc) = v; }
        else {
          const uint2 st2 = make_uint2(pack2(v.x, v.y), pack2(v.z, v.w));
          *(uint2*)(xcb + row * 1024 + cc) = st2;
          v = make_float4(bflo(st2.x), bfhi(st2.x), bflo(st2.y), bfhi(st2.y));
        }
        x[i] = v;
        ss += v.x * v.x + v.y * v.y + v.z * v.z + v.w * v.w;
      }
      if (l == 0) {
        ss = wave_sum(ss, lane);
        const float r = rsqrtf(ss * (1.f / 1024.f) + EPS);
#pragma unroll
        for (int i = 0; i < 4; ++i)
          *(uint2*)(xnb + row * 1024 + i * 256 + lane * 4) = make_uint2(pack2(x[i].x * r, x[i].y * r), pack2(x[i].z * r, x[i].w * r));
      }
    }
  }
}

__device__ __forceinline__ void phase_pool_dlt(const Ctx& c) {
  char* ws = c.ws; const int bid = c.bid, nblk = c.nblk;
  const bf16_t* xnb = (const bf16_t*)(ws + OFF_R4);
  bf16_t* dl = (bf16_t*)(ws + OFF_R1);
  const int t = c.tid;
  const int ch = (t & 127) * 8, sub = t >> 7;
  const int wnd = 2 << (ch >> 8);
  for (int tb = bid; tb < NT / 256; tb += nblk) {
    const int tok0 = tb * 256 + sub * 64;
    const int s0 = tok0 & 4095;
    const bf16_t* src = xnb + (long)tok0 * 1024 + ch;
    float sum[8] = {0.f, 0.f, 0.f, 0.f, 0.f, 0.f, 0.f, 0.f};
    const int nh = min(wnd, s0);
    for (int k = 1; k <= nh; ++k) {
      const uint4 u = *(const uint4*)(src - (long)k * 1024);
      sum[0] += bflo(u.x); sum[1] += bfhi(u.x); sum[2] += bflo(u.y); sum[3] += bfhi(u.y); sum[4] += bflo(u.z); sum[5] += bfhi(u.z); sum[6] += bflo(u.w); sum[7] += bfhi(u.w);
    }
    for (int i0 = 0; i0 < 64; i0 += 4) {
      uint4 un[4], uo[4];
#pragma unroll
      for (int q = 0; q < 4; ++q) {
        un[q] = *(const uint4*)(src + (long)(i0 + q) * 1024);
        uo[q] = make_uint4(0, 0, 0, 0);
        if (s0 + i0 + q >= wnd) uo[q] = *(const uint4*)(src + (long)(i0 + q - wnd) * 1024);
      }
#pragma unroll
      for (int q = 0; q < 4; ++q) {
        const float xn_[8] = {bflo(un[q].x), bfhi(un[q].x), bflo(un[q].y), bfhi(un[q].y), bflo(un[q].z), bfhi(un[q].z), bflo(un[q].w), bfhi(un[q].w)};
        const float xo_[8] = {bflo(uo[q].x), bfhi(uo[q].x), bflo(uo[q].y), bfhi(uo[q].y), bflo(uo[q].z), bfhi(uo[q].z), bflo(uo[q].w), bfhi(uo[q].w)};
        const float inv = 1.f / (float)min(s0 + i0 + q + 1, wnd);
        float o[8];
#pragma unroll
        for (int j = 0; j < 8; ++j) { sum[j] += xn_[j] - xo_[j]; o[j] = sum[j] * inv - xn_[j]; }
        *(uint4*)(dl + (long)(tok0 + i0 + q) * 1024 + ch) = make_uint4(pack2(o[0], o[1]), pack2(o[2], o[3]), pack2(o[4], o[5]), pack2(o[6], o[7]));
      }
    }
  }
}

#define XB_TMO      128
#define XB_XCNT(j)  (256  + 64 * (j))
#define XB_XSUB(j)  (1280 + 64 * (j))
#define XB_XGEN(j)  (2304 + 64 * (j))
#define XB_TOP      3328
#define XB_TOPGEN   3392
#define XCD_BAR_WORDS 3456
#define XB_SPIN_CAP (1u << 22)
#define LAS __attribute__((address_space(3)))
__device__ __forceinline__ unsigned xb_ld(unsigned* p)              { return __hip_atomic_load(p, __ATOMIC_RELAXED, __HIP_MEMORY_SCOPE_AGENT); }
__device__ __forceinline__ unsigned xb_add(unsigned* p, unsigned v) { return __hip_atomic_fetch_add(p, v, __ATOMIC_RELAXED, __HIP_MEMORY_SCOPE_AGENT); }
__device__ __forceinline__ unsigned xb_xcc_id() { return (unsigned)__builtin_amdgcn_s_getreg((3 << 11) | 20) & 0xFu; }
#define XB_SPIN(cond, bar) do { unsigned _sp = 0; while (cond) { __builtin_amdgcn_s_sleep(1); \
    if ((++_sp & 255u) == 0u) { if (xb_ld(&(bar)[XB_TMO])) break; if (_sp > XB_SPIN_CAP) { atomicAdd(&(bar)[XB_TMO], 1u); break; } } } } while (0)
struct XcdBarrier { unsigned* bar; unsigned x; volatile LAS unsigned* st; };
__device__ __forceinline__ XcdBarrier xcd_barrier_post(unsigned* bar, volatile LAS unsigned* st) {
  XcdBarrier b; b.bar = bar; b.x = xb_xcc_id(); b.st = st;
  if (threadIdx.x == 0) (void)xb_add(&bar[XB_XCNT(b.x)], 1u);
  return b;
}
__device__ __forceinline__ void xcd_barrier_complete(unsigned* bar, unsigned x, unsigned& nloc, unsigned& nx) {
  const unsigned G = gridDim.x * gridDim.y * gridDim.z;
  unsigned sum, cnt, mine, sp = 0u;
  for (;;) {
    sum = 0u; cnt = 0u; mine = 0u;
#pragma unroll
    for (unsigned j = 0; j < 16; ++j) { const unsigned cc = xb_ld(&bar[XB_XCNT(j)]); sum += cc; cnt += (cc > 0u) ? 1u : 0u; mine = (j == x) ? cc : mine; }
    if (sum == G) break;
    __builtin_amdgcn_s_sleep(1);
    if ((++sp & 255u) == 0u) { if (xb_ld(&bar[XB_TMO])) break; if (sp > XB_SPIN_CAP) { atomicAdd(&bar[XB_TMO], 1u); break; } }
  }
  nloc = mine > 0u ? mine : 1u; nx = cnt > 0u ? cnt : 1u;
}
__device__ __forceinline__ void xcd_barrier(const XcdBarrier& b) {
  asm volatile("s_waitcnt vmcnt(0)" ::: "memory");
  __syncthreads();
  if (threadIdx.x == 0) {
    unsigned* bar = b.bar;
    __builtin_amdgcn_s_waitcnt(0);
    unsigned nloc = b.st[0], nx = b.st[1];
    if (nloc == 0u) { xcd_barrier_complete(bar, b.x, nloc, nx); b.st[0] = nloc; b.st[1] = nx; }
    const unsigned old = xb_add(&bar[XB_XSUB(b.x)], 1u);
    const unsigned gen = old / nloc;
    if (old + 1u == (gen + 1u) * nloc) {
      __builtin_amdgcn_fence(__ATOMIC_RELEASE, "agent");
      asm volatile("s_waitcnt vmcnt(0)" ::: "memory");
      const unsigned og = xb_add(&bar[XB_TOP], 1u);
      const unsigned tg = og / nx;
      if (og + 1u == (tg + 1u) * nx) xb_add(&bar[XB_TOPGEN], 1u);
      else XB_SPIN(xb_ld(&bar[XB_TOPGEN]) == tg, bar);
      __builtin_amdgcn_fence(__ATOMIC_ACQUIRE, "agent");
      xb_add(&bar[XB_XGEN(b.x)], 1u);
      asm volatile("s_waitcnt vmcnt(0)" ::: "memory");
    } else {
      XB_SPIN(xb_ld(&bar[XB_XGEN(b.x)]) == gen, bar);
      __builtin_amdgcn_fence(__ATOMIC_ACQUIRE, "agent");
      asm volatile("s_waitcnt vmcnt(0)" ::: "memory");
    }
  }
  __syncthreads();
}

constexpr int N_PHASES = 22;
#define RUN_PHASE(PH, CALL) do { \
    constexpr int nrep_ = ((PROBE_MASK >> (PH)) & 1u) ? 2 : 1; \
    _Pragma("unroll 1") for (int rep_ = 0; rep_ < nrep_; ++rep_) { \
      int tid = threadIdx.x; asm volatile("" : "+v"(tid)); \
      size_t wz = 0; asm volatile("" : "+s"(wz)); \
      char* ws = p.ws + wz; \
      int bid = blockIdx.x; asm volatile("" : "+s"(bid)); \
      int nblk = gridDim.x; asm volatile("" : "+s"(nblk)); \
      const Ctx c{p, ws, smem, tid, bid, nblk, (PROBE_MASK != 0u && rep_) ? 0.f : 1.f, rep_}; \
      CALL; \
      if ((PH) + 1 < N_PHASES || rep_ + 1 < nrep_) xcd_barrier(xb); \
    } } while (0)

__global__ void __launch_bounds__(NTHR, 2) fwd_megakernel(Params p) {
  extern __shared__ __attribute__((aligned(16))) char smem[];
  volatile LAS unsigned* xst = (volatile LAS unsigned*)(smem + SMEM_MAIN + 256);
  if (threadIdx.x < 4) xst[threadIdx.x] = 0u;
  __syncthreads();
  const XcdBarrier xb = xcd_barrier_post((unsigned*)(p.ws + OFF_BAR), xst);
  RUN_PHASE(0, phase_prep(c));
  RUN_PHASE(1, phase_gemm_in(c));
  RUN_PHASE(2, phase_up(c));
  RUN_PHASE(3, phase_mix(c));
  RUN_PHASE(4, phase_ynorm(c));
  RUN_PHASE(5, phase_gemm_out(c));
  RUN_PHASE(6, phase_xq(c, 0));
  RUN_PHASE(7, phase_xattn(c, 0));
  RUN_PHASE(8, phase_xo(c, 0));
  RUN_PHASE(9, phase_router(c, 0));
  RUN_PHASE(10, phase_expert<0>(c, 0));
  RUN_PHASE(11, phase_expert<1>(c, 0));
  RUN_PHASE(12, phase_combine(c, 0));
  RUN_PHASE(13, phase_pool_dlt(c));
  RUN_PHASE(14, phase_pool_gemm(c));
  RUN_PHASE(15, phase_xq(c, 1));
  RUN_PHASE(16, phase_xattn(c, 1));
  RUN_PHASE(17, phase_xo(c, 1));
  RUN_PHASE(18, phase_router(c, 1));
  RUN_PHASE(19, phase_expert<0>(c, 1));
  RUN_PHASE(20, phase_expert<1>(c, 1));
  RUN_PHASE(21, phase_combine(c, 1));
}

extern "C" void kernel_launch(void* const* d_in, const int* in_sizes, int n_in, void* d_out,
                              int out_size, void* d_ws, size_t ws_size, hipStream_t stream) {
  static int grid_blocks = 0;
  if (!grid_blocks) {
    int dev = 0, cus = 0, per_cu = 0;
    (void)hipGetDevice(&dev);
    (void)hipDeviceGetAttribute(&cus, hipDeviceAttributeMultiprocessorCount, dev);
    (void)hipFuncSetAttribute((const void*)fwd_megakernel, hipFuncAttributeMaxDynamicSharedMemorySize, SMEM_BYTES);
    (void)hipOccupancyMaxActiveBlocksPerMultiprocessor(&per_cu, fwd_megakernel, NTHR, SMEM_BYTES);
    if (per_cu > 1) per_cu = 1;
    if (per_cu < 1) per_cu = 1;
    grid_blocks = cus * per_cu;
    if (ws_size < WS_END) { fprintf(stderr, "workspace too small: %zu < %zu\n", ws_size, (size_t)WS_END); grid_blocks = -1; }
    if (n_in != N_IN) { fprintf(stderr, "unexpected n_in %d\n", n_in); grid_blocks = -1; }
  }
  if (grid_blocks < 0) return;
  Params p{};
  for (int i = 0; i < N_IN; ++i) p.in[i] = d_in[i];
  p.out = (float*)d_out;
  p.ws = (char*)d_ws;
  (void)hipMemsetAsync((char*)d_ws + OFF_BAR, 0, 16384, stream);
  void* args[] = {&p};
  hipError_t e = hipLaunchCooperativeKernel((void*)fwd_megakernel, dim3(grid_blocks), dim3(NTHR), args, SMEM_BYTES, stream);
  if (e != hipSuccess) fprintf(stderr, "cooperative launch failed: %s (grid %d)\n", hipGetErrorString(e), grid_blocks);
}
```
